# Optimizing an MI355X kernel written in HIP

```python
import math
import jax, jax.numpy as jnp
from jax import lax
import numpy as np

D_MODEL = 1024
BATCH = 8
SEQ = 2048
DEPTH = 1

GRID_W = 64
CTX_LEN = 256

N_MOD = 6
NORM_EPS = 1e-6

MIX_WIDTH = D_MODEL
RET_HEADS = 4
RET_WIDTH = MIX_WIDTH // 2
RET_DV = RET_WIDTH // RET_HEADS
RET_DK = RET_DV // 2
RET_CHUNK = 128
DIFF_HEADS = 4
DIFF_WIDTH = MIX_WIDTH - RET_WIDTH
DIFF_DV = DIFF_WIDTH // DIFF_HEADS
DIFF_D = DIFF_DV // 2
Q_BLOCK = 128
ROPE_DIM = RET_DK
ROPE_BASE = 10000.0

RET_QK_COLS = RET_HEADS * RET_DK
IN_SPLITS = (RET_QK_COLS, 2 * RET_QK_COLS, 2 * RET_QK_COLS + RET_WIDTH, 2 * RET_QK_COLS + 2 * RET_WIDTH, 2 * RET_QK_COLS + 2 * RET_WIDTH + DIFF_WIDTH, 2 * RET_QK_COLS + 2 * RET_WIDTH + 2 * DIFF_WIDTH)
IN_COLS = 2 * RET_QK_COLS + 2 * RET_WIDTH + 3 * DIFF_WIDTH

PEER_HEADS = 8
PEER_NKEYS = 128
PEER_N_EXPERTS = PEER_NKEYS * PEER_NKEYS
PEER_QDIM = 256
PEER_HALF = PEER_QDIM // 2
PEER_TOPK = 16
PEER_BLOCK = 128

kernel_name = "hybrid_retention_diffattn_peer_dit_layer"


def rms_norm(x, g, eps=NORM_EPS):
    xf = x.astype(jnp.float32)
    y = xf * lax.rsqrt(jnp.mean(xf * xf, axis=-1, keepdims=True) + eps)
    return (y * g.astype(jnp.float32)).astype(x.dtype)


def modulate(x, g, shift, scale):
    return rms_norm(x, g) * (1.0 + scale) + shift


def adaln_params(cond, w_mod, b_mod):
    mod = jax.nn.silu(cond) @ w_mod + b_mod
    return mod.reshape(cond.shape[0], N_MOD, 1, cond.shape[-1])


def heads(t, n_heads):
    b, l, _ = t.shape
    return t.reshape(b, l, n_heads, -1).transpose(0, 2, 1, 3)


def merge_heads(t):
    b, h, l, e = t.shape
    return t.transpose(0, 2, 1, 3).reshape(b, l, h * e)


def axial_rope_tables(rows, head_dim, dtype):
    quarter = head_dim // 4
    freqs = ROPE_BASE ** (-jnp.arange(quarter, dtype=jnp.float32) / quarter)
    row = jnp.repeat(jnp.arange(rows, dtype=jnp.float32), GRID_W)
    col = jnp.tile(jnp.arange(GRID_W, dtype=jnp.float32), rows)
    ar = row[:, None] * freqs
    ac = col[:, None] * freqs
    ang = jnp.concatenate([ar, ar, ac, ac], axis=-1)
    return jnp.cos(ang).astype(dtype), jnp.sin(ang).astype(dtype)


def apply_rope(x, cos, sin):
    quarter = x.shape[-1] // 4
    xr = x.reshape(x.shape[:-1] + (2, 2, quarter))
    rot = jnp.concatenate([-xr[..., 1:, :], xr[..., :1, :]], axis=-2).reshape(x.shape)
    return x * cos + rot * sin


def decayed_state(k, v, log_gamma):
    l = k.shape[2]
    dist = (l - 1 - jnp.arange(l)).astype(jnp.float32)
    w = jnp.exp(dist[None, :] * log_gamma[:, None]).astype(k.dtype)
    return jnp.einsum('bhjd,hj,bhje->bhde', k, w, v)


def retention_chunkwise(q, k, v, log_gamma, init_state, strict):
    b, h, l, dk = q.shape
    dv = v.shape[-1]
    n = l // RET_CHUNK
    C = RET_CHUNK
    qc = q.reshape(b, h, n, C, dk)
    kc = k.reshape(b, h, n, C, dk)
    vc = v.reshape(b, h, n, C, dv)
    idx = jnp.arange(C, dtype=jnp.float32)
    diff = idx[:, None] - idx[None, :]
    mask = (diff > 0) if strict else (diff >= 0)
    lg = log_gamma[:, None, None]
    intra_decay = jnp.where(mask, jnp.exp(jnp.where(mask, diff, 0.0) * lg), 0.0).astype(q.dtype)
    scores = jnp.einsum('bhnid,bhnjd->bhnij', qc, kc) * intra_decay[None, :, None]
    out = jnp.einsum('bhnij,bhnje->bhnie', scores, vc)
    k_w = jnp.exp((C - 1 - idx)[None, :] * log_gamma[:, None]).astype(q.dtype)
    local = jnp.einsum('bhnjd,hj,bhnje->bhnde', kc, k_w, vc)
    chunk_decay = jnp.exp(C * log_gamma).astype(q.dtype)[None, :, None, None]

    def step(r, s):
        return chunk_decay * r + s, r

    _, r_prev = lax.scan(step, init_state.astype(local.dtype), jnp.moveaxis(local, 2, 0))
    r_prev = jnp.moveaxis(r_prev, 0, 2)
    q_w = jnp.exp((idx + 1.0)[None, :] * log_gamma[:, None]).astype(q.dtype)
    out = out + jnp.einsum('bhnid,hi,bhnde->bhnie', qc, q_w, r_prev)
    return out.reshape(b, h, l, dv)


def bidirectional_retention(q, k, v, lg_f, lg_b, state_f, state_b):
    flip = lambda t: jnp.flip(t, axis=2)
    y_f = retention_chunkwise(q, k, v, lg_f, state_f, strict=False)
    y_b = flip(retention_chunkwise(flip(q), flip(k), flip(v), lg_b, state_b, strict=True))
    return y_f + y_b


def retention_group(rq, rk, rv, rg, crq, crk, crv, crg, decay_logit, norm_g, cos, sin, with_ctx_out):
    scale = RET_DK ** -0.5
    log_gamma = jax.nn.log_sigmoid(decay_logit.astype(jnp.float32))
    lg_f, lg_b = log_gamma[0], log_gamma[1]
    q = apply_rope(heads(rq, RET_HEADS), cos, sin)
    k = apply_rope(heads(rk, RET_HEADS), cos, sin) * scale
    v = heads(rv, RET_HEADS)
    kc = heads(crk, RET_HEADS) * scale
    vc = heads(crv, RET_HEADS)
    state_f = decayed_state(kc, vc, lg_f)
    state_b = decayed_state(jnp.flip(kc, axis=2), jnp.flip(vc, axis=2), lg_b)
    y = bidirectional_retention(q, k, v, lg_f, lg_b, state_f, state_b)
    g_norm = norm_g[:, None, :]
    out = merge_heads(rms_norm(y, g_norm)) * jax.nn.silu(rg)
    ctx_out = None
    if with_ctx_out:
        qc = heads(crq, RET_HEADS)
        zero = jnp.zeros(state_f.shape, state_f.dtype)
        yc = bidirectional_retention(qc, kc, vc, lg_f, lg_b, zero, zero)
        ctx_out = merge_heads(rms_norm(yc, g_norm)) * jax.nn.silu(crg)
    return out, ctx_out


def diff_softmax_attend(q, k, v, lam):
    s = jnp.einsum('bhpqd,bhpkd->bhpqk', q, k).astype(jnp.float32) * (DIFF_D ** -0.5)
    p = jax.nn.softmax(s, axis=-1)
    a = (p[:, :, 0] - lam * p[:, :, 1]).astype(v.dtype)
    return jnp.einsum('bhqk,bhke->bhqe', a, v)


def diff_attention_group(dq, dk, dv, cdq, cdk, cdv, qk_norm_g, lam_params, norm_g, lam_init, cos, sin, with_ctx_out):
    def qk_heads(t, g):
        b_, l_, _ = t.shape
        t = t.reshape(b_, l_, DIFF_HEADS, 2, DIFF_D).transpose(0, 2, 3, 1, 4)
        return rms_norm(t, g)

    q = apply_rope(qk_heads(dq, qk_norm_g[0]), cos, sin)
    k = apply_rope(qk_heads(dk, qk_norm_g[1]), cos, sin)
    v = heads(dv, DIFF_HEADS)
    kc = qk_heads(cdk, qk_norm_g[1])
    vc = heads(cdv, DIFF_HEADS)
    lp = lam_params.astype(jnp.float32)
    lam = jnp.exp(jnp.sum(lp[0] * lp[1])) - jnp.exp(jnp.sum(lp[2] * lp[3])) + lam_init
    keys = jnp.concatenate([kc, k], axis=3)
    vals = jnp.concatenate([vc, v], axis=2)
    b, h, _, l, d = q.shape
    nb = l // Q_BLOCK
    q_blocks = jnp.moveaxis(q.reshape(b, h, 2, nb, Q_BLOCK, d), 3, 0)
    y = lax.map(lambda qb: diff_softmax_attend(qb, keys, vals, lam), q_blocks)
    y = jnp.moveaxis(y, 0, 2).reshape(b, h, l, DIFF_DV)
    g_norm = norm_g[:, None, :]
    out = merge_heads(rms_norm(y, g_norm) * (1.0 - lam_init))
    ctx_out = None
    if with_ctx_out:
        qc = qk_heads(cdq, qk_norm_g[0])
        yc = diff_softmax_attend(qc, kc, vc, lam)
        ctx_out = merge_heads(rms_norm(yc, g_norm) * (1.0 - lam_init))
    return out, ctx_out


def peer_ffn(h, w_query, sub_keys, expert_u, expert_v):
    b, l, d = h.shape
    tokens = h.reshape(-1, PEER_BLOCK, d)

    def block_fn(hb):
        t = hb.shape[0]
        q = (hb @ w_query).reshape(t, PEER_HEADS, 2, PEER_HALF)
        s = jnp.einsum('thpc,hpnc->thpn', q, sub_keys).astype(jnp.float32)
        v1, i1 = lax.top_k(s[:, :, 0], PEER_TOPK)
        v2, i2 = lax.top_k(s[:, :, 1], PEER_TOPK)
        cand = (v1[..., :, None] + v2[..., None, :]).reshape(t, PEER_HEADS, PEER_TOPK * PEER_TOPK)
        cand_idx = (i1[..., :, None] * PEER_NKEYS + i2[..., None, :]).reshape(t, PEER_HEADS, PEER_TOPK * PEER_TOPK)
        best, pos = lax.top_k(cand, PEER_TOPK)
        experts = jnp.take_along_axis(cand_idx, pos, axis=-1)
        gate = jax.nn.softmax(best, axis=-1).astype(hb.dtype)
        u = expert_u[experts]
        vsel = expert_v[experts]
        act = jax.nn.gelu(jnp.einsum('thkd,td->thk', u, hb), approximate=False)
        return jnp.einsum('thk,thkd->td', gate * act, vsel)

    return lax.map(block_fn, tokens).reshape(b, l, d)


def setup_inputs(seed: int = 0) -> dict:
    key = jax.random.key(seed)
    ks = jax.random.split(key, 20)
    nrm = lambda k, shape, s: jax.random.normal(k, shape, jnp.float32) * s
    L = DEPTH
    D = D_MODEL
    decay_init = jnp.asarray(np.log(2.0 ** (5 + np.arange(RET_HEADS)) - 1.0).astype(np.float32))
    return {
        "x": nrm(ks[0], (BATCH, SEQ, D), 1.0),
        "c": nrm(ks[1], (BATCH, D), 1.0),
        "ctx": nrm(ks[2], (BATCH, CTX_LEN, D), 1.0),
        "c_ctx": nrm(ks[3], (D,), 1.0),
        "w_mod": nrm(ks[4], (L, D, N_MOD * D), 0.5 * D ** -0.5),
        "b_mod": nrm(ks[5], (L, N_MOD * D), 0.02),
        "norm1_g": 1.0 + nrm(ks[6], (L, D), 0.02),
        "norm2_g": 1.0 + nrm(ks[7], (L, D), 0.02),
        "w_in": nrm(ks[8], (L, D, IN_COLS), D ** -0.5),
        "ret_decay_logit": decay_init[None, None, :] + nrm(ks[9], (L, 2, RET_HEADS), 0.1),
        "ret_norm_g": 1.0 + nrm(ks[10], (L, RET_HEADS, RET_DV), 0.02),
        "diff_qk_norm_g": 1.0 + nrm(ks[11], (L, 2, DIFF_D), 0.02),
        "diff_lambda": nrm(ks[12], (L, 4, DIFF_D), 0.1),
        "diff_norm_g": 1.0 + nrm(ks[13], (L, DIFF_HEADS, DIFF_DV), 0.02),
        "w_out": nrm(ks[14], (L, MIX_WIDTH, D), MIX_WIDTH ** -0.5),
        "peer_w_query": nrm(ks[15], (L, D, PEER_HEADS * PEER_QDIM), D ** -0.5),
        "peer_sub_keys": nrm(ks[16], (L, PEER_HEADS, 2, PEER_NKEYS, PEER_HALF), PEER_HALF ** -0.5),
        "peer_u": nrm(ks[17], (L, PEER_N_EXPERTS, D), D ** -0.5),
        "peer_v": nrm(ks[18], (L, PEER_N_EXPERTS, D), (PEER_HEADS * PEER_TOPK) ** -0.5),
    }


def reference(x, c, ctx, c_ctx, w_mod, b_mod, norm1_g, norm2_g, w_in, ret_decay_logit, ret_norm_g, diff_qk_norm_g, diff_lambda, diff_norm_g, w_out, peer_w_query, peer_sub_keys, peer_u, peer_v):
    rows = x.shape[1] // GRID_W
    cos, sin = axial_rope_tables(rows, ROPE_DIM, x.dtype)
    for layer in range(DEPTH):
        last = layer == DEPTH - 1
        lam_init = 0.8 - 0.6 * math.exp(-0.3 * layer)
        mod = adaln_params(c, w_mod[layer], b_mod[layer])
        mod_c = adaln_params(c_ctx[None, :], w_mod[layer], b_mod[layer])
        h = modulate(x, norm1_g[layer], mod[:, 0], mod[:, 1])
        hc = modulate(ctx, norm1_g[layer], mod_c[:, 0], mod_c[:, 1])
        rq, rk, rv, rg, dq, dk, dv = jnp.split(h @ w_in[layer], IN_SPLITS, axis=-1)
        crq, crk, crv, crg, cdq, cdk, cdv = jnp.split(hc @ w_in[layer], IN_SPLITS, axis=-1)
        ret_lat, ret_ctx = retention_group(rq, rk, rv, rg, crq, crk, crv, crg, ret_decay_logit[layer], ret_norm_g[layer], cos, sin, not last)
        diff_lat, diff_ctx = diff_attention_group(dq, dk, dv, cdq, cdk, cdv, diff_qk_norm_g[layer], diff_lambda[layer], diff_norm_g[layer], lam_init, cos, sin, not last)
        x = x + mod[:, 2] * (jnp.concatenate([ret_lat, diff_lat], axis=-1) @ w_out[layer])
        h2 = modulate(x, norm2_g[layer], mod[:, 3], mod[:, 4])
        x = x + mod[:, 5] * peer_ffn(h2, peer_w_query[layer], peer_sub_keys[layer], peer_u[layer], peer_v[layer])
        if not last:
            ctx = ctx + mod_c[:, 2] * (jnp.concatenate([ret_ctx, diff_ctx], axis=-1) @ w_out[layer])
            hc2 = modulate(ctx, norm2_g[layer], mod_c[:, 3], mod_c[:, 4])
            ctx = ctx + mod_c[:, 5] * peer_ffn(hc2, peer_w_query[layer], peer_sub_keys[layer], peer_u[layer], peer_v[layer])
    return x
```

```cpp
#include <hip/hip_runtime.h>
#include <stdint.h>
#include <math.h>

namespace nv {
constexpr int D = 1024, NB = 8, L = 2048, CT = 256, LT = L + CT, INC = 3072;
constexpr int NMODC = 6 * D;
constexpr float EPS = 1e-6f;

__global__ void __launch_bounds__(256) k_mod(const float* __restrict__ c, const float* __restrict__ cctx, const float* __restrict__ w_mod,
                                             const float* __restrict__ b_mod, float* __restrict__ mod) {
    __shared__ float s[9][D];
    for (int i = threadIdx.x; i < 9 * D; i += 256) {
        const int r = i / D, k = i % D;
        const float v = r < 8 ? c[r * D + k] : cctx[k];
        s[r][k] = v / (1.f + expf(-v));
    }
    __syncthreads();
    const int j = blockIdx.x * 256 + threadIdx.x;
    float acc[9];
#pragma unroll
    for (int r = 0; r < 9; ++r) acc[r] = 0.f;
    for (int k = 0; k < D; ++k) {
        const float w = w_mod[(size_t)k * NMODC + j];
#pragma unroll
        for (int r = 0; r < 9; ++r) acc[r] += s[r][k] * w;
    }
#pragma unroll
    for (int r = 0; r < 9; ++r) mod[r * NMODC + j] = acc[r] + b_mod[j];
}

__global__ void k_rope_tab(float* __restrict__ tab) {
    const int idx = blockIdx.x * blockDim.x + threadIdx.x;
    if (idx >= L * 32) return;
    const int l = idx / 32, a = (idx % 32) / 16, i = idx % 16;
    const float f = powf(10000.f, -(float)i / 16.f);
    const float pos = a == 0 ? (float)(l / 64) : (float)(l % 64);
    const float ang = pos * f;
    tab[l * 64 + a * 16 + i] = cosf(ang);
    tab[l * 64 + 32 + a * 16 + i] = sinf(ang);
}

__device__ __forceinline__ float block_sum_256(float v, float* red) {
#pragma unroll
    for (int o = 32; o > 0; o >>= 1) v += __shfl_xor(v, o);
    const int w = threadIdx.x >> 6;
    __syncthreads();
    if ((threadIdx.x & 63) == 0) red[w] = v;
    __syncthreads();
    return red[0] + red[1] + red[2] + red[3];
}

__global__ void __launch_bounds__(256) k_modulate(const float* __restrict__ x, const float* __restrict__ ctx, const float* __restrict__ g,
                                                  const float* __restrict__ mod, int b, int shift_idx, int scale_idx, int ntok_ctx,
                                                  float* __restrict__ h) {
    __shared__ float red[4];
    const int tok = blockIdx.x;
    const float* src = tok < ntok_ctx ? ctx + ((size_t)b * CT + tok) * D : x + ((size_t)b * L + (tok - ntok_ctx)) * D;
    const float* mrow = mod + (size_t)(tok < ntok_ctx ? 8 : b) * NMODC;
    float v[4]; float ss = 0.f;
#pragma unroll
    for (int j = 0; j < 4; ++j) { v[j] = src[threadIdx.x + 256 * j]; ss += v[j] * v[j]; }
    const float tot = block_sum_256(ss, red);
    const float rstd = rsqrtf(tot / (float)D + EPS);
#pragma unroll
    for (int j = 0; j < 4; ++j) {
        const int k = threadIdx.x + 256 * j;
        const float y = v[j] * rstd * g[k];
        h[(size_t)tok * D + k] = y * (1.f + mrow[scale_idx * D + k]) + mrow[shift_idx * D + k];
    }
}

__global__ void __launch_bounds__(256) k_gemm(const float* __restrict__ A, const float* __restrict__ W, float* __restrict__ C, int M, int N, int K) {
    __shared__ float As[16][68];
    __shared__ float Bs[16][68];
    const int tx = threadIdx.x & 15, ty = threadIdx.x >> 4;
    const int m0 = blockIdx.y * 64, n0 = blockIdx.x * 64;
    float acc[4][4];
#pragma unroll
    for (int i = 0; i < 4; ++i)
#pragma unroll
        for (int j = 0; j < 4; ++j) acc[i][j] = 0.f;
    for (int k0 = 0; k0 < K; k0 += 16) {
#pragma unroll
        for (int i = 0; i < 4; ++i) {
            const int e = threadIdx.x + 256 * i; const int r = e / 16, kk = e % 16;
            As[kk][r] = A[(size_t)(m0 + r) * K + k0 + kk];
        }
#pragma unroll
        for (int i = 0; i < 4; ++i) {
            const int e = threadIdx.x + 256 * i; const int kk = e / 64, cc = e % 64;
            Bs[kk][cc] = W[(size_t)(k0 + kk) * N + n0 + cc];
        }
        __syncthreads();
#pragma unroll
        for (int kk = 0; kk < 16; ++kk) {
            float a[4], bb[4];
#pragma unroll
            for (int i = 0; i < 4; ++i) a[i] = As[kk][ty * 4 + i];
#pragma unroll
            for (int j = 0; j < 4; ++j) bb[j] = Bs[kk][tx * 4 + j];
#pragma unroll
            for (int i = 0; i < 4; ++i)
#pragma unroll
                for (int j = 0; j < 4; ++j) acc[i][j] += a[i] * bb[j];
        }
        __syncthreads();
    }
#pragma unroll
    for (int i = 0; i < 4; ++i)
#pragma unroll
        for (int j = 0; j < 4; ++j) C[(size_t)(m0 + ty * 4 + i) * N + n0 + tx * 4 + j] = acc[i][j];
}

__device__ __forceinline__ float rope_elem(const float* v64, int d, const float* tabl) {
    const int a = d >> 5, i = d & 15; const bool second = (d & 16) != 0;
    const float cs = tabl[a * 16 + i], sn = tabl[32 + a * 16 + i];
    const float xv = v64[d];
    return second ? xv * cs + v64[d - 16] * sn : xv * cs - v64[d + 16] * sn;
}
__global__ void __launch_bounds__(256) k_post(const float* __restrict__ proj, const float* __restrict__ tab, const float* __restrict__ qkg,
                                              float* __restrict__ RQ, float* __restrict__ RK, float* __restrict__ RV, float* __restrict__ RG,
                                              float* __restrict__ DQ, float* __restrict__ DK, float* __restrict__ DV) {
    __shared__ float p[INC];
    __shared__ float rs[16];
    const int tok = blockIdx.x;
    const bool isctx = tok < CT; const int l = tok - CT;
    for (int i = threadIdx.x; i < INC; i += 256) p[i] = proj[(size_t)tok * INC + i];
    __syncthreads();
    if (threadIdx.x < 16) {
        const int gi = threadIdx.x; const float* v = p + (gi < 8 ? 1536 + gi * 64 : 2048 + (gi - 8) * 64);
        float s = 0.f; for (int d = 0; d < 64; ++d) s += v[d] * v[d];
        rs[gi] = rsqrtf(s / 64.f + EPS);
    }
    __syncthreads();
    for (int i = threadIdx.x; i < 1024; i += 256) {
        const int gi = i / 64, d = i % 64;
        p[1536 + i] = p[1536 + i] * rs[gi] * qkg[(gi < 8 ? 0 : 64) + d];
    }
    __syncthreads();
    const float* tabl = tab + (size_t)(isctx ? 0 : l) * 64;
    {
        const int i = threadIdx.x; const int hh = i / 64, d = i % 64;
        if (!isctx) RQ[((size_t)hh * L + l) * 64 + d] = rope_elem(p + hh * 64, d, tabl);
        const float kv = isctx ? p[256 + i] : rope_elem(p + 256 + hh * 64, d, tabl);
        RK[((size_t)hh * LT + tok) * 64 + d] = kv * 0.125f;
    }
    for (int i = threadIdx.x; i < 512; i += 256) {
        const int hh = i / 128, e = i % 128;
        RV[((size_t)hh * LT + tok) * 128 + e] = p[512 + i];
        if (!isctx) RG[(size_t)l * 512 + i] = p[1024 + i];
        DV[((size_t)hh * LT + tok) * 128 + e] = p[2560 + i];
    }
    for (int i = threadIdx.x; i < 512; i += 256) {
        const int hp = i / 64, d = i % 64;
        if (!isctx) DQ[((size_t)hp * L + l) * 64 + d] = rope_elem(p + 1536 + hp * 64, d, tabl);
        DK[((size_t)hp * LT + tok) * 64 + d] = isctx ? p[2048 + i] : rope_elem(p + 2048 + hp * 64, d, tabl);
    }
}

template <int MODE>
__global__ void __launch_bounds__(256) k_attn(const float* __restrict__ Q, const float* __restrict__ K, const float* __restrict__ V,
                                              float* __restrict__ O, int vshift, const float* __restrict__ decay_logit) {
    __shared__ float Qs[64][65];
    __shared__ float Ks[64][65];
    __shared__ float Vs[64][128];
    __shared__ float Ps[64][65];
    const int hq = blockIdx.y, q0 = blockIdx.x * 64;
    const int r = threadIdx.x >> 2, c4 = threadIdx.x & 3;
    const float* Qh = Q + (size_t)hq * L * 64; const float* Kh = K + (size_t)hq * LT * 64; const float* Vh = V + (size_t)(hq >> vshift) * LT * 128;
    for (int i = threadIdx.x; i < 64 * 64; i += 256) Qs[i / 64][i % 64] = Qh[(size_t)(q0 + i / 64) * 64 + (i % 64)];
    float lgf = 0.f, lgb = 0.f;
    if (MODE == 0) {
        const float a = decay_logit[hq], bb = decay_logit[4 + hq];
        lgf = -log1pf(expf(-a)); lgb = -log1pf(expf(-bb));
    }
    float o[32];
#pragma unroll
    for (int j = 0; j < 32; ++j) o[j] = 0.f;
    float m = -INFINITY, lsum = 0.f;
    const int t = q0 + r;
    for (int kt = 0; kt < LT / 64; ++kt) {
        __syncthreads();
        for (int i = threadIdx.x; i < 64 * 64; i += 256) Ks[i / 64][i % 64] = Kh[(size_t)(kt * 64 + i / 64) * 64 + (i % 64)];
        for (int i = threadIdx.x; i < 64 * 128; i += 256) Vs[i / 128][i % 128] = Vh[(size_t)(kt * 64 + i / 128) * 128 + (i % 128)];
        __syncthreads();
        float s[16];
#pragma unroll
        for (int j = 0; j < 16; ++j) s[j] = 0.f;
        for (int d = 0; d < 64; ++d) {
            const float qv = Qs[r][d];
#pragma unroll
            for (int j = 0; j < 16; ++j) s[j] += qv * Ks[c4 * 16 + j][d];
        }
        if (MODE == 0) {
#pragma unroll
            for (int j = 0; j < 16; ++j) {
                const int jj = kt * 64 + c4 * 16 + j;
                float w;
                if (jj < CT) w = expf((float)(t + CT - jj) * lgf) + expf((float)(L - t + jj) * lgb);
                else { const int jp = jj - CT; w = jp <= t ? expf((float)(t - jp) * lgf) : expf((float)(jp - t) * lgb); }
                Ps[r][c4 * 16 + j] = s[j] * w;
            }
        } else {
            float mx = -INFINITY;
#pragma unroll
            for (int j = 0; j < 16; ++j) { s[j] *= 0.125f; mx = fmaxf(mx, s[j]); }
            mx = fmaxf(mx, __shfl_xor(mx, 1)); mx = fmaxf(mx, __shfl_xor(mx, 2));
            const float mn = fmaxf(m, mx);
            const float alpha = expf(m - mn);
            float ps = 0.f;
#pragma unroll
            for (int j = 0; j < 16; ++j) { const float pv = expf(s[j] - mn); Ps[r][c4 * 16 + j] = pv; ps += pv; }
            ps += __shfl_xor(ps, 1); ps += __shfl_xor(ps, 2);
            lsum = lsum * alpha + ps; m = mn;
#pragma unroll
            for (int j = 0; j < 32; ++j) o[j] *= alpha;
        }
        __syncthreads();
        for (int k = 0; k < 64; ++k) {
            const float pv = Ps[r][k];
#pragma unroll
            for (int j = 0; j < 32; ++j) o[j] += pv * Vs[k][c4 * 32 + j];
        }
    }
    const float inv = MODE == 1 ? 1.f / lsum : 1.f;
#pragma unroll
    for (int j = 0; j < 32; ++j) O[((size_t)hq * L + t) * 128 + c4 * 32 + j] = o[j] * inv;
}

__global__ void __launch_bounds__(256) k_mix(const float* __restrict__ Y, const float* __restrict__ OD, const float* __restrict__ RG,
                                             const float* __restrict__ ret_g, const float* __restrict__ diff_g, const float* __restrict__ lamp,
                                             float* __restrict__ mix) {
    const int l = blockIdx.x; const int w = threadIdx.x >> 6, lane = threadIdx.x & 63;
    float a = lamp[lane] * lamp[64 + lane], b2 = lamp[128 + lane] * lamp[192 + lane];
#pragma unroll
    for (int o = 32; o > 0; o >>= 1) { a += __shfl_xor(a, o); b2 += __shfl_xor(b2, o); }
    const float lam_init = 0.2f;
    const float lam = expf(a) - expf(b2) + lam_init;
    {
        const float y0 = Y[((size_t)w * L + l) * 128 + lane], y1 = Y[((size_t)w * L + l) * 128 + 64 + lane];
        float ss = y0 * y0 + y1 * y1;
#pragma unroll
        for (int o = 32; o > 0; o >>= 1) ss += __shfl_xor(ss, o);
        const float rstd = rsqrtf(ss / 128.f + EPS);
        const float g0 = RG[(size_t)l * 512 + w * 128 + lane], g1 = RG[(size_t)l * 512 + w * 128 + 64 + lane];
        mix[(size_t)l * D + w * 128 + lane] = y0 * rstd * ret_g[w * 128 + lane] * (g0 / (1.f + expf(-g0)));
        mix[(size_t)l * D + w * 128 + 64 + lane] = y1 * rstd * ret_g[w * 128 + 64 + lane] * (g1 / (1.f + expf(-g1)));
    }
    {
        const float* o0 = OD + ((size_t)(w * 2 + 0) * L + l) * 128; const float* o1 = OD + ((size_t)(w * 2 + 1) * L + l) * 128;
        const float y0 = o0[lane] - lam * o1[lane], y1 = o0[64 + lane] - lam * o1[64 + lane];
        float ss = y0 * y0 + y1 * y1;
#pragma unroll
        for (int o = 32; o > 0; o >>= 1) ss += __shfl_xor(ss, o);
        const float rstd = rsqrtf(ss / 128.f + EPS);
        mix[(size_t)l * D + 512 + w * 128 + lane] = y0 * rstd * diff_g[w * 128 + lane] * (1.f - lam_init);
        mix[(size_t)l * D + 512 + w * 128 + 64 + lane] = y1 * rstd * diff_g[w * 128 + 64 + lane] * (1.f - lam_init);
    }
}

__global__ void __launch_bounds__(256) k_resid(const float* __restrict__ x, const float* __restrict__ tmp, const float* __restrict__ gate, float* __restrict__ out, int n) {
    const int i = blockIdx.x * 256 + threadIdx.x;
    if (i < n) out[i] = x[i] + gate[i % D] * tmp[i];
}

__global__ void __launch_bounds__(256) k_modulate2(const float* __restrict__ x1, const float* __restrict__ g, const float* __restrict__ mrow,
                                                   float* __restrict__ h2) {
    __shared__ float red[4];
    const int tok = blockIdx.x;
    const float* src = x1 + (size_t)tok * D;
    float v[4]; float ss = 0.f;
#pragma unroll
    for (int j = 0; j < 4; ++j) { v[j] = src[threadIdx.x + 256 * j]; ss += v[j] * v[j]; }
    const float tot = block_sum_256(ss, red);
    const float rstd = rsqrtf(tot / (float)D + EPS);
#pragma unroll
    for (int j = 0; j < 4; ++j) {
        const int k = threadIdx.x + 256 * j;
        const float y = v[j] * rstd * g[k];
        h2[(size_t)tok * D + k] = y * (1.f + mrow[4 * D + k]) + mrow[3 * D + k];
    }
}

__global__ void __launch_bounds__(128) k_peer_select(const float* __restrict__ q, const float* __restrict__ subk, int* __restrict__ pidx, float* __restrict__ pgate) {
    __shared__ float qs[256];
    __shared__ float sc[2][128];
    __shared__ float tv[2][16];
    __shared__ int ti[2][16];
    __shared__ float cv[256];
    __shared__ float bv[16];
    __shared__ int bi[16];
    const int tok = blockIdx.x, hh = blockIdx.y, n = threadIdx.x;
    qs[n] = q[(size_t)tok * 2048 + hh * 256 + n]; qs[128 + n] = q[(size_t)tok * 2048 + hh * 256 + 128 + n];
    __syncthreads();
#pragma unroll
    for (int p = 0; p < 2; ++p) {
        const float* kr = subk + (((size_t)hh * 2 + p) * 128 + n) * 128;
        float s = 0.f;
        for (int c = 0; c < 128; ++c) s += qs[p * 128 + c] * kr[c];
        sc[p][n] = s;
    }
    __syncthreads();
#pragma unroll
    for (int p = 0; p < 2; ++p) {
        const float mine = sc[p][n]; int rank = 0;
        for (int m2 = 0; m2 < 128; ++m2) { const float o = sc[p][m2]; rank += (o > mine || (o == mine && m2 < n)) ? 1 : 0; }
        if (rank < 16) { tv[p][rank] = mine; ti[p][rank] = n; }
    }
    __syncthreads();
    for (int cidx = n; cidx < 256; cidx += 128) cv[cidx] = tv[0][cidx / 16] + tv[1][cidx % 16];
    __syncthreads();
    for (int cidx = n; cidx < 256; cidx += 128) {
        const float mine = cv[cidx]; int rank = 0;
        for (int m2 = 0; m2 < 256; ++m2) { const float o = cv[m2]; rank += (o > mine || (o == mine && m2 < cidx)) ? 1 : 0; }
        if (rank < 16) { bv[rank] = mine; bi[rank] = ti[0][cidx / 16] * 128 + ti[1][cidx % 16]; }
    }
    __syncthreads();
    if (n < 16) {
        const float mx = bv[0]; float sum = 0.f;
        for (int k = 0; k < 16; ++k) sum += expf(bv[k] - mx);
        pidx[((size_t)tok * 8 + hh) * 16 + n] = bi[n];
        pgate[((size_t)tok * 8 + hh) * 16 + n] = expf(bv[n] - mx) / sum;
    }
}

__global__ void __launch_bounds__(256) k_peer_gather(const float* x1, const float* __restrict__ h2, const int* __restrict__ pidx, const float* __restrict__ pgate,
                                                     const float* __restrict__ pu, const float* __restrict__ pv, const float* __restrict__ gate2, float* out) {
    __shared__ float4 part[4][256];
    const int tok = blockIdx.x, w = threadIdx.x >> 6, lane = threadIdx.x & 63;
    float4 hv[4], acc[4];
#pragma unroll
    for (int j = 0; j < 4; ++j) { hv[j] = *(const float4*)(h2 + (size_t)tok * D + j * 256 + lane * 4); acc[j] = make_float4(0.f, 0.f, 0.f, 0.f); }
    for (int e = 0; e < 32; ++e) {
        const int slot = w * 32 + e;
        const int ex = pidx[(size_t)tok * 128 + slot]; const float gt = pgate[(size_t)tok * 128 + slot];
        const float* ur = pu + (size_t)ex * D; const float* vr = pv + (size_t)ex * D;
        float dsum = 0.f;
#pragma unroll
        for (int j = 0; j < 4; ++j) { const float4 u4 = *(const float4*)(ur + j * 256 + lane * 4); dsum += u4.x * hv[j].x + u4.y * hv[j].y + u4.z * hv[j].z + u4.w * hv[j].w; }
#pragma unroll
        for (int o = 32; o > 0; o >>= 1) dsum += __shfl_xor(dsum, o);
        const float act = 0.5f * dsum * (1.f + erff(dsum * 0.70710678118654752f));
        const float wgt = gt * act;
#pragma unroll
        for (int j = 0; j < 4; ++j) { const float4 v4 = *(const float4*)(vr + j * 256 + lane * 4); acc[j].x += wgt * v4.x; acc[j].y += wgt * v4.y; acc[j].z += wgt * v4.z; acc[j].w += wgt * v4.w; }
    }
#pragma unroll
    for (int j = 0; j < 4; ++j) part[w][j * 64 + lane] = acc[j];
    __syncthreads();
    {
        const int i = threadIdx.x;
        const float4 a = part[0][i], b = part[1][i], c2 = part[2][i], d2 = part[3][i];
        const int off = (i / 64) * 256 + (i % 64) * 4;
        const float4 xv = *(const float4*)(x1 + (size_t)tok * D + off);
        const float4 g = *(const float4*)(gate2 + off);
        float4 r;
        r.x = xv.x + g.x * (a.x + b.x + c2.x + d2.x); r.y = xv.y + g.y * (a.y + b.y + c2.y + d2.y);
        r.z = xv.z + g.z * (a.z + b.z + c2.z + d2.z); r.w = xv.w + g.w * (a.w + b.w + c2.w + d2.w);
        *(float4*)(out + (size_t)tok * D + off) = r;
    }
}
}

extern "C" void kernel_launch(void* const* d_in, const int* in_sizes, int n_in, void* d_out, int out_size, void* d_ws, size_t ws_size, hipStream_t stream) {
    using namespace nv;
    const float* x = (const float*)d_in[0]; const float* c = (const float*)d_in[1]; const float* ctx = (const float*)d_in[2]; const float* cctx = (const float*)d_in[3];
    const float* w_mod = (const float*)d_in[4]; const float* b_mod = (const float*)d_in[5]; const float* g1 = (const float*)d_in[6]; const float* g2 = (const float*)d_in[7];
    const float* w_in = (const float*)d_in[8]; const float* decay = (const float*)d_in[9]; const float* ret_g = (const float*)d_in[10]; const float* qkg = (const float*)d_in[11];
    const float* lamp = (const float*)d_in[12]; const float* diff_g = (const float*)d_in[13]; const float* w_out = (const float*)d_in[14]; const float* wq = (const float*)d_in[15];
    const float* subk = (const float*)d_in[16]; const float* pu = (const float*)d_in[17]; const float* pv = (const float*)d_in[18];
    float* out = (float*)d_out;
    float* ws = (float*)d_ws; size_t off = 0;
    auto take = [&](size_t n) { float* p = ws + off; off += (n + 63) & ~(size_t)63; return p; };
    float* mod = take(9 * NMODC); float* tab = take((size_t)L * 64);
    float* h = take((size_t)LT * D); float* proj = take((size_t)LT * INC);
    float* RQ = take((size_t)4 * L * 64); float* RK = take((size_t)4 * LT * 64); float* RV = take((size_t)4 * LT * 128); float* RG = take((size_t)L * 512);
    float* DQ = take((size_t)8 * L * 64); float* DK = take((size_t)8 * LT * 64); float* DV = take((size_t)4 * LT * 128);
    float* Y = take((size_t)4 * L * 128); float* OD = take((size_t)8 * L * 128); float* mix = take((size_t)L * D); float* tmp = take((size_t)L * D);
    float* h2 = take((size_t)L * D); float* q = take((size_t)L * 2048); int* pidx = (int*)take((size_t)L * 128); float* pgate = take((size_t)L * 128);
    (void)ws_size; (void)in_sizes; (void)n_in; (void)out_size;

    k_mod<<<NMODC / 256, 256, 0, stream>>>(c, cctx, w_mod, b_mod, mod);
    k_rope_tab<<<(L * 32 + 255) / 256, 256, 0, stream>>>(tab);
    for (int b = 0; b < NB; ++b) {
        float* x1 = out + (size_t)b * L * D;
        k_modulate<<<LT, 256, 0, stream>>>(x, ctx, g1, mod, b, 0, 1, CT, h);
        k_gemm<<<dim3(INC / 64, LT / 64), 256, 0, stream>>>(h, w_in, proj, LT, INC, D);
        k_post<<<LT, 256, 0, stream>>>(proj, tab, qkg, RQ, RK, RV, RG, DQ, DK, DV);
        k_attn<0><<<dim3(L / 64, 4), 256, 0, stream>>>(RQ, RK, RV, Y, 0, decay);
        k_attn<1><<<dim3(L / 64, 8), 256, 0, stream>>>(DQ, DK, DV, OD, 1, nullptr);
        k_mix<<<L, 256, 0, stream>>>(Y, OD, RG, ret_g, diff_g, lamp, mix);
        k_gemm<<<dim3(D / 64, L / 64), 256, 0, stream>>>(mix, w_out, tmp, L, D, D);
        k_resid<<<L * D / 256, 256, 0, stream>>>(x + (size_t)b * L * D, tmp, mod + (size_t)b * NMODC + 2 * D, x1, L * D);
        k_modulate2<<<L, 256, 0, stream>>>(x1, g2, mod + (size_t)b * NMODC, h2);
        k_gemm<<<dim3(2048 / 64, L / 64), 256, 0, stream>>>(h2, wq, q, L, 2048, D);
        k_peer_select<<<dim3(L, 8), 128, 0, stream>>>(q, subk, pidx, pgate);
        k_peer_gather<<<L, 256, 0, stream>>>(x1, h2, pidx, pgate, pu, pv, mod + (size_t)b * NMODC + 5 * D, x1);
    }
}
```

```cpp
#include <hip/hip_runtime.h>
#include <cstdio>
#include <cstdint>
#include <math.h>
#define GAS __attribute__((address_space(1)))
#define LAS __attribute__((address_space(3)))
typedef unsigned short bf16;
typedef unsigned v4u __attribute__((ext_vector_type(4)));
typedef unsigned v2u __attribute__((ext_vector_type(2)));
typedef float f32x4 __attribute__((ext_vector_type(4)));
typedef float f32x16 __attribute__((ext_vector_type(16)));
typedef short bf16x8 __attribute__((ext_vector_type(8)));
typedef short s16x4 __attribute__((ext_vector_type(4)));
#define LDS_WAIT() asm volatile("s_waitcnt lgkmcnt(0)" ::: "memory")
#define VM_WAIT() asm volatile("s_waitcnt vmcnt(0)" ::: "memory")
__device__ __forceinline__ unsigned f2bf(float f) { unsigned u = __builtin_bit_cast(unsigned, f); return (u + 0x7fffu + ((u >> 16) & 1u)) >> 16; }
__device__ __forceinline__ unsigned pk2(float lo, float hi) { return f2bf(lo) | (f2bf(hi) << 16); }
__device__ __forceinline__ float bf2f(unsigned short h) { return __builtin_bit_cast(float, (unsigned)h << 16); }
__device__ __forceinline__ float wave_sum(float v) {
#pragma unroll
    for (int o = 1; o < 64; o <<= 1) v += __shfl_xor(v, o);
    return v;
}
#define XB_TMO      128
#define XB_XCNT(j)  (256  + 64 * (j))
#define XB_XSUB(j)  (1280 + 64 * (j))
#define XB_XGEN(j)  (2304 + 64 * (j))
#define XB_TOP      3328
#define XB_TOPGEN   3392
#define XCD_BAR_WORDS 3456
#define XB_SPIN_CAP (1u << 18)

__device__ __forceinline__ unsigned xb_ld(unsigned* p)              { return __hip_atomic_load(p, __ATOMIC_RELAXED, __HIP_MEMORY_SCOPE_AGENT); }
__device__ __forceinline__ unsigned xb_add(unsigned* p, unsigned v) { return __hip_atomic_fetch_add(p, v, __ATOMIC_RELAXED, __HIP_MEMORY_SCOPE_AGENT); }
__device__ __forceinline__ unsigned xb_xcc_id() { return (unsigned)__builtin_amdgcn_s_getreg((3 << 11) | 20) & 0xFu; }
#define XB_SPIN(cond, bar) do { unsigned _sp = 0; while (cond) { __builtin_amdgcn_s_sleep(1); \
    if ((++_sp & 255u) == 0u) { if (xb_ld(&(bar)[XB_TMO])) break; if (_sp > XB_SPIN_CAP) { atomicAdd(&(bar)[XB_TMO], 1u); break; } } } } while (0)

struct XcdBarrier {
    unsigned* bar; unsigned x;
    volatile LAS unsigned* st;
};

__device__ __forceinline__ XcdBarrier xcd_barrier_post(unsigned* bar, volatile LAS unsigned* st) {
    XcdBarrier b; b.bar = bar; b.x = xb_xcc_id(); b.st = st;
    if (threadIdx.x == 0) (void)xb_add(&bar[XB_XCNT(b.x)], 1u);
    return b;
}
__device__ __forceinline__ void xcd_barrier_complete(unsigned* bar, unsigned x, unsigned& nloc, unsigned& nx) {
    const unsigned G = gridDim.x * gridDim.y * gridDim.z;
    unsigned sum, cnt, mine, sp = 0u;
    for (;;) {
        sum = 0u; cnt = 0u; mine = 0u;
#pragma unroll
        for (unsigned j = 0; j < 16; ++j) { const unsigned c = xb_ld(&bar[XB_XCNT(j)]); sum += c; cnt += (c > 0u) ? 1u : 0u; mine = (j == x) ? c : mine; }
        if (sum == G) break;
        __builtin_amdgcn_s_sleep(1);
        if ((++sp & 255u) == 0u) { if (xb_ld(&bar[XB_TMO])) break; if (sp > XB_SPIN_CAP) { atomicAdd(&bar[XB_TMO], 1u); break; } }
    }
    nloc = mine > 0u ? mine : 1u; nx = cnt > 0u ? cnt : 1u;
}

__device__ __forceinline__ void xcd_barrier(const XcdBarrier& b) {
    asm volatile("s_waitcnt vmcnt(0)" ::: "memory");
    __syncthreads();
    if (threadIdx.x == 0) {
        unsigned* bar = b.bar;
        __builtin_amdgcn_s_waitcnt(0);
        unsigned nloc = b.st[0], nx = b.st[1];
        if (nloc == 0u) { xcd_barrier_complete(bar, b.x, nloc, nx); b.st[0] = nloc; b.st[1] = nx; }
        const unsigned old = xb_add(&bar[XB_XSUB(b.x)], 1u);
        const unsigned gen = old / nloc;
        if (old + 1u == (gen + 1u) * nloc) {
            __builtin_amdgcn_fence(__ATOMIC_RELEASE, "agent");
            asm volatile("s_waitcnt vmcnt(0)" ::: "memory");
            const unsigned og = xb_add(&bar[XB_TOP], 1u);
            const unsigned tg = og / nx;
            if (og + 1u == (tg + 1u) * nx) xb_add(&bar[XB_TOPGEN], 1u);
            else XB_SPIN(xb_ld(&bar[XB_TOPGEN]) == tg, bar);
            __builtin_amdgcn_fence(__ATOMIC_ACQUIRE, "agent");
            xb_add(&bar[XB_XGEN(b.x)], 1u);
            asm volatile("s_waitcnt vmcnt(0)" ::: "memory");
        } else {
            XB_SPIN(xb_ld(&bar[XB_XGEN(b.x)]) == gen, bar);
            __builtin_amdgcn_fence(__ATOMIC_ACQUIRE, "agent");
            asm volatile("s_waitcnt vmcnt(0)" ::: "memory");
        }
    }
    __syncthreads();
}
namespace pg8 {
#define PG8_LAS __attribute__((address_space(3)))
typedef unsigned short bf16_t;
typedef short bf16x8 __attribute__((ext_vector_type(8)));
typedef float f32x4 __attribute__((ext_vector_type(4)));
typedef unsigned u32x4 __attribute__((ext_vector_type(4)));
constexpr int BM = 256, BK = 64, HALF = 128, HTB = HALF * BK * 2  , STAGE_BYTES = 8 * HTB, NXCD = 8, WGM = 8;

__host__ __device__ __forceinline__ int lds_byte(int r, int c) { const int st = (r >> 4) * 2 + (c >> 5), rr = r & 15, cc = c & 31, ob = rr * 64 + cc * 2; return st * 1024 + (ob ^ (((ob >> 9) & 1) << 5)); }
__host__ __device__ __forceinline__ void stage_rc(int b, int& R, int& C) { const int st = b / 1024, sb = b % 1024, swz = sb ^ (((sb >> 9) & 1) << 5); R = (st >> 1) * 16 + swz / 64; C = (st & 1) * 32 + (swz % 64) / 2; }
__host__ __device__ __forceinline__ int perm32(int rho) { const int n = rho >> 4, i = rho & 15; return 8 * (i >> 2) + 4 * n + (i & 3); }

struct Unit { int pm, pn; };
struct Gemm { const bf16_t* A; const bf16_t* Bt; int M, N, K; };

struct StaticOrder {
    int nM, nN, nwg, G, c;
    __host__ __device__ void init(int M, int N, int G_, int c_) { nM = M / BM; nN = N / BM; nwg = nM * nN; G = G_; c = c_; }
    __host__ __device__ bool next(int i, Unit& u) const {
        const long L = (long)i * G + c; if (L >= nwg) return false;
        int wgid = (int)L; { const int q = nwg / NXCD, r = nwg % NXCD, xcd = wgid % NXCD, off = wgid / NXCD; wgid = (xcd < r ? xcd * (q + 1) : r * (q + 1) + (xcd - r) * q) + off; }
        const int nig = WGM * nN, gid = wgid / nig, fm = gid * WGM, gsz = (nM - fm) < WGM ? (nM - fm) : WGM;
        u.pm = fm + ((wgid % nig) % gsz); u.pn = (wgid % nig) / gsz; return true;
    }
    __device__ __forceinline__ void a_ready(const Unit&) const {}
    __device__ __forceinline__ void done(const Unit&) const {}
};

__device__ __forceinline__ unsigned cvt_pk_bf16(float lo, float hi) { unsigned r; asm volatile("v_cvt_pk_bf16_f32 %0, %1, %2" : "=v"(r) : "v"(lo), "v"(hi)); return r; }
typedef float f32x2 __attribute__((ext_vector_type(2)));
__device__ __forceinline__ f32x2 gelu_pk(f32x2 v) {
    const f32x2 av = __builtin_elementwise_abs(v), d = av * 0.2316418882f + 1.0f;
    f32x2 t; t.x = __builtin_amdgcn_rcpf(d.x); t.y = __builtin_amdgcn_rcpf(d.y);
    f32x2 q = t * 0.5307027145f + (-0.7265760135f); q = q * t + 0.7107068705f; q = q * t + (-0.142248368f); q = q * t + 0.127414796f; q = q * t;
    const f32x2 s = (v * v) * (-0.72134752044f);
    f32x2 e; e.x = __builtin_amdgcn_exp2f(s.x); e.y = __builtin_amdgcn_exp2f(s.y);
    const f32x2 m = v * (q * e), r = v - m;
    f32x2 o; o.x = v.x < 0.f ? m.x : r.x; o.y = v.y < 0.f ? m.y : r.y; return o;
}

template <int ACT  > struct EpiBf16 {
    static constexpr bool PERM = true, AFTER_DRAIN = false; static_assert(ACT == 0 || ACT == 1, "EpiBf16: ACT is 0 (none) or 1 (gelu_pk)");
    bf16_t* O; int ldc; const float* bias; int split_cols; size_t split_stride; float scale0;
    __device__ __forceinline__ void operator()(const f32x4 (&acc)[2][2][4][2], const Unit& u, int wr, int wc, int fr, int fq) const {
        const int row0 = u.pm * BM + wr * 64 + fr; int colt = u.pn * BM; bf16_t* base = O;
        float sc = 1.f; if (split_cols) { const int t = colt / split_cols; base += (size_t)t * split_stride; colt -= t * split_cols; if (t == 0) sc = scale0; }
        const int col0 = colt + wc * 32 + 8 * fq, bcol0 = u.pn * BM + wc * 32 + 8 * fq;
        f32x4 bv[2][2];
#pragma unroll
        for (int bj = 0; bj < 2; ++bj)
#pragma unroll
            for (int n = 0; n < 2; ++n) bv[bj][n] = bias ? *(const f32x4*)(bias + bcol0 + bj * HALF + 4 * n) : (f32x4){0.f, 0.f, 0.f, 0.f};
#pragma unroll
        for (int ai = 0; ai < 2; ++ai)
#pragma unroll
            for (int m = 0; m < 4; ++m) { bf16_t* rowp = base + (size_t)(row0 + ai * HALF + m * 16) * ldc + col0;
#pragma unroll
                for (int bj = 0; bj < 2; ++bj) { f32x4 v0 = acc[ai][bj][m][0] + bv[bj][0], v1 = acc[ai][bj][m][1] + bv[bj][1];
                    if (ACT == 1) { f32x2 a = gelu_pk((f32x2){v0[0], v0[1]}), b = gelu_pk((f32x2){v0[2], v0[3]}), c = gelu_pk((f32x2){v1[0], v1[1]}), d = gelu_pk((f32x2){v1[2], v1[3]});
                        v0 = (f32x4){a.x, a.y, b.x, b.y}; v1 = (f32x4){c.x, c.y, d.x, d.y}; }
                    v0 = v0 * sc; v1 = v1 * sc; u32x4 w; w.x = cvt_pk_bf16(v0[0], v0[1]); w.y = cvt_pk_bf16(v0[2], v0[3]); w.z = cvt_pk_bf16(v1[0], v1[1]); w.w = cvt_pk_bf16(v1[2], v1[3]);
                    *(u32x4*)(rowp + bj * HALF) = w; } }
    }
};

struct PanelStats {
    unsigned* xbuf;
    unsigned* cnt;
    unsigned* tmo;
    int ntn; float eps;
    unsigned code;
    __device__ __forceinline__ bool run(const f32x4 (&v)[2][2][4][2], const Unit& u, int wr, int wc, int fr, int fq, PG8_LAS unsigned char* lds, int wid, int lane) const {
        typedef float f32x2v __attribute__((ext_vector_type(2)));
        PG8_LAS f32x2v* P = (PG8_LAS f32x2v*)lds;
        PG8_LAS f32x2v* S = (PG8_LAS f32x2v*)(lds + 8192);
        PG8_LAS unsigned* flag = (PG8_LAS unsigned*)(lds + 8192 + 2048);
#pragma unroll
        for (int ai = 0; ai < 2; ++ai)
#pragma unroll
            for (int m = 0; m < 4; ++m) {
                float s = 0.f;
#pragma unroll
                for (int bj = 0; bj < 2; ++bj)
#pragma unroll
                    for (int n = 0; n < 2; ++n) { const f32x4 x = v[ai][bj][m][n]; s += (x[0] + x[1]) + (x[2] + x[3]); }
                s += __shfl_xor(s, 16); s += __shfl_xor(s, 32);
                const float mw = s * (1.0f / 64.0f); float q = 0.f;
#pragma unroll
                for (int bj = 0; bj < 2; ++bj)
#pragma unroll
                    for (int n = 0; n < 2; ++n) { const f32x4 d = v[ai][bj][m][n] - mw; q += (d[0] * d[0] + d[1] * d[1]) + (d[2] * d[2] + d[3] * d[3]); }
                q += __shfl_xor(q, 16); q += __shfl_xor(q, 32);
                if (fq == 0) P[(ai * HALF + wr * 64 + m * 16 + fr) * 4 + wc] = (f32x2v){mw, q};
            }
        asm volatile("s_waitcnt lgkmcnt(0)" ::: "memory"); __builtin_amdgcn_s_barrier(); asm volatile("" ::: "memory");
#if defined(BROKEN_EXCHANGE_NO_WAIT)
#warning BROKEN CONTROL BUILD: the row-statistics exchange does not wait; results are wrong by design
        if (blockIdx.x >= 64) { const long long t0_ = clock64(); while (clock64() - t0_ < 60000) __builtin_amdgcn_s_sleep(8); }
#endif
        const int row = wid * 32 + (lane & 31);
        if (lane < 32) {
            const f32x2v a = P[row * 4 + 0], b = P[row * 4 + 1], c = P[row * 4 + 2], d = P[row * 4 + 3];
            const float mt = (a.x + b.x + c.x + d.x) * 0.25f;
            const float da = a.x - mt, db = b.x - mt, dc = c.x - mt, dd = d.x - mt;
            const float m2 = (a.y + b.y) + (c.y + d.y) + 64.0f * ((da * da + db * db) + (dc * dc + dd * dd));
            unsigned long long* slot = (unsigned long long*)xbuf + ((size_t)(u.pm * BM + row) * 4 + u.pn);
            __hip_atomic_store(slot, ((unsigned long long)__float_as_uint(m2) << 32) | __float_as_uint(mt), __ATOMIC_RELAXED, __HIP_MEMORY_SCOPE_AGENT);
        }
        asm volatile("s_waitcnt vmcnt(0)" ::: "memory");
        if (lane == 0) __hip_atomic_fetch_add(cnt + 64 * u.pm, 1u, __ATOMIC_RELAXED, __HIP_MEMORY_SCOPE_AGENT);
        if (wid == 0) {
            bool dead = false; const unsigned long long t0 = __builtin_amdgcn_s_memrealtime(); const unsigned want = 8u * (unsigned)ntn;
            for (;;) {
#if defined(BROKEN_EXCHANGE_NO_WAIT)
                break;
#endif
                if ((unsigned)__builtin_amdgcn_readfirstlane(__hip_atomic_load(cnt + 64 * u.pm, __ATOMIC_RELAXED, __HIP_MEMORY_SCOPE_AGENT)) >= want) break;
                if (__builtin_amdgcn_s_memrealtime() - t0 > 2000000ull) {
                    if (lane == 0) { unsigned expect = 0u; __hip_atomic_compare_exchange_strong(tmo + 1, &expect, code | (unsigned)(u.pm & 0xff), __ATOMIC_RELAXED, __ATOMIC_RELAXED, __HIP_MEMORY_SCOPE_AGENT);
                                     __hip_atomic_store(tmo, 1u, __ATOMIC_RELAXED, __HIP_MEMORY_SCOPE_AGENT); }
                    dead = true; break; }
                __builtin_amdgcn_s_sleep(2);
            }
            __builtin_amdgcn_fence(__ATOMIC_ACQUIRE, "agent");
            if (lane == 0) flag[0] = dead ? 1u : 0u;
        }
        asm volatile("s_waitcnt vmcnt(0) lgkmcnt(0)" ::: "memory"); __builtin_amdgcn_s_barrier(); asm volatile("" ::: "memory");
        const bool bad = flag[0] != 0u;
        if (lane < 32) {
            const unsigned long long* slot = (const unsigned long long*)xbuf + (size_t)(u.pm * BM + row) * 4; float mt[4], m2[4]; float ms = 0.f;
#pragma unroll
            for (int t = 0; t < 4; ++t) { if (t < ntn) { const unsigned long long w = __hip_atomic_load(slot + t, __ATOMIC_RELAXED, __HIP_MEMORY_SCOPE_AGENT); mt[t] = __uint_as_float((unsigned)w); m2[t] = __uint_as_float((unsigned)(w >> 32)); } else { mt[t] = 0.f; m2[t] = 0.f; } ms += mt[t]; }
            const float mean = ms / (float)ntn; float q = 0.f;
#pragma unroll
            for (int t = 0; t < 4; ++t) if (t < ntn) { const float dm = mt[t] - mean; q += m2[t] + 256.0f * dm * dm; }
            S[row] = (f32x2v){mean, 1.0f / sqrtf(q / (256.0f * (float)ntn) + eps)};
        }
        asm volatile("s_waitcnt lgkmcnt(0)" ::: "memory"); __builtin_amdgcn_s_barrier(); asm volatile("" ::: "memory");
        return bad;
    }
};
struct EpiLnRes {
    static constexpr bool PERM = false, AFTER_DRAIN = true;
    const float* base; float* out; int ldc; const float* bias; PanelStats st; unsigned poison;
    __device__ __forceinline__ void fused(f32x4 (&acc)[2][2][4][2], const Unit& u, int wr, int wc, int fr, int fq, PG8_LAS unsigned char* lds, int wid, int lane) const {
        typedef float f32x2v __attribute__((ext_vector_type(2)));
        const PG8_LAS f32x2v* S = (const PG8_LAS f32x2v*)(lds + 8192);
        const int col0 = u.pn * BM + wc * 32 + 4 * fq;
#pragma unroll
        for (int bj = 0; bj < 2; ++bj)
#pragma unroll
            for (int n = 0; n < 2; ++n) { const f32x4 bv = bias ? *(const f32x4*)(bias + col0 + bj * HALF + n * 16) : (f32x4){0.f, 0.f, 0.f, 0.f};
#pragma unroll
                for (int ai = 0; ai < 2; ++ai)
#pragma unroll
                    for (int m = 0; m < 4; ++m) acc[ai][bj][m][n] += bv; }
        f32x4 pre[4][2][2];
#pragma unroll
        for (int m = 0; m < 4; ++m) { const size_t off = (size_t)(u.pm * BM + wr * 64 + m * 16 + fr) * ldc + col0;
#pragma unroll
            for (int bj = 0; bj < 2; ++bj)
#pragma unroll
                for (int n = 0; n < 2; ++n) pre[m][bj][n] = *(const f32x4*)(base + off + bj * HALF + n * 16); }
        const bool bad = st.run(acc, u, wr, wc, fr, fq, lds, wid, lane) || poison != 0u;
        const float qnan = __builtin_nanf("");
#pragma unroll
        for (int ai = 0; ai < 2; ++ai)
#pragma unroll
            for (int m = 0; m < 4; ++m) { const int r = ai * HALF + wr * 64 + m * 16 + fr; const f32x2v sr = S[r]; const size_t off = (size_t)(u.pm * BM + r) * ldc + col0;
#pragma unroll
                for (int bj = 0; bj < 2; ++bj)
#pragma unroll
                    for (int n = 0; n < 2; ++n) { const f32x4 bs = ai == 0 ? pre[m][bj][n] : *(const f32x4*)(base + off + bj * HALF + n * 16); f32x4 o = bs + (acc[ai][bj][m][n] - sr.x) * sr.y;
                        if (bad) o = (f32x4){qnan, qnan, qnan, qnan}; *(f32x4*)(out + off + bj * HALF + n * 16) = o; }
                if (m & 1) asm volatile("" ::: "memory"); }
    }
};
struct EpiLnResLn {
    static constexpr bool PERM = false, AFTER_DRAIN = true;
    const float* base; float* out; bf16_t* xn; int ldc; const float* bias; PanelStats st1, st2; unsigned poison;
    __device__ __forceinline__ void fused(f32x4 (&acc)[2][2][4][2], const Unit& u, int wr, int wc, int fr, int fq, PG8_LAS unsigned char* lds, int wid, int lane) const {
        typedef float f32x2v __attribute__((ext_vector_type(2))); typedef unsigned u32x2v __attribute__((ext_vector_type(2)));
        const PG8_LAS f32x2v* S = (const PG8_LAS f32x2v*)(lds + 8192);
        const int col0 = u.pn * BM + wc * 32 + 4 * fq;
#pragma unroll
        for (int bj = 0; bj < 2; ++bj)
#pragma unroll
            for (int n = 0; n < 2; ++n) { const f32x4 bv = bias ? *(const f32x4*)(bias + col0 + bj * HALF + n * 16) : (f32x4){0.f, 0.f, 0.f, 0.f};
#pragma unroll
                for (int ai = 0; ai < 2; ++ai)
#pragma unroll
                    for (int m = 0; m < 4; ++m) acc[ai][bj][m][n] += bv; }
        bool bad = st1.run(acc, u, wr, wc, fr, fq, lds, wid, lane) || poison != 0u;
        const float qnan = __builtin_nanf("");
#pragma unroll
        for (int ai = 0; ai < 2; ++ai)
#pragma unroll
            for (int m = 0; m < 4; ++m) { const int r = ai * HALF + wr * 64 + m * 16 + fr; const f32x2v sr = S[r]; const size_t off = (size_t)(u.pm * BM + r) * ldc + col0;
#pragma unroll
                for (int bj = 0; bj < 2; ++bj)
#pragma unroll
                    for (int n = 0; n < 2; ++n) { const f32x4 bs = *(const f32x4*)(base + off + bj * HALF + n * 16); acc[ai][bj][m][n] = bs + (acc[ai][bj][m][n] - sr.x) * sr.y; }
                asm volatile("" : "+v"(acc[ai][0][m][0]), "+v"(acc[ai][0][m][1]), "+v"(acc[ai][1][m][0]), "+v"(acc[ai][1][m][1]));
                if (m & 1) asm volatile("" ::: "memory"); }
        const bool bad1 = bad;
        bad = st2.run(acc, u, wr, wc, fr, fq, lds, wid, lane) || bad;
#pragma unroll
        for (int ai = 0; ai < 2; ++ai)
#pragma unroll
            for (int m = 0; m < 4; ++m) { const int r = ai * HALF + wr * 64 + m * 16 + fr; const f32x2v sr = S[r]; const size_t off = (size_t)(u.pm * BM + r) * ldc + col0;
#pragma unroll
                for (int bj = 0; bj < 2; ++bj)
#pragma unroll
                    for (int n = 0; n < 2; ++n) { const f32x4 x1 = acc[ai][bj][m][n]; *(f32x4*)(out + off + bj * HALF + n * 16) = bad1 ? (f32x4){qnan, qnan, qnan, qnan} : x1;
                        const f32x4 o = (x1 - sr.x) * sr.y; u32x2v w; w.x = cvt_pk_bf16(o[0], o[1]); w.y = cvt_pk_bf16(o[2], o[3]);
                        if (bad) { w.x = 0x7fc07fc0u; w.y = 0x7fc07fc0u; } *(u32x2v*)(xn + off + bj * HALF + n * 16) = w; }
                asm volatile("" ::: "memory"); }
    }
};

template <class Epi, class Sched, bool ALIGN_EPI = false, bool SP2 = false>
__device__ __forceinline__ void gemm_phase(PG8_LAS unsigned char* lds, const Gemm g, const Sched& S, const Epi& E) {
    int tid = threadIdx.x; asm volatile("" : "+v"(tid));
    const int wid = __builtin_amdgcn_readfirstlane(tid >> 6), lane = tid & 63, wr = wid >> 2, wc = wid & 3, fr = lane & 15, fq = lane >> 4;
    const int K = g.K, nt = K / BK;
    unsigned voffA[2], voffB[2];
#pragma unroll
    for (int i = 0; i < 2; ++i) { int R, C; stage_rc(tid * 16 + i * 8192, R, C); const int Rb = Epi::PERM ? ((R & ~31) + perm32(R & 31)) : R;
        voffA[i] = (unsigned)(R * K + C) * 2u; voffB[i] = (unsigned)(Rb * K + C) * 2u; }
    const size_t kstep = (size_t)(BK * 2);
    const size_t hstep = (size_t)HALF * K * 2;
    const size_t tstep = 2 * hstep;
    const unsigned ldsw = (unsigned)wid * 1024u;
    const int aoff = lds_byte(wr * 64 + fr, fq * 8), boff = lds_byte(wc * 32 + fr, fq * 8);
#define PG8_SA(b, h) (((b) * 2 + (h)) * HTB)
#define PG8_SB(b, h) ((4 + (b) * 2 + (h)) * HTB)
#define PG8_STAGE(bufoff, gbase, voff) do { _Pragma("unroll") for (int _i = 0; _i < 2; ++_i) \
        __builtin_amdgcn_global_load_lds((const unsigned*)((const char*)(gbase) + (voff)[_i]), (PG8_LAS unsigned*)(lds + (bufoff) + ldsw + _i * 8192), 16, 0, 0); } while (0)
#define PG8_LDA(dst, b, h) do { _Pragma("unroll") for (int m = 0; m < 4; ++m) _Pragma("unroll") for (int k = 0; k < 2; ++k) dst[m][k] = *(const PG8_LAS bf16x8*)(lds + PG8_SA(b, h) + aoff + m * 2048 + k * 1024); } while (0)
#define PG8_LDB(dst, b, h) do { _Pragma("unroll") for (int n = 0; n < 2; ++n) _Pragma("unroll") for (int k = 0; k < 2; ++k) dst[n][k] = *(const PG8_LAS bf16x8*)(lds + PG8_SB(b, h) + boff + n * 2048 + k * 1024); } while (0)
#define PG8_MMA(ai, bj, At, Bt) do { __builtin_amdgcn_s_setprio(1); _Pragma("unroll") for (int m = 0; m < 4; ++m) _Pragma("unroll") for (int n = 0; n < 2; ++n) _Pragma("unroll") for (int k = 0; k < 2; ++k) \
        acc[ai][bj][m][n] = __builtin_amdgcn_mfma_f32_16x16x32_bf16(Bt[n][k], At[m][k], acc[ai][bj][m][n], 0, 0, 0); __builtin_amdgcn_s_setprio(0); } while (0)
#define PG8_WAIT_V(n) asm volatile("s_waitcnt vmcnt(" #n ")" ::: "memory")
#define PG8_WAIT_L(n) asm volatile("s_waitcnt lgkmcnt(" #n ")" ::: "memory")
#define PG8_BAR __builtin_amdgcn_s_barrier()
#define PG8_SCHED __builtin_amdgcn_sched_barrier(0)
    Unit cur, nxt; int ui = 0;
    if (!S.next(0, cur)) return;
    f32x4 acc[2][2][4][2];
#pragma unroll
    for (int a = 0; a < 2; ++a)
#pragma unroll
        for (int b = 0; b < 2; ++b)
#pragma unroll
            for (int m = 0; m < 4; ++m)
#pragma unroll
                for (int n = 0; n < 2; ++n) acc[a][b][m][n] = (f32x4){0.f, 0.f, 0.f, 0.f};
    bf16x8 At[4][2], B0[2][2], B1[2][2];
    const char* cA = (const char*)g.A + (size_t)cur.pm * tstep; const char* cB = (const char*)g.Bt + (size_t)cur.pn * tstep;
    S.a_ready(cur);
    if constexpr (SP2) {
        PG8_STAGE(PG8_SB(0, 0), cB, voffB); PG8_STAGE(PG8_SB(0, 1), cB + hstep, voffB); PG8_STAGE(PG8_SA(0, 0), cA, voffA); PG8_STAGE(PG8_SA(0, 1), cA + hstep, voffA);
        if (wr == 1) PG8_BAR;
        PG8_WAIT_V(2); PG8_BAR;
        PG8_STAGE(PG8_SB(1, 0), cB + kstep, voffB); PG8_STAGE(PG8_SA(1, 0), cA + kstep, voffA); PG8_STAGE(PG8_SB(1, 1), cB + hstep + kstep, voffB);
        PG8_WAIT_V(6); PG8_BAR;
    } else {
        PG8_STAGE(PG8_SB(0, 0), cB, voffB); PG8_STAGE(PG8_SA(0, 0), cA, voffA); PG8_STAGE(PG8_SB(0, 1), cB + hstep, voffB); PG8_STAGE(PG8_SA(0, 1), cA + hstep, voffA);
        if (wr == 1) PG8_BAR;
        PG8_WAIT_V(4); PG8_BAR;
        PG8_STAGE(PG8_SB(1, 0), cB + kstep, voffB); PG8_STAGE(PG8_SA(1, 0), cA + kstep, voffA); PG8_STAGE(PG8_SB(1, 1), cB + hstep + kstep, voffB);
        PG8_WAIT_V(6); PG8_BAR;
    }
    for (;;) {
        const bool has_next = S.next(ui + 1, nxt);
        const char* nA = has_next ? (const char*)g.A + (size_t)nxt.pm * tstep : cA; const char* nB = has_next ? (const char*)g.Bt + (size_t)nxt.pn * tstep : cB;
        for (int t = 0; t < nt; t += 2) {
            const bool last = (t == nt - 2);
            const char* a1 = cA + (size_t)(t + 1) * kstep;
            const char* a2 = last ? nA : cA + (size_t)(t + 2) * kstep; const char* b2 = last ? nB : cB + (size_t)(t + 2) * kstep;
            const char* a3 = a2 + kstep; const char* b3 = b2 + kstep;
            if (last && has_next) S.a_ready(nxt);
            if constexpr (SP2) {
            PG8_LDB(B0, 0, 0); PG8_LDB(B1, 0, 1); PG8_SCHED; PG8_LDA(At, 0, 0); PG8_STAGE(PG8_SA(1, 1), a1 + hstep, voffA);
            PG8_WAIT_V(8); PG8_WAIT_L(0); PG8_BAR; PG8_MMA(0, 0, At, B0); PG8_MMA(0, 1, At, B1); PG8_BAR; PG8_SCHED;
            PG8_LDA(At, 0, 1); PG8_STAGE(PG8_SB(0, 0), b2, voffB); PG8_STAGE(PG8_SB(0, 1), b2 + hstep, voffB); PG8_STAGE(PG8_SA(0, 0), a2, voffA);
            PG8_WAIT_V(8); PG8_WAIT_L(0); PG8_BAR; PG8_MMA(1, 0, At, B0); PG8_MMA(1, 1, At, B1); PG8_BAR; PG8_SCHED;
            PG8_LDB(B0, 1, 0); PG8_LDB(B1, 1, 1); PG8_SCHED; PG8_LDA(At, 1, 0); PG8_STAGE(PG8_SA(0, 1), a2 + hstep, voffA);
            PG8_WAIT_V(8); PG8_WAIT_L(0); PG8_BAR; PG8_MMA(0, 0, At, B0); PG8_MMA(0, 1, At, B1); PG8_BAR; PG8_SCHED;
            PG8_LDA(At, 1, 1); PG8_STAGE(PG8_SB(1, 0), b3, voffB); PG8_STAGE(PG8_SB(1, 1), b3 + hstep, voffB); PG8_STAGE(PG8_SA(1, 0), a3, voffA);
            PG8_WAIT_V(8); PG8_WAIT_L(0); PG8_BAR; PG8_MMA(1, 0, At, B0); PG8_MMA(1, 1, At, B1); PG8_BAR; PG8_SCHED;
            } else {
            PG8_LDB(B0, 0, 0); PG8_SCHED; PG8_LDA(At, 0, 0); PG8_STAGE(PG8_SA(1, 1), a1 + hstep, voffA);
            PG8_WAIT_L(8); PG8_BAR; PG8_WAIT_L(0); PG8_MMA(0, 0, At, B0); PG8_BAR; PG8_SCHED;
            PG8_LDB(B1, 0, 1); PG8_STAGE(PG8_SB(0, 0), b2, voffB);
            PG8_BAR; PG8_WAIT_L(0); PG8_MMA(0, 1, At, B1); PG8_BAR;
            PG8_LDA(At, 0, 1); PG8_STAGE(PG8_SA(0, 0), a2, voffA);
            PG8_BAR; PG8_WAIT_L(0); PG8_MMA(1, 0, At, B0); PG8_BAR; PG8_SCHED;
            PG8_STAGE(PG8_SB(0, 1), b2 + hstep, voffB);
            PG8_WAIT_V(6); PG8_BAR; PG8_MMA(1, 1, At, B1); PG8_BAR;
            PG8_LDB(B0, 1, 0); PG8_SCHED; PG8_LDA(At, 1, 0); PG8_STAGE(PG8_SA(0, 1), a2 + hstep, voffA);
            PG8_WAIT_L(8); PG8_BAR; PG8_WAIT_L(0); PG8_MMA(0, 0, At, B0); PG8_BAR; PG8_SCHED;
            PG8_LDB(B1, 1, 1); PG8_STAGE(PG8_SB(1, 0), b3, voffB);
            PG8_BAR; PG8_WAIT_L(0); PG8_MMA(0, 1, At, B1); PG8_BAR;
            PG8_LDA(At, 1, 1); PG8_STAGE(PG8_SA(1, 0), a3, voffA);
            PG8_BAR; PG8_WAIT_L(0); PG8_MMA(1, 0, At, B0); PG8_BAR; PG8_SCHED;
            PG8_STAGE(PG8_SB(1, 1), b3 + hstep, voffB);
            PG8_WAIT_V(6); PG8_BAR; PG8_MMA(1, 1, At, B1); PG8_BAR;
            }
        }
        if constexpr (ALIGN_EPI) { if (wr == 0) PG8_BAR; }
        if constexpr (!Epi::AFTER_DRAIN) { E(acc, cur, wr, wc, fr, fq); S.done(cur); }
        if (!has_next) break;
#pragma unroll
        for (int a = 0; a < 2; ++a)
#pragma unroll
            for (int b = 0; b < 2; ++b)
#pragma unroll
                for (int m = 0; m < 4; ++m)
#pragma unroll
                    for (int n = 0; n < 2; ++n) acc[a][b][m][n] = (f32x4){0.f, 0.f, 0.f, 0.f};
        cur = nxt; cA = nA; cB = nB; ++ui;
        if constexpr (ALIGN_EPI) { if (wr == 1) PG8_BAR; }
    }
    PG8_WAIT_V(0);
    if constexpr (!ALIGN_EPI) { if (wr == 0) PG8_BAR; }
    PG8_BAR;
    if constexpr (Epi::AFTER_DRAIN) { E.fused(acc, cur, wr, wc, fr, fq, lds, wid, lane); S.done(cur); }
#undef PG8_SA
#undef PG8_SB
#undef PG8_STAGE
#undef PG8_LDA
#undef PG8_LDB
#undef PG8_MMA
#undef PG8_WAIT_V
#undef PG8_WAIT_L
#undef PG8_BAR
#undef PG8_SCHED
}
}

#ifndef PG8_SP2
#define PG8_SP2 true
#endif
#ifndef PG8_ALIGN
#define PG8_ALIGN true
#endif
namespace att {
constexpr int NW = 8, QBLK = 32, KVBLK = 64;
constexpr int SHM_V = KVBLK * 128 * 2, SHM_K = KVBLK * 64 * 2, SHM_ATTN = 2 * SHM_V + 2 * SHM_K + NW * 64 * 4;
#define KSWZ64(row, colB) ((row) * 128 + ((colB) ^ ((((row) >> 1) & 7) << 4)))
#define SBAR() __builtin_amdgcn_sched_barrier(0)
__device__ __forceinline__ int crow(int r, int hi) { return (r & 3) + 8 * (r >> 2) + 4 * hi; }
__device__ __forceinline__ unsigned cvtpk(float lo, float hi) { unsigned r; asm volatile("v_cvt_pk_bf16_f32 %0, %1, %2" : "=v"(r) : "v"(lo), "v"(hi)); return r; }
__device__ __forceinline__ void expA(f32x16& p) {
#pragma unroll
    for (int r = 0; r < 16; ++r) p[r] = __builtin_amdgcn_exp2f(p[r]);
}
__device__ __forceinline__ void finishSM(f32x16& p0, f32x16& p1, float& l_reg, bf16x8& pa0, bf16x8& pa1, bf16x8& pa2, bf16x8& pa3) {
#pragma unroll
    for (int r = 0; r < 16; ++r) p1[r] = __builtin_amdgcn_exp2f(p1[r]);
    float ps = 0;
#pragma unroll
    for (int r = 0; r < 16; ++r) ps += p0[r];
#pragma unroll
    for (int r = 0; r < 16; ++r) ps += p1[r];
    l_reg += ps;
#define PK4(P, BASE, OUT) do { unsigned a0 = cvtpk(P[BASE + 0], P[BASE + 1]), a1 = cvtpk(P[BASE + 2], P[BASE + 3]);   \
    unsigned b0 = cvtpk(P[BASE + 4], P[BASE + 5]), b1 = cvtpk(P[BASE + 6], P[BASE + 7]);                              \
    auto r0 = __builtin_amdgcn_permlane32_swap(a0, b0, false, false); auto r1 = __builtin_amdgcn_permlane32_swap(a1, b1, false, false); \
    v4u w = {r0[0], r1[0], r0[1], r1[1]}; OUT = *reinterpret_cast<bf16x8*>(&w); } while (0)
    PK4(p0, 0, pa0); PK4(p0, 8, pa1); PK4(p1, 0, pa2); PK4(p1, 8, pa3);
#undef PK4
}
__device__ __forceinline__ void softHalf(f32x16& p, float& l_reg, bf16x8& paLo, bf16x8& paHi) {
#pragma unroll
    for (int r = 0; r < 16; ++r) p[r] = __builtin_amdgcn_exp2f(p[r]);
    float ps = 0;
#pragma unroll
    for (int r = 0; r < 16; ++r) ps += p[r];
    l_reg += ps;
#define PK4(P, BASE, OUT) do { unsigned a0 = cvtpk(P[BASE + 0], P[BASE + 1]), a1 = cvtpk(P[BASE + 2], P[BASE + 3]);   \
    unsigned b0 = cvtpk(P[BASE + 4], P[BASE + 5]), b1 = cvtpk(P[BASE + 6], P[BASE + 7]);                              \
    auto r0 = __builtin_amdgcn_permlane32_swap(a0, b0, false, false); auto r1 = __builtin_amdgcn_permlane32_swap(a1, b1, false, false); \
    v4u w = {r0[0], r1[0], r0[1], r1[1]}; OUT = *reinterpret_cast<bf16x8*>(&w); } while (0)
    PK4(p, 0, paLo); PK4(p, 8, paHi);
#undef PK4
}
__device__ __forceinline__ void qkt(f32x16& p0, f32x16& p1, const char* Ks, const bf16x8* qr, int r32, int hi) {
    p0 = f32x16{}; p1 = f32x16{};
#pragma unroll
    for (int d0 = 0; d0 < 4; ++d0) { const int cb = (d0 * 16 + hi * 8) * 2;
        const bf16x8 b0 = *reinterpret_cast<const bf16x8*>(Ks + KSWZ64(r32, cb));
        const bf16x8 b1 = *reinterpret_cast<const bf16x8*>(Ks + KSWZ64(32 + r32, cb));
        p0 = __builtin_amdgcn_mfma_f32_32x32x16_bf16(b0, qr[d0], p0, 0, 0, 0);
        p1 = __builtin_amdgcn_mfma_f32_32x32x16_bf16(b1, qr[d0], p1, 0, 0, 0); }
}
__device__ __forceinline__ int v_st(int k, int c) { const int kk = (k & ~0xC) | ((k & 4) << 1) | ((k & 8) >> 1); return ((kk >> 3) * 4 + (c >> 5)) * 512 + ((kk & 7) * 32 + (c & 31)) * 2; }
__device__ __forceinline__ int v_rd_base(int lane) { return ((lane & 3) << 3) | (((lane >> 2) & 3) << 6) | (((lane >> 4) & 1) << 5) | (((lane >> 5) & 1) << 8); }
constexpr int v_rd_off(int d0, int ks, int half) { return d0 * 512 + ks * 4096 + half * 2048; }
template <int OFF> __device__ __forceinline__ s16x4 tr_read(int vb) {
    s16x4 r; asm volatile("ds_read_b64_tr_b16 %0, %1 offset:%2" : "=&v"(r) : "v"(vb), "i"(OFF) : "memory"); return r;
}
template <int D0> __device__ __forceinline__ void pv_one(f32x16& od, int vb, bf16x8 pa0, bf16x8 pa1, bf16x8 pa2, bf16x8 pa3) {
    const s16x4 l0 = tr_read<v_rd_off(D0, 0, 0)>(vb), h0 = tr_read<v_rd_off(D0, 0, 1)>(vb), l1 = tr_read<v_rd_off(D0, 1, 0)>(vb), h1 = tr_read<v_rd_off(D0, 1, 1)>(vb);
    const s16x4 l2 = tr_read<v_rd_off(D0, 2, 0)>(vb), h2 = tr_read<v_rd_off(D0, 2, 1)>(vb), l3 = tr_read<v_rd_off(D0, 3, 0)>(vb), h3 = tr_read<v_rd_off(D0, 3, 1)>(vb);
    asm volatile("s_waitcnt lgkmcnt(0)" ::: "memory"); SBAR();
#define PK(L, H) (bf16x8){L[0], L[1], L[2], L[3], H[0], H[1], H[2], H[3]}
    od = __builtin_amdgcn_mfma_f32_32x32x16_bf16(pa0, PK(l0, h0), od, 0, 0, 0);
    od = __builtin_amdgcn_mfma_f32_32x32x16_bf16(pa1, PK(l1, h1), od, 0, 0, 0);
    od = __builtin_amdgcn_mfma_f32_32x32x16_bf16(pa2, PK(l2, h2), od, 0, 0, 0);
    od = __builtin_amdgcn_mfma_f32_32x32x16_bf16(pa3, PK(l3, h3), od, 0, 0, 0);
#undef PK
}
template <int KS> __device__ __forceinline__ void pv_ks(f32x16* o, int vb, bf16x8 pa) {
    const s16x4 l0 = tr_read<v_rd_off(0, KS, 0)>(vb), h0 = tr_read<v_rd_off(0, KS, 1)>(vb), l1 = tr_read<v_rd_off(1, KS, 0)>(vb), h1 = tr_read<v_rd_off(1, KS, 1)>(vb);
    const s16x4 l2 = tr_read<v_rd_off(2, KS, 0)>(vb), h2 = tr_read<v_rd_off(2, KS, 1)>(vb), l3 = tr_read<v_rd_off(3, KS, 0)>(vb), h3 = tr_read<v_rd_off(3, KS, 1)>(vb);
    asm volatile("s_waitcnt lgkmcnt(0)" ::: "memory"); SBAR();
#define PK(L, H) (bf16x8){L[0], L[1], L[2], L[3], H[0], H[1], H[2], H[3]}
    o[0] = __builtin_amdgcn_mfma_f32_32x32x16_bf16(pa, PK(l0, h0), o[0], 0, 0, 0);
    o[1] = __builtin_amdgcn_mfma_f32_32x32x16_bf16(pa, PK(l1, h1), o[1], 0, 0, 0);
    o[2] = __builtin_amdgcn_mfma_f32_32x32x16_bf16(pa, PK(l2, h2), o[2], 0, 0, 0);
    o[3] = __builtin_amdgcn_mfma_f32_32x32x16_bf16(pa, PK(l3, h3), o[3], 0, 0, 0);
#undef PK
}
__device__ __forceinline__ void pv_d0(f32x16* o, int vb, bf16x8 pa0, bf16x8 pa1, bf16x8 pa2, bf16x8 pa3) {
    pv_one<0>(o[0], vb, pa0, pa1, pa2, pa3); pv_one<1>(o[1], vb, pa0, pa1, pa2, pa3); pv_one<2>(o[2], vb, pa0, pa1, pa2, pa3); pv_one<3>(o[3], vb, pa0, pa1, pa2, pa3);
}
__device__ __forceinline__ void attn_unit(const bf16* __restrict__ Qb, const bf16* __restrict__ Kh, const bf16* __restrict__ Vh, bf16* __restrict__ Ob, int seq, char* lds) {
    int tid = threadIdx.x; asm volatile("" : "+v"(tid));
    const int wid = tid >> 6, lane = tid & 63, r32 = lane & 31, hi = lane >> 5;
    char* V_lds = lds; char* K_lds = lds + 2 * SHM_V;
    float* wsf = (float*)(lds + 2 * SHM_V + 2 * SHM_K) + wid * 64;
    float l_reg = 0; f32x16 o[4] = {}; bf16x8 qr[4];
    const bf16* Qw = Qb + (long)(wid * QBLK + r32) * 64 + hi * 8;
#pragma unroll
    for (int d0 = 0; d0 < 4; ++d0) qr[d0] = *reinterpret_cast<const bf16x8*>(Qw + d0 * 16);
    const int sr = tid >> 4, sc = (tid & 15) * 8, vst0 = v_st(sr, sc), vst1 = v_st(32 + sr, sc);
    const int kr = tid >> 3, kc = (tid & 7) * 8, kst = KSWZ64(kr, kc * 2);
    const int vb0 = (int)(uintptr_t)V_lds + v_rd_base(lane);
    struct { bf16x8 vs0, vs1, ks0; } sr_[1];
    const unsigned voff0 = (unsigned)((sr * 128 + sc) * 2), koff0 = (unsigned)((kr * 64 + kc) * 2);
#define SLOAD(i, k0) do { const char* vt_ = (const char*)Vh + (size_t)(k0) * 256; const char* kt_ = (const char*)Kh + (size_t)(k0) * 128; \
    sr_[i].vs0 = *reinterpret_cast<const bf16x8*>(vt_ + voff0); sr_[i].vs1 = *reinterpret_cast<const bf16x8*>(vt_ + 32 * 256 + voff0); \
    sr_[i].ks0 = *reinterpret_cast<const bf16x8*>(kt_ + koff0); } while (0)
#define SWRITE(b, i) do { *(bf16x8*)(V_lds + (b) * SHM_V + vst0) = sr_[i].vs0; *(bf16x8*)(V_lds + (b) * SHM_V + vst1) = sr_[i].vs1; \
    *(bf16x8*)(K_lds + (b) * SHM_K + kst) = sr_[i].ks0; } while (0)
#define SWAIT() asm volatile("s_waitcnt vmcnt(0)" ::: "memory")
    f32x16 pA0, pA1, pB0, pB1; bf16x8 pa0, pa1, pa2, pa3; const int NT = seq / KVBLK;
    constexpr int SE = 0, SO = 0;
    SLOAD(SE, 0); asm volatile("s_waitcnt vmcnt(0)" ::: "memory"); SWRITE(0, SE); __syncthreads();
    qkt(pA0, pA1, K_lds, qr, r32, hi); softHalf(pA0, l_reg, pa0, pa1);
    SLOAD(SO, KVBLK);
    SWAIT(); SWRITE(1, SO); __syncthreads();
    for (int j = 1; j + 1 < NT; j += 2) {
        SBAR(); qkt(pB0, pB1, K_lds + SHM_K, qr, r32, hi); pv_ks<0>(o, vb0, pa0); SBAR();
        softHalf(pA1, l_reg, pa2, pa3); SBAR();
        SLOAD(SO, (j + 1) * KVBLK); SBAR();
        pv_ks<1>(o, vb0, pa1); pv_ks<2>(o, vb0, pa2); pv_ks<3>(o, vb0, pa3); SBAR();
        softHalf(pB0, l_reg, pa0, pa1); SBAR();
        __syncthreads(); SWAIT(); SWRITE(0, SE);
        __syncthreads();
        SBAR(); qkt(pA0, pA1, K_lds, qr, r32, hi); pv_ks<0>(o, vb0 + SHM_V, pa0); SBAR();
        softHalf(pB1, l_reg, pa2, pa3); SBAR();
        SLOAD(SE, (j + 2) * KVBLK); SBAR();
        pv_ks<1>(o, vb0 + SHM_V, pa1); pv_ks<2>(o, vb0 + SHM_V, pa2); pv_ks<3>(o, vb0 + SHM_V, pa3); SBAR();
        softHalf(pA0, l_reg, pa0, pa1); SBAR();
        __syncthreads(); SWAIT(); SWRITE(1, SO);
        __syncthreads();
    }
    SBAR(); qkt(pB0, pB1, K_lds + SHM_K, qr, r32, hi); pv_ks<0>(o, vb0, pa0); SBAR();
    softHalf(pA1, l_reg, pa2, pa3); SBAR();
    pv_ks<1>(o, vb0, pa1); pv_ks<2>(o, vb0, pa2); pv_ks<3>(o, vb0, pa3); SBAR();
    softHalf(pB0, l_reg, pa0, pa1); SBAR();
    pv_ks<0>(o, vb0 + SHM_V, pa0); SBAR();
    softHalf(pB1, l_reg, pa2, pa3); SBAR();
    pv_ks<1>(o, vb0 + SHM_V, pa1); pv_ks<2>(o, vb0 + SHM_V, pa2); pv_ks<3>(o, vb0 + SHM_V, pa3);
    { auto rr = __builtin_amdgcn_permlane32_swap(__float_as_uint(l_reg), __float_as_uint(l_reg), false, false); l_reg = __uint_as_float(rr[0]) + __uint_as_float(rr[1]); }
    if (hi == 0) wsf[r32] = l_reg; asm volatile("s_waitcnt lgkmcnt(0)" ::: "memory");
    float rli[16];
#pragma unroll
    for (int r = 0; r < 16; ++r) rli[r] = __builtin_amdgcn_rcpf(wsf[crow(r, hi)]);
    bf16* Ow = Ob + (long)(wid * QBLK) * 128;
    {
        char* stg = lds + 53248 + wid * 8192;
#pragma unroll
        for (int r = 0; r < 16; ++r) { const int orow = crow(r, hi);
#pragma unroll
            for (int d0 = 0; d0 < 4; ++d0) *(unsigned short*)(stg + (orow * 128 + d0 * 32 + r32) * 2) = (unsigned short)f2bf(o[d0][r] * rli[r]); }
        asm volatile("s_waitcnt lgkmcnt(0)" ::: "memory");
#pragma unroll
        for (int i = 0; i < 8; ++i) { const int row = i * 4 + (lane >> 4), ch = lane & 15; const v4u v = *(const v4u*)(stg + row * 256 + ch * 16); *(v4u*)(Ow + (long)row * 128 + ch * 8) = v; }
    }
    __syncthreads();
#undef SLOAD
#undef SWRITE
#undef SWAIT
}
#undef SBAR
}
namespace ret {
using namespace att;
#define SBAR() __builtin_amdgcn_sched_barrier(0)
__device__ __forceinline__ int v_st64(int k, int c) { const int kk = (k & ~0xC) | ((k & 4) << 1) | ((k & 8) >> 1); return ((kk >> 3) * 2 + (c >> 5)) * 512 + ((kk & 7) * 32 + (c & 31)) * 2; }
constexpr int v_rd_off64(int d0, int ks, int half) { return d0 * 512 + ks * 2048 + half * 1024; }
__device__ __forceinline__ float log2_sigmoid(float x) { return -log1pf(expf(-x)) * 1.4426950408889634f; }
__device__ __forceinline__ bf16x8 scale8(bf16x8 v, float s) {
    v4u w = *reinterpret_cast<v4u*>(&v), o;
#pragma unroll
    for (int i = 0; i < 4; ++i) { const float lo = __builtin_bit_cast(float, w[i] << 16) * s, hi = __builtin_bit_cast(float, w[i] & 0xffff0000u) * s; o[i] = pk2(lo, hi); }
    return *reinterpret_cast<bf16x8*>(&o);
}
__device__ __forceinline__ void state_unit(const bf16* __restrict__ Kc, const bf16* __restrict__ Vc, float* __restrict__ Sf, float* __restrict__ Sb, float lgf2, float lgb2, char* lds) {
    int tid = threadIdx.x; asm volatile("" : "+v"(tid));
    const int wid = tid >> 6, lane = tid & 63, r32 = lane & 31, hi = lane >> 5;
    const int sr = tid >> 4, sc = (tid & 15) * 8, vst0 = v_st(sr, sc), vst1 = v_st(32 + sr, sc);
    const int kr = tid >> 3, kc = (tid & 7) * 8, kst = v_st64(kr, kc);
#pragma unroll
    for (int t = 0; t < 4; ++t) {
        const bf16x8 a0 = *reinterpret_cast<const bf16x8*>(Vc + (size_t)(64 * t + sr) * 128 + sc), a1 = *reinterpret_cast<const bf16x8*>(Vc + (size_t)(64 * t + 32 + sr) * 128 + sc);
        const bf16x8 k0 = *reinterpret_cast<const bf16x8*>(Kc + (size_t)(64 * t + kr) * 64 + kc);
        const int i = 64 * t + kr;
        const float wf = __builtin_amdgcn_exp2f((float)(255 - i) * lgf2), wb = __builtin_amdgcn_exp2f((float)i * lgb2);
        *(bf16x8*)(lds + t * 32768 + vst0) = a0; *(bf16x8*)(lds + t * 32768 + vst1) = a1;
        *(bf16x8*)(lds + t * 32768 + 16384 + kst) = scale8(k0, wf); *(bf16x8*)(lds + t * 32768 + 24576 + kst) = scale8(k0, wb);
    }
    __syncthreads();
    const int dblk = wid >> 2, eblk = wid & 3;
    const int vb = (int)(uintptr_t)lds + v_rd_base(lane);
    f32x16 accf = {}, accb = {};
#pragma unroll
    for (int t = 0; t < 4; ++t) {
#pragma unroll
        for (int ks = 0; ks < 4; ++ks) {
            s16x4 vl, vh, fl, fh, bl, bh;
            const int vo = vb + t * 32768 + eblk * 512 + ks * 4096, ko = vb + t * 32768 + 16384 + dblk * 512 + ks * 2048;
            asm volatile("ds_read_b64_tr_b16 %0, %1" : "=&v"(vl) : "v"(vo) : "memory");
            asm volatile("ds_read_b64_tr_b16 %0, %1 offset:2048" : "=&v"(vh) : "v"(vo) : "memory");
            asm volatile("ds_read_b64_tr_b16 %0, %1" : "=&v"(fl) : "v"(ko) : "memory");
            asm volatile("ds_read_b64_tr_b16 %0, %1 offset:1024" : "=&v"(fh) : "v"(ko) : "memory");
            asm volatile("ds_read_b64_tr_b16 %0, %1 offset:8192" : "=&v"(bl) : "v"(ko) : "memory");
            asm volatile("ds_read_b64_tr_b16 %0, %1 offset:9216" : "=&v"(bh) : "v"(ko) : "memory");
            asm volatile("s_waitcnt lgkmcnt(0)" ::: "memory"); SBAR();
            const bf16x8 vf = (bf16x8){vl[0], vl[1], vl[2], vl[3], vh[0], vh[1], vh[2], vh[3]};
            const bf16x8 kf = (bf16x8){fl[0], fl[1], fl[2], fl[3], fh[0], fh[1], fh[2], fh[3]};
            const bf16x8 kb = (bf16x8){bl[0], bl[1], bl[2], bl[3], bh[0], bh[1], bh[2], bh[3]};
            accf = __builtin_amdgcn_mfma_f32_32x32x16_bf16(kf, vf, accf, 0, 0, 0);
            accb = __builtin_amdgcn_mfma_f32_32x32x16_bf16(kb, vf, accb, 0, 0, 0);
        }
    }
#pragma unroll
    for (int r = 0; r < 16; ++r) { const int d = 32 * dblk + crow(r, hi), e = 32 * eblk + r32;
        Sf[d * 128 + e] = accf[r]; Sb[d * 128 + e] = accb[r]; }
    __syncthreads();
}
__device__ __forceinline__ void out_unit(const bf16* __restrict__ Qc, const bf16* __restrict__ Kc, const bf16* __restrict__ Vc, const float* __restrict__ ST, int c,
                                         const bf16* __restrict__ RGc, const float* __restrict__ gnorm, bf16* __restrict__ MIXc, float lgf2, float lgb2, char* lds) {
    int tid = threadIdx.x; asm volatile("" : "+v"(tid));
    const int wid = tid >> 6, lane = tid & 63, r32 = lane & 31, hi = lane >> 5;
    const int sr = tid >> 4, sc = (tid & 15) * 8, vst0 = v_st(sr, sc), vst1 = v_st(32 + sr, sc);
    const int kr = tid >> 3, kc = (tid & 7) * 8, kst = KSWZ64(kr, kc * 2);
#pragma unroll
    for (int t = 0; t < 4; ++t) {
        const bf16x8 a0 = *reinterpret_cast<const bf16x8*>(Vc + (size_t)(64 * t + sr) * 128 + sc), a1 = *reinterpret_cast<const bf16x8*>(Vc + (size_t)(64 * t + 32 + sr) * 128 + sc);
        const bf16x8 k0 = *reinterpret_cast<const bf16x8*>(Kc + (size_t)(64 * t + kr) * 64 + kc);
        *(bf16x8*)(lds + 32768 + t * 16384 + vst0) = a0; *(bf16x8*)(lds + 32768 + t * 16384 + vst1) = a1;
        *(bf16x8*)(lds + t * 8192 + kst) = k0;
    }
    {
        float rf[2][8], rb[2][8];
#pragma unroll
        for (int q = 0; q < 2; ++q)
#pragma unroll
            for (int j = 0; j < 8; ++j) { rf[q][j] = 0.f; rb[q][j] = 0.f; }
        for (int g3 = 0; g3 < 9; g3 += 3) {
            f32x4 sv[3][2][2]; float wf[3], wb[3];
#pragma unroll
            for (int u = 0; u < 3; ++u) { const int cp = g3 + u; const bool fwd = cp < c;
                const float wgt = cp == c ? 0.f : (fwd ? __builtin_amdgcn_exp2f((float)(256 * (c - 1 - cp)) * lgf2) : __builtin_amdgcn_exp2f((float)(256 * (cp - c - 1)) * lgb2));
                wf[u] = fwd ? wgt : 0.f; wb[u] = fwd ? 0.f : wgt;
                const float* S = ST + ((size_t)cp * 2 + (fwd ? 0 : 1)) * 8192;
#pragma unroll
                for (int q = 0; q < 2; ++q) { sv[u][q][0] = *(const f32x4*)(S + (sr + 32 * q) * 128 + sc); sv[u][q][1] = *(const f32x4*)(S + (sr + 32 * q) * 128 + sc + 4); } }
#pragma unroll
            for (int u = 0; u < 3; ++u)
#pragma unroll
                for (int q = 0; q < 2; ++q)
#pragma unroll
                    for (int j = 0; j < 8; ++j) { const float v = sv[u][q][j >> 2][j & 3]; rf[q][j] += wf[u] * v; rb[q][j] += wb[u] * v; }
        }
        {
            const float wgt = __builtin_amdgcn_exp2f((float)(256 * (8 - c)) * lgb2);
            const float* S = ST + 8192;
#pragma unroll
            for (int q = 0; q < 2; ++q) { const f32x4 s0 = *(const f32x4*)(S + (sr + 32 * q) * 128 + sc), s1 = *(const f32x4*)(S + (sr + 32 * q) * 128 + sc + 4);
                rb[q][0] += wgt * s0.x; rb[q][1] += wgt * s0.y; rb[q][2] += wgt * s0.z; rb[q][3] += wgt * s0.w; rb[q][4] += wgt * s1.x; rb[q][5] += wgt * s1.y; rb[q][6] += wgt * s1.z; rb[q][7] += wgt * s1.w; }
        }
#pragma unroll
        for (int q = 0; q < 2; ++q) {
            v4u of, ob;
            of.x = pk2(rf[q][0], rf[q][1]); of.y = pk2(rf[q][2], rf[q][3]); of.z = pk2(rf[q][4], rf[q][5]); of.w = pk2(rf[q][6], rf[q][7]);
            ob.x = pk2(rb[q][0], rb[q][1]); ob.y = pk2(rb[q][2], rb[q][3]); ob.z = pk2(rb[q][4], rb[q][5]); ob.w = pk2(rb[q][6], rb[q][7]);
            *(v4u*)(lds + 98304 + (q ? vst1 : vst0)) = of; *(v4u*)(lds + 114688 + (q ? vst1 : vst0)) = ob;
        }
    }
    bf16x8 qr[4];
    const bf16* Qw = Qc + (long)(wid * 32 + r32) * 64 + hi * 8;
#pragma unroll
    for (int d0 = 0; d0 < 4; ++d0) qr[d0] = *reinterpret_cast<const bf16x8*>(Qw + d0 * 16);
    __syncthreads();
    const int i = wid * 32 + r32;
    f32x16 o[4] = {};
    const int vb0 = (int)(uintptr_t)lds + v_rd_base(lane);
#pragma unroll 1
    for (int t = 0; t < 4; ++t) {
        f32x16 p0, p1;
        qkt(p0, p1, lds + t * 8192, qr, r32, hi);
        const float fi = (float)(i - 64 * t - 4 * hi);
#pragma unroll
        for (int r = 0; r < 16; ++r) {
            const float d0 = fi - (float)((r & 3) + 8 * (r >> 2)), d1 = d0 - 32.f;
            const float x0 = d0 >= 0.f ? d0 * lgf2 : -d0 * lgb2, x1 = d1 >= 0.f ? d1 * lgf2 : -d1 * lgb2;
            p0[r] *= __builtin_amdgcn_exp2f(x0); p1[r] *= __builtin_amdgcn_exp2f(x1);
        }
        bf16x8 pa0, pa1, pa2, pa3;
#define PK4(P, BASE, OUT) do { unsigned a0 = cvtpk(P[BASE + 0], P[BASE + 1]), a1 = cvtpk(P[BASE + 2], P[BASE + 3]);   \
    unsigned b0 = cvtpk(P[BASE + 4], P[BASE + 5]), b1 = cvtpk(P[BASE + 6], P[BASE + 7]);                              \
    auto r0 = __builtin_amdgcn_permlane32_swap(a0, b0, false, false); auto r1 = __builtin_amdgcn_permlane32_swap(a1, b1, false, false); \
    v4u w = {r0[0], r1[0], r0[1], r1[1]}; OUT = *reinterpret_cast<bf16x8*>(&w); } while (0)
        PK4(p0, 0, pa0); PK4(p0, 8, pa1); PK4(p1, 0, pa2); PK4(p1, 8, pa3);
#undef PK4
        SBAR();
        pv_d0(o, vb0 + 32768 + t * 16384, pa0, pa1, pa2, pa3);
    }
    {
        const float af = __builtin_amdgcn_exp2f((float)(i + 1) * lgf2), ab = __builtin_amdgcn_exp2f((float)(256 - i) * lgb2);
        SBAR();
        pv_d0(o, vb0 + 98304, scale8(qr[0], af), scale8(qr[1], af), scale8(qr[2], af), scale8(qr[3], af));
        pv_d0(o, vb0 + 114688, scale8(qr[0], ab), scale8(qr[1], ab), scale8(qr[2], ab), scale8(qr[3], ab));
    }
    __syncthreads();
    {
        float* stg = (float*)(lds + wid * 16384);
#pragma unroll
        for (int r = 0; r < 16; ++r) { const int orow = crow(r, hi);
#pragma unroll
            for (int d0 = 0; d0 < 4; ++d0) stg[orow * 128 + d0 * 32 + r32] = o[d0][r]; }
        const int c0 = (lane & 15) * 8, rq = lane >> 4;
        v4u gv[8];
#pragma unroll
        for (int i = 0; i < 8; ++i) gv[i] = *(const v4u*)(RGc + (size_t)(wid * 32 + i * 4 + rq) * 512 + c0);
        const f32x4 gn0 = *(const f32x4*)(gnorm + c0), gn1 = *(const f32x4*)(gnorm + c0 + 4);
        asm volatile("s_waitcnt lgkmcnt(0)" ::: "memory");
#pragma unroll
        for (int i = 0; i < 8; ++i) { const int row = i * 4 + rq;
            const f32x4 y0 = *(const f32x4*)(stg + row * 128 + c0), y1 = *(const f32x4*)(stg + row * 128 + c0 + 4);
            float ss = (y0.x * y0.x + y0.y * y0.y) + (y0.z * y0.z + y0.w * y0.w) + (y1.x * y1.x + y1.y * y1.y) + (y1.z * y1.z + y1.w * y1.w);
            ss += __int_as_float(__builtin_amdgcn_update_dpp(0, __float_as_int(ss), 0xB1, 0xf, 0xf, true));
            ss += __int_as_float(__builtin_amdgcn_update_dpp(0, __float_as_int(ss), 0x4E, 0xf, 0xf, true));
            ss += __int_as_float(__builtin_amdgcn_update_dpp(0, __float_as_int(ss), 0x141, 0xf, 0xf, true));
            ss += __int_as_float(__builtin_amdgcn_update_dpp(0, __float_as_int(ss), 0x140, 0xf, 0xf, true));
            const float rstd = rsqrtf(ss * (1.f / 128.f) + 1e-6f);
            float yv[8] = {y0.x, y0.y, y0.z, y0.w, y1.x, y1.y, y1.z, y1.w}; const float gnv[8] = {gn0.x, gn0.y, gn0.z, gn0.w, gn1.x, gn1.y, gn1.z, gn1.w};
            v4u ov;
#pragma unroll
            for (int j = 0; j < 4; ++j) { const float ga = __builtin_bit_cast(float, gv[i][j] << 16), gb = __builtin_bit_cast(float, gv[i][j] & 0xffff0000u);
                const float sa = ga * __builtin_amdgcn_rcpf(1.f + __expf(-ga)), sb = gb * __builtin_amdgcn_rcpf(1.f + __expf(-gb));
                ov[j] = pk2(yv[2 * j] * rstd * gnv[2 * j] * sa, yv[2 * j + 1] * rstd * gnv[2 * j + 1] * sb); }
            *(v4u*)(MIXc + (size_t)(wid * 32 + row) * 1024 + c0) = ov;
        }
    }
    __syncthreads();
}
#undef SBAR
}
namespace peer {
#ifndef PEER_DOT2
#define PEER_DOT2 0
#endif
using att::crow;
typedef __bf16 bf16x2_t __attribute__((ext_vector_type(2)));
__device__ __forceinline__ unsigned fkey(float f) { const unsigned u = __float_as_uint(f); return u ^ ((unsigned)((int)u >> 31) | 0x80000000u); }
__device__ __forceinline__ float kval(unsigned k) { const unsigned u = (k & 0x80000000u) ? (k ^ 0x80000000u) : ~k; return __uint_as_float(u); }
#define KSWZ256(row, colB) ((row) * 256 + ((colB) ^ (((row) & 7) << 4)))
template <int N> __device__ __forceinline__ void bitonic_sort_desc(unsigned (&a)[N]) {
#pragma unroll
    for (int k = 2; k <= N; k <<= 1)
#pragma unroll
        for (int j = k >> 1; j > 0; j >>= 1)
#pragma unroll
            for (int i = 0; i < N; ++i) { const int l = i ^ j;
                if (l > i) { const bool desc = (i & k) == 0; const unsigned mx = a[i] > a[l] ? a[i] : a[l], mn = a[i] > a[l] ? a[l] : a[i]; a[i] = desc ? mx : mn; a[l] = desc ? mn : mx; } }
}
template <int N> __device__ __forceinline__ void bitonic_merge_desc(unsigned (&a)[N]) {
#pragma unroll
    for (int j = N >> 1; j > 0; j >>= 1)
#pragma unroll
        for (int i = 0; i < N; ++i) { const int l = i ^ j;
            if (l > i) { const unsigned mx = a[i] > a[l] ? a[i] : a[l], mn = a[i] > a[l] ? a[l] : a[i]; a[i] = mx; a[l] = mn; } }
}
__device__ __forceinline__ void merge_top16(unsigned (&Lst)[16], const unsigned (&S)[16]) {
#pragma unroll
    for (int i = 0; i < 16; ++i) Lst[i] = Lst[i] > S[15 - i] ? Lst[i] : S[15 - i];
    bitonic_merge_desc<16>(Lst);
}
__device__ __forceinline__ float max8_dpp(float a) {
    a = fmaxf(a, __int_as_float(__builtin_amdgcn_update_dpp(0, __float_as_int(a), 0xB1, 0xf, 0xf, true)));
    a = fmaxf(a, __int_as_float(__builtin_amdgcn_update_dpp(0, __float_as_int(a), 0x4E, 0xf, 0xf, true)));
    a = fmaxf(a, __int_as_float(__builtin_amdgcn_update_dpp(0, __float_as_int(a), 0x141, 0xf, 0xf, true)));
    return a;
}
__device__ __forceinline__ void quant_h2_wave(int t0w, int c, const bf16* __restrict__ x1a, const float* __restrict__ ssq, const float* __restrict__ mod,
                                              unsigned char* __restrict__ HQ, float* __restrict__ HS, int lane) {
    const int s = lane & 7, k0 = 256 * c + 32 * s;
#pragma unroll
    for (int pass = 0; pass < 2; ++pass) {
        const int t = t0w + pass * 8 + (lane >> 3), b = t >> 11;
        const f32x4 s0 = *(const f32x4*)(ssq + (size_t)t * 16), s1 = *(const f32x4*)(ssq + (size_t)t * 16 + 4), s2 = *(const f32x4*)(ssq + (size_t)t * 16 + 8), s3 = *(const f32x4*)(ssq + (size_t)t * 16 + 12);
        const float tot = ((s0.x + s0.y) + (s0.z + s0.w)) + ((s1.x + s1.y) + (s1.z + s1.w)) + ((s2.x + s2.y) + (s2.z + s2.w)) + ((s3.x + s3.y) + (s3.z + s3.w));
        const float rstd = rsqrtf(tot * (1.f / 1024.f) + 1e-6f);
        const float* be = mod + (size_t)b * 6144 + 3 * 1024 + k0;
        f32x4 hv[8]; float am = 0.f;
#pragma unroll
        for (int u = 0; u < 4; ++u) { const v4u xa = *(const v4u*)(x1a + (size_t)t * 1024 + k0 + 8 * u);
#pragma unroll
            for (int hh = 0; hh < 2; ++hh) { const unsigned w0 = xa[2 * hh], w1 = xa[2 * hh + 1];
                const f32x4 xv = {__builtin_bit_cast(float, w0 << 16), __builtin_bit_cast(float, w0 & 0xffff0000u), __builtin_bit_cast(float, w1 << 16), __builtin_bit_cast(float, w1 & 0xffff0000u)};
                const f32x4 h = xv * rstd + *(const f32x4*)(be + 8 * u + 4 * hh); hv[2 * u + hh] = h;
                am = fmaxf(am, fmaxf(fmaxf(fabsf(h.x), fabsf(h.y)), fmaxf(fabsf(h.z), fabsf(h.w)))); } }
        am = max8_dpp(am);
        const float sc = am > 0.f ? 119.f / am : 0.f;
        v4u oa, ob;
#pragma unroll
        for (int k = 0; k < 4; ++k) { unsigned wa = 0u, wb = 0u;
#pragma unroll
            for (int i = 0; i < 8; ++i) { const float f = (i < 4) ? hv[2 * k][i] : hv[2 * k + 1][i - 4]; const int q = (int)rintf(f * sc); const int ahi = (q + 8) >> 4, blo = q - 16 * ahi;
                wa |= ((unsigned)ahi & 15u) << (4 * i); wb |= ((unsigned)blo & 15u) << (4 * i); }
            oa[k] = wa; ob[k] = wb; }
        unsigned char* dst = HQ + ((size_t)c * 16384 + t) * 256 + 32 * s;
        *(v4u*)dst = oa; *(v4u*)(dst + 16) = ob;
        if (s == 0) HS[(size_t)c * 16384 + t] = am * (1.f / 119.f);
    }
}
__device__ __forceinline__ void topk_p_lds(const bf16* __restrict__ skf, const char* qlds, int r32, int hi, unsigned (&Lst)[16]) {
    bf16x8 bq[8];
#pragma unroll
    for (int ks = 0; ks < 8; ++ks) bq[ks] = *reinterpret_cast<const bf16x8*>(qlds + ((2 * ks + hi) * 32 + r32) * 16);
#pragma unroll
    for (int kb = 0; kb < 4; ++kb) {
        bf16x8 a[8];
#pragma unroll
        for (int ks = 0; ks < 8; ++ks) a[ks] = *reinterpret_cast<const bf16x8*>(skf + (size_t)((((kb * 8 + ks) * 2 + hi) * 32 + r32) * 8));
        f32x16 acc = {};
#pragma unroll
        for (int ks = 0; ks < 8; ++ks) acc = __builtin_amdgcn_mfma_f32_32x32x16_bf16(a[ks], bq[ks], acc, 0, 0, 0);
        unsigned S[16];
#pragma unroll
        for (int r = 0; r < 16; ++r) S[r] = (fkey(acc[r]) & ~127u) | (unsigned)(32 * kb + crow(r, hi));
        bitonic_sort_desc<16>(S);
        if (kb == 0) {
#pragma unroll
            for (int r = 0; r < 16; ++r) Lst[r] = S[r];
        } else merge_top16(Lst, S);
    }
    unsigned Y[16];
#pragma unroll
    for (int s = 0; s < 16; ++s) { auto rr = __builtin_amdgcn_permlane32_swap(Lst[s], Lst[s], false, false); Y[s] = hi ? rr[0] : rr[1]; }
    merge_top16(Lst, Y);
}
__device__ __forceinline__ void select_wave_lds(const bf16* __restrict__ skf_h, char* qtile, int h, int* __restrict__ pidx, float* __restrict__ pgate, int wid, int lane) {
    const int r32 = lane & 31, hi = lane >> 5;
    unsigned T0[16], T1[16];
    topk_p_lds(skf_h, qtile + (wid * 2 + 0) * 8192, r32, hi, T0);
    topk_p_lds(skf_h + 4 * 8 * 2 * 32 * 8, qtile + (wid * 2 + 1) * 8192, r32, hi, T1);
    asm volatile("s_waitcnt lgkmcnt(0)" ::: "memory");
    unsigned short* tab = (unsigned short*)(qtile + wid * 16384) + lane;
    unsigned C[16], R1[16], X[32];
#define PEER_CAND(a, b, cid, dst) do { const float sum_ = kval(T0[a] & ~127u) + kval(T1[b] & ~127u); dst = (fkey(sum_) & ~63u) | (unsigned)(cid); \
        tab[(cid) * 64] = (unsigned short)((T0[a] & 127u) * 128u + (T1[b] & 127u)); } while (0)
#pragma unroll
    for (int b = 0; b < 16; ++b) PEER_CAND(0, b, 15 - b, C[b]);
#pragma unroll
    for (int b = 0; b < 16; ++b) { if (b < 8) PEER_CAND(1, b, 23 - b, R1[b]); else R1[b] = 0u; }
    {   int xi = 0;
#pragma unroll
        for (int a = 2; a < 16; ++a)
#pragma unroll
            for (int b = 0; b < 16; ++b) if ((a + 1) * (b + 1) <= 16) { PEER_CAND(a, b, 24 + xi, X[xi]); ++xi; }
#pragma unroll
        for (int q = 26; q < 32; ++q) X[q] = 0u;
    }
#undef PEER_CAND
    merge_top16(C, R1);
    bitonic_sort_desc<32>(X);
    {   unsigned X16[16];
#pragma unroll
        for (int q = 0; q < 16; ++q) X16[q] = X[q];
        merge_top16(C, X16); }
    asm volatile("s_waitcnt lgkmcnt(0)" ::: "memory");
    float v[16]; float sum = 0.f; const float mx = kval(C[0] & ~63u);
#pragma unroll
    for (int s = 0; s < 16; ++s) { v[s] = __expf(kval(C[s] & ~63u) - mx); sum += v[s]; }
    const float inv = 1.f / sum;
    int ex[16];
#pragma unroll
    for (int s = 0; s < 16; ++s) ex[s] = (int)tab[(C[s] & 63u) * 64];
    if (hi == 0) {
        int* pi = pidx + (size_t)(wid * 32 + r32) * 128 + h * 16; float* pg = pgate + (size_t)(wid * 32 + r32) * 128 + h * 16;
#pragma unroll
        for (int s = 0; s < 16; s += 4) { *(int4*)(pi + s) = make_int4(ex[s], ex[s + 1], ex[s + 2], ex[s + 3]); *(f32x4*)(pg + s) = (f32x4){v[s] * inv, v[s + 1] * inv, v[s + 2] * inv, v[s + 3] * inv}; }
    }
}
__device__ __forceinline__ void cvt_row_fp8(const float* __restrict__ src, unsigned char* __restrict__ T8, float* __restrict__ inv_scale, int e, int lane) {
    f32x4 v[4]; float am = 0.f;
#pragma unroll
    for (int j = 0; j < 4; ++j) { v[j] = *(const f32x4*)(src + (size_t)e * 1024 + 16 * lane + 4 * j);
        am = fmaxf(am, fmaxf(fmaxf(fabsf(v[j].x), fabsf(v[j].y)), fmaxf(fabsf(v[j].z), fabsf(v[j].w)))); }
#pragma unroll
    for (int o = 1; o < 64; o <<= 1) am = fmaxf(am, __shfl_xor(am, o));
    const int ex = (int)((__float_as_uint(am) >> 23) & 0xffu) - 127;
    const int k = (am > 0.f) ? (7 - ex) : 0;
    const int kc = k > 120 ? 120 : (k < -120 ? -120 : k);
    const float sc = __uint_as_float((unsigned)(127 + kc) << 23), isc = __uint_as_float((unsigned)(127 - kc) << 23);
    v4u o;
#pragma unroll
    for (int j = 0; j < 4; ++j) { int pk = 0;
        pk = __builtin_amdgcn_cvt_pk_fp8_f32(v[j].x * sc, v[j].y * sc, pk, false); pk = __builtin_amdgcn_cvt_pk_fp8_f32(v[j].z * sc, v[j].w * sc, pk, true); o[j] = (unsigned)pk; }
    *(v4u*)(T8 + ((size_t)(lane >> 3) * 16384 + e) * 128 + 16 * (lane & 7)) = o;
    if (lane == 0) inv_scale[e] = isc;
}
__device__ __forceinline__ unsigned fp4_code(float y) { const int q = (int)rintf(y); return (unsigned)q & 15u; }
__device__ __forceinline__ unsigned spread4(unsigned h16) { unsigned y = h16 & 0xffffu; y = (y | (y << 8)) & 0x00ff00ffu; y = (y | (y << 4)) & 0x0f0f0f0fu; return y; }
__device__ __forceinline__ void cvt_row_fp4(const float* __restrict__ src, unsigned char* __restrict__ T4, float* __restrict__ inv_scale, int e, int lane) {
    f32x4 v[4]; float am = 0.f;
#pragma unroll
    for (int j = 0; j < 4; ++j) { v[j] = *(const f32x4*)(src + (size_t)e * 1024 + 16 * lane + 4 * j);
        am = fmaxf(am, fmaxf(fmaxf(fabsf(v[j].x), fabsf(v[j].y)), fmaxf(fabsf(v[j].z), fabsf(v[j].w)))); }
#pragma unroll
    for (int o = 1; o < 64; o <<= 1) am = fmaxf(am, __shfl_xor(am, o));
    const float sc = am > 0.f ? 7.f / am : 0.f;
    unsigned n0 = 0u, n1 = 0u;
#pragma unroll
    for (int i = 0; i < 8; ++i) { n0 |= fp4_code(v[i >> 2][i & 3] * sc) << (4 * i); n1 |= fp4_code(v[2 + (i >> 2)][i & 3] * sc) << (4 * i); }
    const unsigned p0 = (unsigned)__builtin_amdgcn_update_dpp(0, (int)n0, 0xB1, 0xf, 0xf, true), p1 = (unsigned)__builtin_amdgcn_update_dpp(0, (int)n1, 0xB1, 0xf, 0xf, true);
    if ((lane & 1) == 0) {
        v4u o;
        o.x = spread4(n0) | (spread4(p0) << 4); o.y = spread4(n0 >> 16) | (spread4(p0 >> 16) << 4);
        o.z = spread4(n1) | (spread4(p1) << 4); o.w = spread4(n1 >> 16) | (spread4(p1 >> 16) << 4);
        *(v4u*)(T4 + ((size_t)(lane >> 4) * 16384 + e) * 128 + 16 * ((lane & 15) >> 1)) = o;
    }
    if (lane == 0) inv_scale[e] = am * (1.f / (7.f * 16.f));
}
__device__ __forceinline__ void cvt_row_i4(const float* __restrict__ src, unsigned char* __restrict__ T4, float* __restrict__ inv_scale, int e, int lane) {
    f32x4 v[4]; float am = 0.f;
#pragma unroll
    for (int j = 0; j < 4; ++j) { v[j] = *(const f32x4*)(src + (size_t)e * 1024 + 16 * lane + 4 * j);
        am = fmaxf(am, fmaxf(fmaxf(fabsf(v[j].x), fabsf(v[j].y)), fmaxf(fabsf(v[j].z), fabsf(v[j].w)))); }
#pragma unroll
    for (int o = 1; o < 64; o <<= 1) am = fmaxf(am, __shfl_xor(am, o));
    const float sc = am > 0.f ? 7.f / am : 0.f;
    v2u o;
#pragma unroll
    for (int k = 0; k < 2; ++k) { unsigned w = 0u;
#pragma unroll
        for (int i = 0; i < 8; ++i) { const int q = (int)rintf(v[2 * k + (i >> 2)][i & 3] * sc); w |= ((unsigned)q & 15u) << (4 * i); }
        o[k] = w; }
    *(v2u*)(T4 + ((size_t)(lane >> 4) * 16384 + e) * 128 + 8 * (lane & 15)) = o;
    if (lane == 0) inv_scale[e] = am * (1.f / 7.f);
}
__device__ __forceinline__ int sum8_dpp_i(int a) {
    a += __builtin_amdgcn_update_dpp(0, a, 0xB1, 0xf, 0xf, true);
    a += __builtin_amdgcn_update_dpp(0, a, 0x4E, 0xf, 0xf, true);
    a += __builtin_amdgcn_update_dpp(0, a, 0x141, 0xf, 0xf, true);
    return a;
}
__device__ __forceinline__ float gelu_exact(float x) { return 0.5f * x * (1.f + erff(x * 0.70710678118654752f)); }
struct Rows { v4u v[16]; };
__device__ __forceinline__ void issue_rows(Rows& R, const unsigned short* __restrict__ idxrow, const unsigned char* __restrict__ base  , unsigned loff  , int r) {
#pragma unroll
    for (int i = 0; i < 16; ++i) { const unsigned e = idxrow[8 * i + r]; R.v[i] = *(const v4u*)(base + (e * 128u + loff)); }
}
__device__ __forceinline__ float sum8_dpp(float a) {
    a += __int_as_float(__builtin_amdgcn_update_dpp(0, __float_as_int(a), 0xB1, 0xf, 0xf, true));
    a += __int_as_float(__builtin_amdgcn_update_dpp(0, __float_as_int(a), 0x4E, 0xf, 0xf, true));
    a += __int_as_float(__builtin_amdgcn_update_dpp(0, __float_as_int(a), 0x141, 0xf, 0xf, true));
    return a;
}
__device__ __forceinline__ float xor8_dpp(float a) { return __int_as_float(__builtin_amdgcn_update_dpp(0, __float_as_int(a), 0x128, 0xf, 0xf, true)); }
typedef float f32x2 __attribute__((ext_vector_type(2)));
typedef _Float16 f16x2 __attribute__((ext_vector_type(2)));
__device__ __forceinline__ void dec16p(const v4u raw, f32x2 (&f)[8]) {
#pragma unroll
    for (int j = 0; j < 4; ++j) { f[2 * j] = __builtin_amdgcn_cvt_pk_f32_fp8((int)raw[j], false); f[2 * j + 1] = __builtin_amdgcn_cvt_pk_f32_fp8((int)raw[j], true); }
}
template <int OFF = 65536>
__device__ __forceinline__ void stage_idx(const int* __restrict__ pidx, int t0, char* lds, int tid) {
#pragma unroll
    for (int k = 0; k < 8; ++k) { const int q = tid + 512 * k;
        const int4 v = *(const int4*)(pidx + (size_t)t0 * 128 + (size_t)q * 4);
        v2u o; o.x = (unsigned)v.x | ((unsigned)v.y << 16); o.y = (unsigned)v.z | ((unsigned)v.w << 16);
        *(v2u*)(lds + OFF + q * 8) = o; }
}
__device__ __forceinline__ void gatherA_stream(int c, int tile0, int tstep, int ntiles, const unsigned char* __restrict__ HQ,
                                               const int* __restrict__ pidx, const unsigned char* __restrict__ UT4, bf16* __restrict__ part, char* lds) {
    int tid = threadIdx.x; asm volatile("" : "+v"(tid));
    const int wid = tid >> 6, lane = tid & 63, r = lane >> 3, s = lane & 7;
    const int N = ntiles * 16;
    if (N <= 0) return;
    const unsigned char* base = UT4 + (size_t)c * 16384 * 128; const unsigned loff = 16u * (unsigned)s, l4 = 4u * (unsigned)lane;
    const unsigned char* hqc = HQ + (size_t)c * 16384 * 256; const unsigned char* pib = (const unsigned char*)pidx;
    bf16* partc = part + (size_t)c * 16384 * 128 + 8 * s + r;
    LAS unsigned char* ring = (LAS unsigned char*)lds + wid * 16384;
    LAS unsigned char* meta = (LAS unsigned char*)lds + 132096 + wid * 1536;
#define PEER_TOK(n) ((tile0 + ((n) >> 4) * tstep) * 128 + wid * 16 + ((n) & 15))
#define PEER_ISSUE_H(n) do { const unsigned t_ = (unsigned)PEER_TOK(n); \
        __builtin_amdgcn_global_load_lds((const unsigned*)(hqc + (t_ * 256u + l4)), (LAS unsigned*)(meta + ((n) & 1) * 256), 4, 0, 0); } while (0)
#define PEER_ISSUE_I(n) do { const unsigned t_ = (unsigned)PEER_TOK(n); \
        __builtin_amdgcn_global_load_lds((const unsigned*)(pib + (t_ * 512u + l4)), (LAS unsigned*)(meta + 512 + ((n) & 1) * 512), 4, 0, 0); \
        __builtin_amdgcn_global_load_lds((const unsigned*)(pib + (t_ * 512u + 256u + l4)), (LAS unsigned*)(meta + 512 + ((n) & 1) * 512 + 256), 4, 0, 0); } while (0)
#define PEER_LOAD_IDX(n) do { _Pragma("unroll") for (int i_ = 0; i_ < 16; ++i_) idxv[i_] = *(const LAS unsigned*)(meta + 512 + ((n) & 1) * 512 + (8 * i_ + r) * 4); } while (0)
#define PEER_ISSUE_ROW(i) __builtin_amdgcn_global_load_lds((const unsigned*)(base + (idxv[i] * 128u + loff)), (LAS unsigned*)(ring + (i) * 1024), 16, 0, 0)
#define PEER_READ_ROW(i) (*(const LAS v4u*)(ring + (i) * 1024 + lane * 16))
#define PEER_DOT_A(rw, i) do { int a_ = __builtin_amdgcn_sdot8((int)rw[0], (int)ha[0], 0, false), b_ = __builtin_amdgcn_sdot8((int)rw[0], (int)hb[0], 0, false); \
        a_ = __builtin_amdgcn_sdot8((int)rw[1], (int)ha[1], a_, false); b_ = __builtin_amdgcn_sdot8((int)rw[1], (int)hb[1], b_, false); \
        a_ = __builtin_amdgcn_sdot8((int)rw[2], (int)ha[2], a_, false); b_ = __builtin_amdgcn_sdot8((int)rw[2], (int)hb[2], b_, false); \
        a_ = __builtin_amdgcn_sdot8((int)rw[3], (int)ha[3], a_, false); b_ = __builtin_amdgcn_sdot8((int)rw[3], (int)hb[3], b_, false); \
        a_ = sum8_dpp_i(a_ * 16 + b_); \
        if ((i) < 8) res0 = (s == (i)) ? a_ : res0; else res1 = (s == (i) - 8) ? a_ : res1; } while (0)
#define PEER_VMWAIT(N) asm volatile("s_waitcnt vmcnt(" #N ")" ::: "memory")
#define PEER_LOAD_H(n) do { ha = *(const LAS v4u*)(meta + ((n) & 1) * 256 + 32 * s); hb = *(const LAS v4u*)(meta + ((n) & 1) * 256 + 32 * s + 16); } while (0)
    unsigned idxv[16]; v4u ha, hb, rcur, rnext;
    PEER_ISSUE_H(0); PEER_ISSUE_I(0); PEER_ISSUE_I(N > 1 ? 1 : 0);
    PEER_VMWAIT(0);
    PEER_LOAD_IDX(0);
#pragma unroll
    for (int i = 0; i < 16; ++i) PEER_ISSUE_ROW(i);
    PEER_VMWAIT(15);
    rcur = PEER_READ_ROW(0);
#pragma unroll 1
    for (int n = 0; n < N - 1; ++n) {
        int res0 = 0, res1 = 0;
        PEER_LOAD_IDX(n + 1);
        PEER_ISSUE_H(n + 1); { const int n2 = n + 2 < N ? n + 2 : N - 1; PEER_ISSUE_I(n2); }
        PEER_LOAD_H(n);
#pragma unroll
        for (int i = 0; i < 16; ++i) {
            if (i < 15) PEER_VMWAIT(17); else PEER_VMWAIT(14);
            rnext = PEER_READ_ROW((i + 1) & 15);
            PEER_DOT_A(rcur, i);
            asm volatile("s_waitcnt lgkmcnt(1)" ::: "memory");
            PEER_ISSUE_ROW(i);
            rcur = rnext;
        }
        bf16* prow = partc + (size_t)PEER_TOK(n) * 128; prow[0] = (bf16)f2bf((float)res0); prow[64] = (bf16)f2bf((float)res1);
    }
    {   int res0 = 0, res1 = 0;
        PEER_LOAD_H(N - 1);
        PEER_VMWAIT(14); rnext = PEER_READ_ROW(1);  PEER_DOT_A(rcur, 0);  rcur = rnext;
        PEER_VMWAIT(13); rnext = PEER_READ_ROW(2);  PEER_DOT_A(rcur, 1);  rcur = rnext;
        PEER_VMWAIT(12); rnext = PEER_READ_ROW(3);  PEER_DOT_A(rcur, 2);  rcur = rnext;
        PEER_VMWAIT(11); rnext = PEER_READ_ROW(4);  PEER_DOT_A(rcur, 3);  rcur = rnext;
        PEER_VMWAIT(10); rnext = PEER_READ_ROW(5);  PEER_DOT_A(rcur, 4);  rcur = rnext;
        PEER_VMWAIT(9);  rnext = PEER_READ_ROW(6);  PEER_DOT_A(rcur, 5);  rcur = rnext;
        PEER_VMWAIT(8);  rnext = PEER_READ_ROW(7);  PEER_DOT_A(rcur, 6);  rcur = rnext;
        PEER_VMWAIT(7);  rnext = PEER_READ_ROW(8);  PEER_DOT_A(rcur, 7);  rcur = rnext;
        PEER_VMWAIT(6);  rnext = PEER_READ_ROW(9);  PEER_DOT_A(rcur, 8);  rcur = rnext;
        PEER_VMWAIT(5);  rnext = PEER_READ_ROW(10); PEER_DOT_A(rcur, 9);  rcur = rnext;
        PEER_VMWAIT(4);  rnext = PEER_READ_ROW(11); PEER_DOT_A(rcur, 10); rcur = rnext;
        PEER_VMWAIT(3);  rnext = PEER_READ_ROW(12); PEER_DOT_A(rcur, 11); rcur = rnext;
        PEER_VMWAIT(2);  rnext = PEER_READ_ROW(13); PEER_DOT_A(rcur, 12); rcur = rnext;
        PEER_VMWAIT(1);  rnext = PEER_READ_ROW(14); PEER_DOT_A(rcur, 13); rcur = rnext;
        PEER_VMWAIT(0);  rnext = PEER_READ_ROW(15); PEER_DOT_A(rcur, 14); rcur = rnext;
        PEER_DOT_A(rcur, 15);
        bf16* prow = partc + (size_t)PEER_TOK(N - 1) * 128; prow[0] = (bf16)f2bf((float)res0); prow[64] = (bf16)f2bf((float)res1);
    }
#undef PEER_TOK
#undef PEER_ISSUE_H
#undef PEER_ISSUE_I
#undef PEER_LOAD_IDX
#undef PEER_ISSUE_ROW
#undef PEER_READ_ROW
#undef PEER_DOT_A
#undef PEER_VMWAIT
#undef PEER_LOAD_H
}
typedef int v2i32 __attribute__((ext_vector_type(2)));
typedef int v4i32 __attribute__((ext_vector_type(4)));
__device__ __forceinline__ void gatherB_stream(int c, int tile0, int tstep, int ntiles, float* out, const float* __restrict__ mod, const unsigned* __restrict__ pw,
                                               const unsigned char* __restrict__ VT4, char* lds) {
    int tid = threadIdx.x; asm volatile("" : "+v"(tid));
    const int wid = tid >> 6, lane = tid & 63, r = lane >> 3, g = lane >> 4, li = lane & 15;
    const int N = ntiles * 16;
    if (N <= 0) return;
    const int colb = 256 * c + 64 * g + li;
    float gt[2][4];
#pragma unroll
    for (int k = 0; k < 2; ++k) { const int tl = tile0 + (k < ntiles ? k : 0) * tstep; const float* gp = mod + (size_t)((tl * 128) >> 11) * 6144 + 5 * 1024 + colb;
#pragma unroll
        for (int u = 0; u < 4; ++u) gt[k][u] = gp[16 * u]; }
    asm volatile("s_waitcnt vmcnt(0)" ::: "memory");
#pragma unroll
    for (int k = 0; k < 2; ++k)
#pragma unroll
        for (int u = 0; u < 4; ++u) asm volatile("" : "+v"(gt[k][u]));
    const unsigned char* base = VT4 + (size_t)c * 16384 * 128; const unsigned l4 = 4u * (unsigned)lane;
    const unsigned loff0 = 16u * (unsigned)((lane & 7) ^ (r >> 1)), loff1 = loff0 ^ 64u;
    const unsigned char* pwb = (const unsigned char*)pw;
    LAS unsigned char* ring = (LAS unsigned char*)lds + wid * 16384;
    LAS unsigned char* meta = (LAS unsigned char*)lds + 132096 + wid * 512;
    LAS unsigned char* xslot = (LAS unsigned char*)lds + 136192 + wid * 1024;
    const unsigned char* xb = (const unsigned char*)(out + 256 * c);
    unsigned tra[8];
#pragma unroll
    for (int t = 0; t < 8; ++t) tra[t] = (unsigned)(g * 1024 + (li >> 1) * 128 + ((t ^ (li >> 2) ^ (4 * (g & 1))) * 16) + 8 * (li & 1));
    const int m4 = li & 3;
    const unsigned aoffs = (unsigned)((m4 == 1 ? 384 : 256) + 8 * g);
#define PEER_TOK(n) ((tile0 + ((n) >> 4) * tstep) * 128 + wid * 16 + ((n) & 15))
#define PEER_ISSUE_W(n) do { const unsigned t_ = (unsigned)PEER_TOK(n); \
        __builtin_amdgcn_global_load_lds((const unsigned*)(pwb + (t_ * 512u + l4)), (LAS unsigned*)(meta), 4, 0, 0); \
        __builtin_amdgcn_global_load_lds((const unsigned*)(pwb + (t_ * 512u + 256u + l4)), (LAS unsigned*)(meta + 256), 4, 0, 0); } while (0)
#define PEER_ISSUE_X(n) do { const unsigned t_ = (unsigned)PEER_TOK(n); \
        __builtin_amdgcn_global_load_lds((const unsigned*)(xb + ((size_t)t_ * 4096u + 4u * l4)), (LAS unsigned*)(xslot), 16, 0, 0); } while (0)
#define PEER_LOAD_IDX() do { _Pragma("unroll") for (int i_ = 0; i_ < 16; ++i_) idxv[i_] = *(const LAS unsigned short*)(meta + (8 * i_ + r) * 2); } while (0)
#define PEER_ISSUE_ROW(i) __builtin_amdgcn_global_load_lds((const unsigned*)(base + ((idxv[i] & 0x3fffu) * 128u + (((i) & 1) ? loff1 : loff0))), (LAS unsigned*)(ring + (i) * 1024), 16, 0, 0)
#define PEER_LOAD_A(AOP, WS) do { _Pragma("unroll") for (int q_ = 0; q_ < 2; ++q_) { const v2u a_ = *(const LAS v2u*)(meta + aoffs + 64 * q_), b_ = *(const LAS v2u*)(meta + aoffs + 64 * q_ + 32); \
            v4i32 z_; z_[0] = m4 < 2 ? (int)a_.x : 0; z_[1] = m4 < 2 ? (int)a_.y : 0; z_[2] = m4 < 2 ? (int)b_.x : 0; z_[3] = m4 < 2 ? (int)b_.y : 0; AOP[q_] = z_; } \
        const v2u d_ = *(const LAS v2u*)(meta); \
        const int kb_ = (int)(((d_.x >> 14) & 3u) | (((d_.x >> 30) & 3u) << 2) | (((d_.y >> 14) & 3u) << 4) | (((d_.y >> 30) & 3u) << 6)); \
        WS = __uint_as_float((unsigned)(255 - kb_) << 23); } while (0)
#define PEER_WIDEN(x, L, H) do { L = (int)((((unsigned)(x)) << 4) & 0xf0f0f0f0u); H = (int)(((unsigned)(x)) & 0xf0f0f0f0u); } while (0)
#define PEER_KSTEP_B(Q) do { _Pragma("unroll") for (int t_ = 0; t_ < 8; ++t_) { \
            const v2i32 b0_ = __builtin_amdgcn_ds_read_tr8_b64_v2i32((LAS v2i32*)(ring + (Q) * 8192 + tra[t_])); \
            const v2i32 b1_ = __builtin_amdgcn_ds_read_tr8_b64_v2i32((LAS v2i32*)(ring + (Q) * 8192 + 4096 + tra[t_])); \
            v4i32 lo_, hi_; PEER_WIDEN(b0_[0], lo_[0], hi_[0]); PEER_WIDEN(b0_[1], lo_[1], hi_[1]); PEER_WIDEN(b1_[0], lo_[2], hi_[2]); PEER_WIDEN(b1_[1], lo_[3], hi_[3]); \
            acc[2 * t_] = __builtin_amdgcn_mfma_i32_16x16x64_i8(aop[Q], lo_, acc[2 * t_], 0, 0, 0); \
            acc[2 * t_ + 1] = __builtin_amdgcn_mfma_i32_16x16x64_i8(aop[Q], hi_, acc[2 * t_ + 1], 0, 0, 0); } \
        asm volatile("s_waitcnt lgkmcnt(0)" ::: "memory"); } while (0)
#define PEER_VMWAIT(N) asm volatile("s_waitcnt vmcnt(" #N ")" ::: "memory")
#define PEER_FINISH_B(n) do { const int t_ = PEER_TOK(n); const bool k1_ = ((n) >> 4) != 0; \
        float* o_ = out + (size_t)t_ * 1024 + colb; \
        _Pragma("unroll") for (int u_ = 0; u_ < 4; ++u_) { \
            const v4i32 s_ = g == 0 ? acc[u_] : (g == 1 ? acc[4 + u_] : (g == 2 ? acc[8 + u_] : acc[12 + u_])); \
            const float x_ = *(const LAS float*)(xslot + (64 * g + 16 * u_ + li) * 4); \
            o_[16 * u_] = x_ + (k1_ ? gt[1][u_] : gt[0][u_]) * (((float)s_[0] + (float)s_[1] * (1.f / 128.f)) * wscale); } \
        asm volatile("s_waitcnt lgkmcnt(0)" ::: "memory"); \
        _Pragma("unroll") for (int q_ = 0; q_ < 16; ++q_) acc[q_] = (v4i32){0, 0, 0, 0}; } while (0)
    unsigned idxv[16]; v4i32 aop[2], aopn[2]; v4i32 acc[16]; float wscale, wscalen;
#pragma unroll
    for (int q = 0; q < 16; ++q) acc[q] = (v4i32){0, 0, 0, 0};
    PEER_ISSUE_W(0);
    PEER_VMWAIT(0);
    PEER_LOAD_IDX(); PEER_LOAD_A(aop, wscale);
    asm volatile("s_waitcnt lgkmcnt(0)" ::: "memory");
    PEER_ISSUE_W(N > 1 ? 1 : 0);
#pragma unroll
    for (int i = 0; i < 16; ++i) PEER_ISSUE_ROW(i);
    PEER_VMWAIT(16);
#pragma unroll 1
    for (int n = 0; n < N - 1; ++n) {
        PEER_LOAD_IDX(); PEER_LOAD_A(aopn, wscalen);
        asm volatile("s_waitcnt lgkmcnt(0)" ::: "memory");
        { const int n2 = n + 2 < N ? n + 2 : N - 1; PEER_ISSUE_W(n2); }
        PEER_ISSUE_X(n);
        PEER_VMWAIT(11); PEER_KSTEP_B(0);
        PEER_ISSUE_ROW(0);  PEER_ISSUE_ROW(1);  PEER_ISSUE_ROW(2);  PEER_ISSUE_ROW(3);  PEER_ISSUE_ROW(4);  PEER_ISSUE_ROW(5);  PEER_ISSUE_ROW(6);  PEER_ISSUE_ROW(7);
        PEER_VMWAIT(11); PEER_KSTEP_B(1);
        PEER_ISSUE_ROW(8);  PEER_ISSUE_ROW(9);  PEER_ISSUE_ROW(10); PEER_ISSUE_ROW(11); PEER_ISSUE_ROW(12); PEER_ISSUE_ROW(13); PEER_ISSUE_ROW(14); PEER_ISSUE_ROW(15);
        PEER_VMWAIT(16);
        PEER_FINISH_B(n);
        aop[0] = aopn[0]; aop[1] = aopn[1];
        wscale = wscalen;
    }
    {
        PEER_ISSUE_X(N - 1);
        PEER_VMWAIT(9); PEER_KSTEP_B(0);
        PEER_VMWAIT(1); PEER_KSTEP_B(1);
        PEER_VMWAIT(0);
        PEER_FINISH_B(N - 1);
    }
#undef PEER_TOK
#undef PEER_ISSUE_W
#undef PEER_ISSUE_X
#undef PEER_LOAD_IDX
#undef PEER_ISSUE_ROW
#undef PEER_LOAD_A
#undef PEER_WIDEN
#undef PEER_KSTEP_B
#undef PEER_VMWAIT
#undef PEER_FINISH_B
}
}
namespace mk {
#ifndef MK_CTX_IN_P1
#define MK_CTX_IN_P1 0
#endif
#ifndef MK_DUP
#define MK_DUP -1
#endif
constexpr int NWAVES = 8, NTHR = 512;
constexpr int D = 1024, NB = 8, L = 2048, CT = 256, LT = L + CT, INC = 3072, NMODC = 6 * D;
constexpr int M1 = NB * LT;
constexpr int M2 = NB * L;
constexpr float EPS = 1e-6f;
constexpr float C2 = 0.125f * 1.4426950408889634f;
constexpr size_t MiB = 1u << 20;
constexpr size_t WS_CTL = 0, CTL_ZERO_BYTES = 64 * 1024;
constexpr size_t WS_MOD = 1 * MiB;
constexpr size_t WS_TAB = WS_MOD + 256 * 1024;
constexpr size_t WS_ALPHA2 = WS_TAB + 512 * 1024;
constexpr size_t WS_BIASQ = WS_ALPHA2 + 32 * 1024;
constexpr size_t WS_SSQ = 2 * MiB;
constexpr size_t WS_WIN = 3 * MiB;
constexpr size_t WS_WOUT = 9 * MiB;
constexpr size_t WS_WQ = 11 * MiB;
constexpr size_t WS_SUBK = 15 * MiB;
constexpr size_t WS_PU = 16 * MiB;
constexpr size_t WS_PV = 32 * MiB;
constexpr size_t WS_SU = 48 * MiB, WS_SV = 49 * MiB;
constexpr size_t WS_PART = 116 * MiB;
constexpr size_t WS_A = 80 * MiB;
constexpr size_t WS_HB = WS_A, WS_OD = WS_A, WS_X1A = WS_A;
constexpr size_t WS_B = 116 * MiB;
constexpr size_t WS_RQ = WS_B;
constexpr size_t WS_RK = WS_RQ + 8 * MiB;
constexpr size_t WS_RV = WS_RK + 9 * MiB;
constexpr size_t WS_RG = WS_RV + 18 * MiB;
constexpr size_t WS_DQ = WS_RG + 16 * MiB;
constexpr size_t WS_DK = WS_DQ + 16 * MiB;
constexpr size_t WS_DV = WS_DK + 18 * MiB;
constexpr size_t WS_ST = 219 * MiB;
constexpr size_t WS_MIX = WS_DQ;
constexpr size_t WS_QP = WS_B;
constexpr size_t WS_HQ = 180 * MiB;
constexpr size_t WS_HS = 196 * MiB;
constexpr size_t WS_PIDX = 200 * MiB;
constexpr size_t WS_PGATE = 208 * MiB;
constexpr size_t WS_END = 237 * MiB;
constexpr int CW_BAR = 1024;
static_assert((CW_BAR + XCD_BAR_WORDS) * 4 <= (int)CTL_ZERO_BYTES, "barrier words inside the memset region");
constexpr int RING_BYTES = 131072, MISC_OFF = RING_BYTES + 320, LDS_BYTES = 147456;

struct Args { const float* in[19]; float* out; unsigned char* ws; int ph_lo, ph_hi; };

template <int R, bool SILU>
__device__ __forceinline__ void gemv_rows(const float* const (&src)[R], const float* __restrict__ W, int N, const float* __restrict__ bias, float* __restrict__ out, int out_stride, LAS float* lds) {
    LAS float* s = lds; LAS float* part = lds + R * 1024;
    const int tid = threadIdx.x;
    bool did = false;
    for (int cb = blockIdx.x; cb < N / 32; cb += gridDim.x) {
        if (!did) {
            for (int i = tid; i < R * 1024; i += NTHR) { const int r = i >> 10, k = i & 1023; float v = 0.f;
#pragma unroll
                for (int q = 0; q < R; ++q) if (q == r) v = src[q][k];
                s[i] = SILU ? v / (1.f + expf(-v)) : v; }
            __syncthreads(); did = true;
        }
        const int cc = tid & 31, ks = tid >> 5;
        float acc[R];
#pragma unroll
        for (int r = 0; r < R; ++r) acc[r] = 0.f;
        const float* wp = W + (size_t)(ks * 64) * N + cb * 32 + cc;
#pragma unroll
        for (int k0 = 0; k0 < 64; k0 += 16) {
            float w[16];
#pragma unroll
            for (int k = 0; k < 16; ++k) w[k] = wp[(size_t)(k0 + k) * N];
#pragma unroll
            for (int k = 0; k < 16; ++k)
#pragma unroll
                for (int r = 0; r < R; ++r) acc[r] += s[r * 1024 + ks * 64 + k0 + k] * w[k]; }
#pragma unroll
        for (int r = 0; r < R; ++r) part[(ks * R + r) * 32 + cc] = acc[r];
        __syncthreads();
        if (tid < R * 32) { const int r = tid >> 5, c2 = tid & 31; float t = 0.f;
#pragma unroll
            for (int q = 0; q < 16; ++q) t += part[(q * R + r) * 32 + c2];
            out[(size_t)r * out_stride + cb * 32 + c2] = t + (bias ? bias[cb * 32 + c2] : 0.f); }
        __syncthreads();
    }
}
__device__ __forceinline__ void transpose_item(const float* __restrict__ W, int K, int N, bf16* __restrict__ WT, int k0, int n0, int n_dst0, LAS float* scr, int lane) {
#pragma unroll 8
    for (int i = 0; i < 32; ++i) { const int kk = 2 * i + (lane >> 5); scr[kk * 33 + (lane & 31)] = W[(size_t)(k0 + kk) * N + n0 + (lane & 31)]; }
    LDS_WAIT(); asm volatile("" ::: "memory");
    const int c = lane & 7;
#pragma unroll
    for (int j = 0; j < 4; ++j) { const int n = (lane >> 3) + 8 * j; const LAS float* sp = scr + (8 * c) * 33 + n;
        v4u o; o.x = pk2(sp[0 * 33], sp[1 * 33]); o.y = pk2(sp[2 * 33], sp[3 * 33]); o.z = pk2(sp[4 * 33], sp[5 * 33]); o.w = pk2(sp[6 * 33], sp[7 * 33]);
        *(v4u*)(WT + (size_t)(n_dst0 + n) * K + k0 + 8 * c) = o; }
    LDS_WAIT(); asm volatile("" ::: "memory");
}
__host__ __device__ __forceinline__ int win_perm(int q_abs) { const int T = q_abs >> 8, q = q_abs & 255; return T * 256 + 128 * ((q >> 5) & 1) + 32 * (q >> 6) + (q & 31); }


struct EpiInProj {
    static constexpr bool PERM = false, AFTER_DRAIN = false;
    bf16 *RQ, *RK, *RV, *RG, *DQ, *DK, *DV; const float* tab; const float* qkg;
    __device__ __forceinline__ void operator()(const pg8::f32x4 (&acc)[2][2][4][2], const pg8::Unit& u, int wr, int wc, int fr, int fq) const {
        const int b = u.pm / 9, w = u.pm % 9, pn = u.pn; const bool isctx = (w == 0);
        const int grp = (pn == 0) ? 0 : (pn == 1) ? 1 : (pn < 4) ? 2 : (pn < 6) ? 3 : (pn < 8) ? 4 : (pn < 10) ? 5 : 6;
        f32x4 gq[2][2];
        if (grp == 4 || grp == 5) {
#pragma unroll
            for (int bj = 0; bj < 2; ++bj)
#pragma unroll
                for (int n = 0; n < 2; ++n) gq[bj][n] = *(const f32x4*)(qkg + (grp == 5 ? 64 : 0) + 32 * bj + 16 * n + 4 * fq);
        }
#pragma unroll
        for (int ai = 0; ai < 2; ++ai)
#pragma unroll
            for (int m = 0; m < 4; ++m) {
                const int rl = 128 * ai + 64 * wr + 16 * m + fr;
                const int tok = 256 * w + rl;
                const int l = tok - 256;
                f32x4 v[2][2];
#pragma unroll
                for (int bj = 0; bj < 2; ++bj)
#pragma unroll
                    for (int n = 0; n < 2; ++n) v[bj][n] = acc[ai][bj][m][n];
                if (grp == 4 || grp == 5) {
                    float ss = 0.f;
#pragma unroll
                    for (int bj = 0; bj < 2; ++bj)
#pragma unroll
                        for (int n = 0; n < 2; ++n) ss += (v[bj][n].x * v[bj][n].x + v[bj][n].y * v[bj][n].y) + (v[bj][n].z * v[bj][n].z + v[bj][n].w * v[bj][n].w);
                    ss += __shfl_xor(ss, 16); ss += __shfl_xor(ss, 32);
                    const float rstd = rsqrtf(ss * (1.f / 64.f) + EPS);
#pragma unroll
                    for (int bj = 0; bj < 2; ++bj)
#pragma unroll
                        for (int n = 0; n < 2; ++n) v[bj][n] = v[bj][n] * rstd * gq[bj][n];
                }
                const bool rope = (grp == 0 || grp == 1 || grp == 4 || grp == 5) && !isctx;
                if (rope) {
#pragma unroll
                    for (int bj = 0; bj < 2; ++bj) {
                        const f32x4 cs = *(const f32x4*)(tab + (size_t)l * 64 + 16 * bj + 4 * fq), sn = *(const f32x4*)(tab + (size_t)l * 64 + 32 + 16 * bj + 4 * fq);
                        const f32x4 x0 = v[bj][0], x1 = v[bj][1];
                        v[bj][0] = x0 * cs - x1 * sn; v[bj][1] = x1 * cs + x0 * sn;
                    }
                }
                float scl = 1.f; bf16* dst;
                if (grp == 0) { dst = RQ + ((size_t)(b * 4 + wc) * L + l) * 64; }
                else if (grp == 1) { dst = RK + ((size_t)(b * 4 + wc) * LT + tok) * 64; scl = 0.125f; }
                else if (grp == 2) { dst = RV + ((size_t)(b * 4 + 2 * (pn - 2) + (wc >> 1)) * LT + tok) * 128 + 64 * (wc & 1); }
                else if (grp == 3) { dst = RG + ((size_t)b * L + l) * 512 + 256 * (pn - 4) + 64 * wc; }
                else if (grp == 4) { dst = DQ + ((size_t)(b * 8 + 4 * (pn - 6) + wc) * L + l) * 64; scl = C2; }
                else if (grp == 5) { dst = DK + ((size_t)(b * 8 + 4 * (pn - 8) + wc) * LT + tok) * 64; }
                else { dst = DV + ((size_t)(b * 4 + 2 * (pn - 10) + (wc >> 1)) * LT + tok) * 128 + 64 * (wc & 1); }
#pragma unroll
                for (int bj = 0; bj < 2; ++bj)
#pragma unroll
                    for (int n = 0; n < 2; ++n) { const f32x4 o = v[bj][n] * scl; v2u pk; pk.x = pk2(o.x, o.y); pk.y = pk2(o.z, o.w);
                        *(v2u*)(dst + 32 * bj + 16 * n + 4 * fq) = pk; }
            }
    }
};
struct InSched {
    int xcd, slot, nslots;
    __device__ __forceinline__ void init(int G, int c) { xcd = c % 8; slot = c / 8; nslots = G / 8; }
#if MK_CTX_IN_P1
    __device__ __forceinline__ bool next(int i, pg8::Unit& u) const {
        const int idx = i * nslots + slot;
        if (idx >= 96) return false;
        u.pn = idx >> 3; u.pm = 9 * xcd + 1 + (idx & 7); return true;
    }
#else
    __device__ __forceinline__ bool next(int i, pg8::Unit& u) const {
        int idx = i * nslots + slot;
        if (idx >= 103) return false;
        int pn = 0, w = 0;
#pragma unroll
        for (int p = 0; p < 12; ++p) {
            const bool cn = (p == 1 || p == 2 || p == 3 || p >= 8); const int cnt = cn ? 9 : 8;
            if (idx >= 0 && idx < cnt) { pn = p; w = cn ? idx : idx + 1; idx = -1000; }
            else idx -= cnt;
        }
        u.pm = 9 * xcd + w; u.pn = pn; return true;
    }
#endif
    __device__ __forceinline__ void a_ready(const pg8::Unit&) const {}
    __device__ __forceinline__ void done(const pg8::Unit&) const {}
};
struct OneUnit {
    int pm, pn;
    __device__ __forceinline__ bool next(int i, pg8::Unit& u) const { if (i > 0) return false; u.pm = pm; u.pn = pn; return true; }
    __device__ __forceinline__ void a_ready(const pg8::Unit&) const {}
    __device__ __forceinline__ void done(const pg8::Unit&) const {}
};

struct EpiOutProj {
    static constexpr bool PERM = false, AFTER_DRAIN = false;
    static constexpr int MB = 2;
    const float* x; float* out; bf16* x1a; const float* mod; const float* alpha2; float* ssq;
    __device__ __forceinline__ void operator()(const pg8::f32x4 (&acc)[2][2][4][2], const pg8::Unit& u, int wr, int wc, int fr, int fq) const {
        const int b = u.pm >> 3;
        const int col0 = u.pn * 256 + wc * 32 + 4 * fq;
        f32x4 gt[2][2], al[2][2];
#pragma unroll
        for (int bj = 0; bj < 2; ++bj)
#pragma unroll
            for (int n = 0; n < 2; ++n) { gt[bj][n] = *(const f32x4*)(mod + (size_t)b * NMODC + 2 * D + col0 + bj * 128 + n * 16); al[bj][n] = *(const f32x4*)(alpha2 + (size_t)b * D + col0 + bj * 128 + n * 16); }
#pragma unroll
        for (int ai = 0; ai < 2; ++ai)
#pragma unroll
            for (int mh = 0; mh < 4; mh += MB) {
                f32x4 xv[MB][2][2];
#pragma unroll
                for (int mm = 0; mm < MB; ++mm) { const size_t row = (size_t)u.pm * 256 + ai * 128 + wr * 64 + (mh + mm) * 16 + fr;
#pragma unroll
                    for (int bj = 0; bj < 2; ++bj)
#pragma unroll
                        for (int n = 0; n < 2; ++n) xv[mm][bj][n] = *(const f32x4*)(x + row * D + col0 + bj * 128 + n * 16); }
#pragma unroll
                for (int mm = 0; mm < MB; ++mm) { const int m = mh + mm;
                    const size_t row = (size_t)u.pm * 256 + ai * 128 + wr * 64 + m * 16 + fr;
                    float ss = 0.f;
#pragma unroll
                    for (int bj = 0; bj < 2; ++bj)
#pragma unroll
                        for (int n = 0; n < 2; ++n) { const size_t off = row * D + col0 + bj * 128 + n * 16;
                            const f32x4 x1 = xv[mm][bj][n] + gt[bj][n] * acc[ai][bj][m][n];
                            *(f32x4*)(out + off) = x1; ss += (x1.x * x1.x + x1.y * x1.y) + (x1.z * x1.z + x1.w * x1.w);
                            const f32x4 xa = x1 * al[bj][n]; v2u pk; pk.x = pk2(xa.x, xa.y); pk.y = pk2(xa.z, xa.w); *(v2u*)(x1a + off) = pk; }
                    ss += __shfl_xor(ss, 16); ss += __shfl_xor(ss, 32);
                    if (fq == 0) ssq[row * 16 + u.pn * 4 + wc] = ss;
                }
            }
    }
};
struct EpiQuery {
    static constexpr bool PERM = true, AFTER_DRAIN = false;
    bf16* qp; const float* biasq; const float* ssq;
    __device__ __forceinline__ void operator()(const pg8::f32x4 (&acc)[2][2][4][2], const pg8::Unit& u, int wr, int wc, int fr, int fq) const {
        const int b = u.pm >> 3;
        const int col0 = u.pn * 256 + wc * 32 + 8 * fq;
        f32x4 bv[2][2];
#pragma unroll
        for (int bj = 0; bj < 2; ++bj)
#pragma unroll
            for (int n = 0; n < 2; ++n) bv[bj][n] = *(const f32x4*)(biasq + (size_t)b * 2048 + col0 + bj * 128 + 4 * n);
#pragma unroll
        for (int ai = 0; ai < 2; ++ai)
#pragma unroll
            for (int m = 0; m < 4; ++m) {
                const size_t row = (size_t)u.pm * 256 + ai * 128 + wr * 64 + m * 16 + fr;
                const f32x4 s0 = *(const f32x4*)(ssq + row * 16), s1 = *(const f32x4*)(ssq + row * 16 + 4), s2 = *(const f32x4*)(ssq + row * 16 + 8), s3 = *(const f32x4*)(ssq + row * 16 + 12);
                const float tot = ((s0.x + s0.y) + (s0.z + s0.w)) + ((s1.x + s1.y) + (s1.z + s1.w)) + ((s2.x + s2.y) + (s2.z + s2.w)) + ((s3.x + s3.y) + (s3.z + s3.w));
                const float rstd = rsqrtf(tot * (1.f / D) + EPS);
#pragma unroll
                for (int bj = 0; bj < 2; ++bj) { const f32x4 v0 = acc[ai][bj][m][0] * rstd + bv[bj][0], v1 = acc[ai][bj][m][1] * rstd + bv[bj][1];
                    v4u w; w.x = pk2(v0.x, v0.y); w.y = pk2(v0.z, v0.w); w.z = pk2(v1.x, v1.y); w.w = pk2(v1.z, v1.w);
                    const int kg = 4 * wc + fq;
                    *(v4u*)(qp + ((((row >> 5) * 8 + u.pn) * 2 + bj) * 16 + kg) * 256 + (row & 31) * 8) = w; }
            }
    }
};

struct EpiQuerySelect {
    static constexpr bool PERM = true, AFTER_DRAIN = true;
    const float* biasq; const float* ssq; const bf16* skf; int* pidx; float* pgate;
    __device__ __forceinline__ void fused(pg8::f32x4 (&acc)[2][2][4][2], const pg8::Unit& u, int wr, int wc, int fr, int fq, PG8_LAS unsigned char* lds, int wid, int lane) const {
        const int b = u.pm >> 3;
        const int col0 = u.pn * 256 + wc * 32 + 8 * fq, kg = 4 * wc + fq;
        f32x4 bv[2][2];
#pragma unroll
        for (int bj = 0; bj < 2; ++bj)
#pragma unroll
            for (int n = 0; n < 2; ++n) bv[bj][n] = *(const f32x4*)(biasq + (size_t)b * 2048 + col0 + bj * 128 + 4 * n);
#pragma unroll
        for (int ai = 0; ai < 2; ++ai)
#pragma unroll
            for (int m = 0; m < 4; ++m) {
                const int rl = ai * 128 + wr * 64 + m * 16 + fr; const size_t row = (size_t)u.pm * 256 + rl;
                const f32x4 s0 = *(const f32x4*)(ssq + row * 16), s1 = *(const f32x4*)(ssq + row * 16 + 4), s2 = *(const f32x4*)(ssq + row * 16 + 8), s3 = *(const f32x4*)(ssq + row * 16 + 12);
                const float tot = ((s0.x + s0.y) + (s0.z + s0.w)) + ((s1.x + s1.y) + (s1.z + s1.w)) + ((s2.x + s2.y) + (s2.z + s2.w)) + ((s3.x + s3.y) + (s3.z + s3.w));
                const float rstd = rsqrtf(tot * (1.f / D) + EPS);
#pragma unroll
                for (int bj = 0; bj < 2; ++bj) { const f32x4 v0 = acc[ai][bj][m][0] * rstd + bv[bj][0], v1 = acc[ai][bj][m][1] * rstd + bv[bj][1];
                    v4u w; w.x = pk2(v0.x, v0.y); w.y = pk2(v0.z, v0.w); w.z = pk2(v1.x, v1.y); w.w = pk2(v1.z, v1.w);
                    *(LAS v4u*)(lds + ((((rl >> 5) * 2 + bj) * 16 + kg) * 512 + (rl & 31) * 16)) = w; }
            }
        asm volatile("s_waitcnt lgkmcnt(0)" ::: "memory"); __builtin_amdgcn_s_barrier(); asm volatile("" ::: "memory");
        peer::select_wave_lds(skf + (size_t)u.pn * (2 * 4 * 8 * 2 * 32 * 8), (char*)lds, u.pn, pidx + (size_t)u.pm * 256 * 128, pgate + (size_t)u.pm * 256 * 128, wid, lane);
    }
};

__global__ void __launch_bounds__(NTHR, 2) mega(Args args) {
    extern __shared__ __attribute__((aligned(16))) unsigned char lds_raw[];
    LAS unsigned char* lds = (LAS unsigned char*)lds_raw;
    volatile LAS unsigned* MISC = (volatile LAS unsigned*)(lds + MISC_OFF);
    const int tid = threadIdx.x, lane = tid & 63, wave = __builtin_amdgcn_readfirstlane(tid >> 6);
    const int G = gridDim.x;
    const int gw = blockIdx.x * NWAVES + wave, NGW = G * NWAVES;
    unsigned char* ws = args.ws;
    const float* x = args.in[0]; const float* cnd = args.in[1]; const float* ctx = args.in[2]; const float* cctx = args.in[3];
    const float* w_mod = args.in[4]; const float* b_mod = args.in[5]; const float* g1 = args.in[6]; const float* g2 = args.in[7];
    const float* w_in = args.in[8]; const float* qkg = args.in[11];
    const float* w_out = args.in[14]; const float* wq = args.in[15];
    const float* subk = args.in[16]; const float* pu = args.in[17]; const float* pv = args.in[18];
    float* mod = (float*)(ws + WS_MOD); float* tab = (float*)(ws + WS_TAB); float* alpha2 = (float*)(ws + WS_ALPHA2); float* biasq = (float*)(ws + WS_BIASQ);
    bf16* WinT = (bf16*)(ws + WS_WIN); bf16* WoutT = (bf16*)(ws + WS_WOUT); bf16* WqT = (bf16*)(ws + WS_WQ); bf16* SubK = (bf16*)(ws + WS_SUBK);
    unsigned char* UT8 = ws + WS_PU; unsigned char* VT8 = ws + WS_PV; float* SUs = (float*)(ws + WS_SU); float* SVs = (float*)(ws + WS_SV); bf16* HB = (bf16*)(ws + WS_HB);

    for (int u = tid; u < (LDS_BYTES - RING_BYTES) / 4; u += NTHR) ((LAS unsigned*)(lds + RING_BYTES))[u] = 0u;
    __syncthreads();
    XcdBarrier bar = xcd_barrier_post((unsigned*)(ws + WS_CTL) + CW_BAR, MISC + 8);
    const int lo = args.ph_lo, hi = args.ph_hi;
#define IN(k) (lo <= (k) && (k) < hi)
#define SEAM(k) do { if (IN(k) && IN((k) + 1)) xcd_barrier(bar); } while (0)

    if (IN(0)) { for (int rep = 0; rep < (MK_DUP == 0 ? 2 : 1); ++rep) {
        {   const float* const rows[9] = {cnd, cnd + D, cnd + 2 * D, cnd + 3 * D, cnd + 4 * D, cnd + 5 * D, cnd + 6 * D, cnd + 7 * D, cctx};
            gemv_rows<9, true>(rows, w_mod, NMODC, b_mod, mod, NMODC, (LAS float*)lds); }
        LAS float* scr = (LAS float*)(lds + 57344 + wave * 8448);
        constexpr int I_IN = 16 * 96, I_OUT = 16 * 32, I_Q = 16 * 64;
        for (int it = gw; it < I_IN + I_OUT + I_Q; it += NGW) {
            int r = it;
            if (r < I_IN) { const int kb = r / 96, nb = r % 96; transpose_item(w_in, D, INC, WinT, 64 * kb, 32 * nb, win_perm(32 * nb), scr, lane); continue; } r -= I_IN;
            if (r < I_OUT) { const int kb = r / 32, nb = r % 32; transpose_item(w_out, D, D, WoutT, 64 * kb, 32 * nb, 32 * nb, scr, lane); continue; } r -= I_OUT;
            { const int kb = r / 64, nb = r % 64; transpose_item(wq, D, 2048, WqT, 64 * kb, 32 * nb, 32 * nb, scr, lane); }
        }
        const size_t gt = (size_t)blockIdx.x * NTHR + tid, GT = (size_t)G * NTHR;
        for (size_t i = gt; i < (size_t)8 * 2 * 128 * 128 / 8; i += GT) {
            const int ii = (int)i, hp = ii >> 11, n = (ii >> 4) & 127, c8 = ii & 15;
            const f32x4 a = *(const f32x4*)(subk + (size_t)ii * 8), bq4 = *(const f32x4*)(subk + (size_t)ii * 8 + 4);
            v4u o; o.x = pk2(a.x, a.y); o.y = pk2(a.z, a.w); o.z = pk2(bq4.x, bq4.y); o.w = pk2(bq4.z, bq4.w);
            *(v4u*)(SubK + (size_t)((((hp * 4 + (n >> 5)) * 8 + (c8 >> 1)) * 2 + (c8 & 1)) * 32 + (n & 31)) * 8) = o; }
        for (size_t i = gt; i < (size_t)L * 32; i += GT) {
            const int l = (int)(i >> 5), a = (int)((i >> 4) & 1), q = (int)(i & 15);
            const float f = powf(10000.f, -(float)q / 16.f); const float pos = a == 0 ? (float)(l >> 6) : (float)(l & 63); const float ang = pos * f;
            tab[l * 64 + a * 16 + q] = cosf(ang); tab[l * 64 + 32 + a * 16 + q] = sinf(ang);
        }
    if (MK_DUP == 0 && rep == 0) xcd_barrier(bar); } }
    SEAM(0);
    if (IN(1)) { for (int rep = 0; rep < (MK_DUP == 1 ? 2 : 1); ++rep) {
        const int NCTXWG = MK_CTX_IN_P1 ? 56 : G, nlat = G - NCTXWG;
        const bool ctxwg = nlat > 0 && (int)blockIdx.x >= nlat;
        const int cu_ = (int)blockIdx.x - nlat, cb_ = cu_ / 7, cj_ = cu_ % 7;
        const int mi0 = ctxwg ? wave : (int)blockIdx.x * NWAVES + wave, mstep = ctxwg ? NWAVES : (nlat > 0 ? nlat : G) * NWAVES, mcnt = ctxwg ? CT : (nlat > 0 ? M2 : M1);
        for (int mi = mi0; mi < mcnt; mi += 4 * mstep) {
            f32x4 v[4][4]; float ss[4]; int mrow_[4]; bool ok[4];
#pragma unroll
            for (int q = 0; q < 4; ++q) {
                const int mq = mi + q * mstep; ok[q] = mq < mcnt; const int mqq = ok[q] ? mq : mi;
                const int m = ctxwg ? cb_ * LT + mqq : (nlat > 0 ? (mqq >> 11) * LT + CT + (mqq & 2047) : mqq);
                mrow_[q] = m;
                const int b = m / LT, w = m % LT;
                const float* src = w < CT ? ctx + ((size_t)b * CT + w) * D : x + ((size_t)b * L + (w - CT)) * D;
                ss[q] = 0.f;
#pragma unroll
                for (int j2 = 0; j2 < 4; ++j2) { v[q][j2] = ((const f32x4*)src)[lane + 64 * j2]; }
            }
#pragma unroll
            for (int q = 0; q < 4; ++q) {
#pragma unroll
                for (int j2 = 0; j2 < 4; ++j2) ss[q] += (v[q][j2].x * v[q][j2].x + v[q][j2].y * v[q][j2].y) + (v[q][j2].z * v[q][j2].z + v[q][j2].w * v[q][j2].w);
                ss[q] = wave_sum(ss[q]);
            }
#pragma unroll
            for (int q = 0; q < 4; ++q) {
                if (!ok[q]) continue;
                const int m = mrow_[q]; const int b = m / LT, w = m % LT;
                const float* mrow = mod + (size_t)(w < CT ? 8 : b) * NMODC;
                const float rstd = rsqrtf(ss[q] * (1.f / D) + EPS);
#pragma unroll
                for (int j2 = 0; j2 < 4; ++j2) { const int k0 = 4 * lane + 256 * j2;
                    const f32x4 g = *(const f32x4*)(g1 + k0), sc = *(const f32x4*)(mrow + D + k0), sh = *(const f32x4*)(mrow + k0);
                    const f32x4 y = v[q][j2] * rstd * g; const f32x4 h = y * (sc + 1.f) + sh;
                    v2u pk; pk.x = pk2(h.x, h.y); pk.y = pk2(h.z, h.w);
                    *(v2u*)(HB + (size_t)m * D + k0) = pk; }
            }
        }
        if (ctxwg) {
            asm volatile("s_waitcnt vmcnt(0)" ::: "memory"); __syncthreads();
            const int pnl[7] = {1, 2, 3, 8, 9, 10, 11};
            int pn = 1;
#pragma unroll
            for (int q = 0; q < 7; ++q) if (q == cj_) pn = pnl[q];
            pg8::Gemm g{HB, WinT, M1, INC, D}; OneUnit S{9 * cb_, pn};
            EpiInProj E{(bf16*)(ws + WS_RQ), (bf16*)(ws + WS_RK), (bf16*)(ws + WS_RV), (bf16*)(ws + WS_RG), (bf16*)(ws + WS_DQ), (bf16*)(ws + WS_DK), (bf16*)(ws + WS_DV), tab, qkg};
            pg8::gemm_phase<EpiInProj, OneUnit, PG8_ALIGN, PG8_SP2>(lds, g, S, E);
            __syncthreads();
        }
        for (int i = blockIdx.x * NTHR + tid; i < NB * D; i += G * NTHR) { const int b = i >> 10, k = i & 1023; alpha2[i] = g2[k] * (1.f + mod[(size_t)b * NMODC + 4 * D + k]); }
        {   const float* const rows[8] = {mod + 3 * D, mod + NMODC + 3 * D, mod + 2 * NMODC + 3 * D, mod + 3 * NMODC + 3 * D, mod + 4 * NMODC + 3 * D, mod + 5 * NMODC + 3 * D, mod + 6 * NMODC + 3 * D, mod + 7 * NMODC + 3 * D};
            __syncthreads();
            gemv_rows<8, false>(rows, wq, 2048, nullptr, biasq, 2048, (LAS float*)lds); }
    if (MK_DUP == 1 && rep == 0) xcd_barrier(bar); } }
    SEAM(1);
    if (IN(2)) { for (int rep = 0; rep < (MK_DUP == 2 ? 2 : 1); ++rep) {
        __syncthreads();
        pg8::Gemm g{HB, WinT, M1, INC, D}; InSched S; S.init(G, (int)blockIdx.x);
        EpiInProj E{(bf16*)(ws + WS_RQ), (bf16*)(ws + WS_RK), (bf16*)(ws + WS_RV), (bf16*)(ws + WS_RG), (bf16*)(ws + WS_DQ), (bf16*)(ws + WS_DK), (bf16*)(ws + WS_DV), tab, qkg};
        pg8::gemm_phase<EpiInProj, InSched, PG8_ALIGN, PG8_SP2>(lds, g, S, E);
#if !MK_CTX_IN_P1
        {
            const int nslots = G >> 3, rr = 103 % nslots, xcd = (int)blockIdx.x & 7, slot = (int)blockIdx.x >> 3;
            const bool freewg = rr == 0 || slot >= rr;
            const int fidx = rr == 0 ? (int)blockIdx.x : (slot - rr) * 8 + xcd, nfree = rr == 0 ? G : (nslots - rr) * 8;
            if (freewg && rep == 0)
                for (int e = fidx * NWAVES + wave; e < 2 * 16384; e += nfree * NWAVES) { if (e < 16384) peer::cvt_row_i4(pu, UT8, SUs, e, lane); else peer::cvt_row_fp4(pv, VT8, SVs, e - 16384, lane); }
        }
#endif
    if (MK_DUP == 2 && rep == 0) xcd_barrier(bar); } }
    SEAM(2);
    if (IN(3)) { for (int rep = 0; rep < (MK_DUP == 3 ? 2 : 1); ++rep) {
        __syncthreads();
        const bf16* DQb = (const bf16*)(ws + WS_DQ); const bf16* DKb = (const bf16*)(ws + WS_DK); const bf16* DVb = (const bf16*)(ws + WS_DV); bf16* ODb = (bf16*)(ws + WS_OD);
        for (int idx = blockIdx.x; idx < 512; idx += G) {
            const int b = idx & 7, rest = idx >> 3, hp = rest >> 3, qb = rest & 7;
            att::attn_unit(DQb + ((size_t)(b * 8 + hp) * L + qb * 256) * 64, DKb + (size_t)(b * 8 + hp) * LT * 64, DVb + (size_t)(b * 4 + (hp >> 1)) * LT * 128,
                           ODb + ((size_t)(b * 8 + hp) * L + qb * 256) * 128, LT, (char*)lds_raw);
        }
        const float* decay = args.in[9];
        for (int idx = blockIdx.x; idx < 288; idx += G) {
            const int b = idx & 7, rest = idx >> 3, h = rest / 9, c = rest % 9;
            float* st = (float*)(ws + WS_ST) + ((size_t)((b * 4 + h) * 9 + c) * 2) * 8192;
            ret::state_unit((const bf16*)(ws + WS_RK) + ((size_t)(b * 4 + h) * LT + 256 * c) * 64, (const bf16*)(ws + WS_RV) + ((size_t)(b * 4 + h) * LT + 256 * c) * 128,
                            st, st + 8192, ret::log2_sigmoid(decay[h]), ret::log2_sigmoid(decay[4 + h]), (char*)lds_raw);
        }
    if (MK_DUP == 3 && rep == 0) xcd_barrier(bar); } }
    SEAM(3);
    if (IN(4)) { for (int rep = 0; rep < (MK_DUP == 4 ? 2 : 1); ++rep) {
        __syncthreads();
        const float* decay = args.in[9]; const float* ret_g = args.in[10]; const float* lamp = args.in[12]; const float* diff_g = args.in[13];
        bf16* MIX = (bf16*)(ws + WS_MIX);
        for (int idx = blockIdx.x; idx < 256; idx += G) {
            const int b = idx & 7, rest = idx >> 3, h = rest >> 3, blk = rest & 7, c = blk + 1;
            ret::out_unit((const bf16*)(ws + WS_RQ) + ((size_t)(b * 4 + h) * L + 256 * blk) * 64, (const bf16*)(ws + WS_RK) + ((size_t)(b * 4 + h) * LT + 256 * c) * 64,
                          (const bf16*)(ws + WS_RV) + ((size_t)(b * 4 + h) * LT + 256 * c) * 128, (const float*)(ws + WS_ST) + (size_t)(b * 4 + h) * 9 * 2 * 8192, c,
                          (const bf16*)(ws + WS_RG) + ((size_t)b * L + 256 * blk) * 512 + h * 128, ret_g + h * 128, MIX + ((size_t)b * L + 256 * blk) * D + h * 128,
                          ret::log2_sigmoid(decay[h]), ret::log2_sigmoid(decay[4 + h]), (char*)lds_raw);
        }
        {
            float a = lamp[lane] * lamp[64 + lane], b2 = lamp[128 + lane] * lamp[192 + lane];
            a = wave_sum(a); b2 = wave_sum(b2);
            const float lam_init = 0.2f, lam = expf(a) - expf(b2) + lam_init;
            const bf16* ODb = (const bf16*)(ws + WS_OD);
            const int h = lane >> 4, e0 = (lane & 15) * 8;
            const f32x4 g0 = *(const f32x4*)(diff_g + h * 128 + e0), g1v = *(const f32x4*)(diff_g + h * 128 + e0 + 4);
            for (int t0 = gw; t0 < M2; t0 += 4 * NGW) {
                v4u p0[4], p1[4];
#pragma unroll
                for (int u = 0; u < 4; ++u) { const int t = t0 + u * NGW < M2 ? t0 + u * NGW : t0; const int b = t >> 11, l = t & 2047;
                    p0[u] = *(const v4u*)(ODb + ((size_t)(b * 8 + 2 * h) * L + l) * 128 + e0); p1[u] = *(const v4u*)(ODb + ((size_t)(b * 8 + 2 * h + 1) * L + l) * 128 + e0); }
#pragma unroll
                for (int u = 0; u < 4; ++u) {
                    const int t = t0 + u * NGW;
                    float y[8]; float ss = 0.f;
#pragma unroll
                    for (int j = 0; j < 4; ++j) {
                        y[2 * j] = __builtin_bit_cast(float, p0[u][j] << 16) - lam * __builtin_bit_cast(float, p1[u][j] << 16);
                        y[2 * j + 1] = __builtin_bit_cast(float, p0[u][j] & 0xffff0000u) - lam * __builtin_bit_cast(float, p1[u][j] & 0xffff0000u);
                        ss += y[2 * j] * y[2 * j] + y[2 * j + 1] * y[2 * j + 1]; }
                    ss += __shfl_xor(ss, 1); ss += __shfl_xor(ss, 2); ss += __shfl_xor(ss, 4); ss += __shfl_xor(ss, 8);
                    const float rstd = rsqrtf(ss * (1.f / 128.f) + EPS) * (1.f - lam_init);
                    v4u o; o.x = pk2(y[0] * rstd * g0.x, y[1] * rstd * g0.y); o.y = pk2(y[2] * rstd * g0.z, y[3] * rstd * g0.w);
                    o.z = pk2(y[4] * rstd * g1v.x, y[5] * rstd * g1v.y); o.w = pk2(y[6] * rstd * g1v.z, y[7] * rstd * g1v.w);
                    if (t < M2) *(v4u*)(MIX + (size_t)t * D + 512 + h * 128 + e0) = o;
                }
            }
        }
    if (MK_DUP == 4 && rep == 0) xcd_barrier(bar); } }
    SEAM(4);
    if (IN(5)) { for (int rep = 0; rep < (MK_DUP == 5 ? 2 : 1); ++rep) {
        __syncthreads();
        pg8::Gemm g{(const bf16*)(ws + WS_MIX), WoutT, M2, D, D}; pg8::StaticOrder S; S.init(M2, D, G, (int)blockIdx.x);
        EpiOutProj E{x, args.out, (bf16*)(ws + WS_X1A), mod, alpha2, (float*)(ws + WS_SSQ)};
        pg8::gemm_phase<EpiOutProj, pg8::StaticOrder, PG8_ALIGN, PG8_SP2>(lds, g, S, E);
    if (MK_DUP == 5 && rep == 0) xcd_barrier(bar); } }
    SEAM(5);
    if (IN(6)) { for (int rep = 0; rep < (MK_DUP == 6 ? 2 : 1); ++rep) {
        pg8::Gemm g{(const bf16*)(ws + WS_X1A), WqT, M2, 2048, D}; pg8::StaticOrder S0; S0.init(M2, 2048, G, (int)blockIdx.x);
        EpiQuerySelect E{biasq, (const float*)(ws + WS_SSQ), SubK, (int*)(ws + WS_PIDX), (float*)(ws + WS_PGATE)};
        for (int i = 0; ; ++i) {
            pg8::Unit u; if (!S0.next(i, u)) break;
            __syncthreads();
            OneUnit S{u.pm, u.pn};
            pg8::gemm_phase<EpiQuerySelect, OneUnit, false, PG8_SP2>(lds, g, S, E);
            peer::quant_h2_wave(u.pm * 256 + (u.pn & 1) * 128 + wave * 16, u.pn >> 1, (const bf16*)(ws + WS_X1A), (const float*)(ws + WS_SSQ), mod, ws + WS_HQ, (float*)(ws + WS_HS), lane);
        }
    if (MK_DUP == 6 && rep == 0) xcd_barrier(bar); } }
    SEAM(6);
    if (IN(8)) { for (int rep = 0; rep < (MK_DUP == 8 ? 2 : 1); ++rep) {
        __syncthreads();
        const int c = blockIdx.x & 3, half = (blockIdx.x >> 2) & 1, nj = G >> 3, j = blockIdx.x >> 3;
        peer::gatherA_stream(c, half * (M2 / 256) + j, nj, (M2 / 256 - j + nj - 1) / nj, ws + WS_HQ, (const int*)(ws + WS_PIDX), UT8, (bf16*)(ws + WS_PART), (char*)lds_raw);
        __syncthreads();
    if (MK_DUP == 8 && rep == 0) xcd_barrier(bar); } }
    SEAM(8);
    if (IN(9)) {
        const bf16* part = (const bf16*)(ws + WS_PART); const int* pidx = (const int*)(ws + WS_PIDX); float* pg = (float*)(ws + WS_PGATE);
        for (size_t p4 = (size_t)blockIdx.x * NTHR + tid; p4 < (size_t)M2 * 128 / 4; p4 += (size_t)G * NTHR) {
            const size_t p = p4 * 4;
            float d0 = 0.f, d1 = 0.f, d2 = 0.f, d3 = 0.f;
#pragma unroll
            for (int cc = 0; cc < 4; ++cc) { const v2u w = *(const v2u*)(part + (size_t)cc * M2 * 128 + p); const float hs = ((const float*)(ws + WS_HS))[(size_t)cc * M2 + (p >> 7)];
                d0 = fmaf(__builtin_bit_cast(float, w.x << 16), hs, d0); d1 = fmaf(__builtin_bit_cast(float, w.x & 0xffff0000u), hs, d1);
                d2 = fmaf(__builtin_bit_cast(float, w.y << 16), hs, d2); d3 = fmaf(__builtin_bit_cast(float, w.y & 0xffff0000u), hs, d3); }
            const int4 e = *(const int4*)(pidx + p); const f32x4 g = *(const f32x4*)(pg + p);
            f32x4 o;
            o.x = peer::gelu_exact(d0 * SUs[e.x]) * g.x * SVs[e.x]; o.y = peer::gelu_exact(d1 * SUs[e.y]) * g.y * SVs[e.y];
            o.z = peer::gelu_exact(d2 * SUs[e.z]) * g.z * SVs[e.z]; o.w = peer::gelu_exact(d3 * SUs[e.w]) * g.w * SVs[e.w];
            float am = fmaxf(fmaxf(fabsf(o.x), fabsf(o.y)), fmaxf(fabsf(o.z), fabsf(o.w)));
#pragma unroll
            for (int sh = 1; sh < 32; sh <<= 1) am = fmaxf(am, __shfl_xor(am, sh));
            const int ex = (int)((__float_as_uint(am) >> 23) & 0xffu) - 127;
            int kk = am > 0.f ? 6 - ex : 0; kk = kk > 100 ? 100 : (kk < -100 ? -100 : kk);
            const float S = __uint_as_float((unsigned)(127 + kk) << 23);
            const float a0 = o.x * S, a1 = o.y * S, a2 = o.z * S, a3 = o.w * S;
            const float h0 = fmaxf(fminf(rintf(a0), 127.f), -127.f), h1 = fmaxf(fminf(rintf(a1), 127.f), -127.f), h2 = fmaxf(fminf(rintf(a2), 127.f), -127.f), h3 = fmaxf(fminf(rintf(a3), 127.f), -127.f);
            const int hi = ((int)h0 & 0xff) | (((int)h1 & 0xff) << 8) | (((int)h2 & 0xff) << 16) | ((int)h3 << 24);
            const int l0 = (int)fmaxf(fminf(rintf((a0 - h0) * 128.f), 127.f), -127.f), l1 = (int)fmaxf(fminf(rintf((a1 - h1) * 128.f), 127.f), -127.f), l2 = (int)fmaxf(fminf(rintf((a2 - h2) * 128.f), 127.f), -127.f), l3 = (int)fmaxf(fminf(rintf((a3 - h3) * 128.f), 127.f), -127.f);
            const int lo = (l0 & 0xff) | ((l1 & 0xff) << 8) | ((l2 & 0xff) << 16) | (l3 << 24);
            const int a = (int)(p4 & 31); const unsigned kb = (unsigned)(kk + 128);
            unsigned i0 = (unsigned)e.x, i1 = (unsigned)e.y, i2 = (unsigned)e.z, i3 = (unsigned)e.w;
            if (a == 0) { i0 |= (kb & 3u) << 14; i1 |= ((kb >> 2) & 3u) << 14; i2 |= ((kb >> 4) & 3u) << 14; i3 |= ((kb >> 6) & 3u) << 14; }
            unsigned char* row = (unsigned char*)pg + (p4 >> 5) * 512;
            v2u iw; iw.x = i0 | (i1 << 16); iw.y = i2 | (i3 << 16);
            *(v2u*)(row + 8 * a) = iw; *(unsigned*)(row + 256 + 4 * a) = (unsigned)hi; *(unsigned*)(row + 384 + 4 * a) = (unsigned)lo;
        }
    }
    SEAM(9);
    if (IN(10)) {
        __syncthreads();
        const int c = blockIdx.x & 3, half = (blockIdx.x >> 2) & 1, nj = G >> 3, j = blockIdx.x >> 3;
        {   const int nt = (M2 / 256 - j + nj - 1) / nj;
            for (int k0 = 0; k0 < nt; k0 += 2) {
                peer::gatherB_stream(c, half * (M2 / 256) + j + k0 * nj, nj, nt - k0 < 2 ? nt - k0 : 2, args.out, mod, (const unsigned*)(ws + WS_PGATE), VT8, (char*)lds_raw);
                __syncthreads(); } }
    }
#undef IN
#undef SEAM
}
}

#ifndef MK_N_LAUNCHES
#define MK_N_LAUNCHES 1
#endif
extern "C" void kernel_launch(void* const* d_in, const int* in_sizes, int n_in, void* d_out, int out_size, void* d_ws, size_t ws_size, hipStream_t stream) {
    static int grid = 0;
    if (grid == 0) {
        int dev = 0, cus = 0, per_cu = 0;
        if (n_in != 19 || out_size != mk::M2 * mk::D || ws_size < mk::WS_END) { fprintf(stderr, "kernel_launch: unexpected shapes (n_in %d out %d ws %zu)\n", n_in, out_size, ws_size); grid = -1; return; }
        if (hipGetDevice(&dev) != hipSuccess || hipDeviceGetAttribute(&cus, hipDeviceAttributeMultiprocessorCount, dev) != hipSuccess) { grid = -1; return; }
        if (hipFuncSetAttribute((const void*)mk::mega, hipFuncAttributeMaxDynamicSharedMemorySize, mk::LDS_BYTES) != hipSuccess) { fprintf(stderr, "kernel_launch: hipFuncSetAttribute failed\n"); grid = -1; return; }
        if (hipOccupancyMaxActiveBlocksPerMultiprocessor(&per_cu, (const void*)mk::mega, mk::NTHR, mk::LDS_BYTES) != hipSuccess || per_cu < 1) { fprintf(stderr, "kernel_launch: occupancy query says %d blocks per CU\n", per_cu); grid = -1; return; }
        (void)hipGetLastError();
        grid = (cus / 8) * 8;
    }
    if (grid < 0) return;
    (void)in_sizes;
    unsigned char* wsb = (unsigned char*)d_ws;
    (void)hipMemsetAsync(wsb + mk::WS_CTL, 0, mk::CTL_ZERO_BYTES, stream);
#ifdef PROBE_MEMSET2
    (void)hipMemsetAsync(wsb + mk::WS_CTL, 0, mk::CTL_ZERO_BYTES, stream);
#endif
    mk::Args a{};
    for (int i = 0; i < 19; ++i) a.in[i] = (const float*)d_in[i];
    a.out = (float*)d_out; a.ws = wsb;
    if (MK_N_LAUNCHES == 1) { a.ph_lo = 0; a.ph_hi = 11; hipLaunchKernelGGL(mk::mega, dim3(grid), dim3(mk::NTHR), mk::LDS_BYTES, stream, a); }
    else for (int ph = 0; ph < 11; ++ph) { a.ph_lo = ph; a.ph_hi = ph + 1; hipLaunchKernelGGL(mk::mega, dim3(grid), dim3(mk::NTHR), mk::LDS_BYTES, stream, a); }
}
```

```cpp
#include <hip/hip_runtime.h>
#include <cstdio>
#include <cstdint>
#include <math.h>
#define GAS __attribute__((address_space(1)))
#define LAS __attribute__((address_space(3)))
typedef unsigned short bf16;
typedef unsigned v4u __attribute__((ext_vector_type(4)));
typedef unsigned v2u __attribute__((ext_vector_type(2)));
typedef float f32x4 __attribute__((ext_vector_type(4)));
typedef float f32x16 __attribute__((ext_vector_type(16)));
typedef short bf16x8 __attribute__((ext_vector_type(8)));
typedef short s16x4 __attribute__((ext_vector_type(4)));
#define LDS_WAIT() asm volatile("s_waitcnt lgkmcnt(0)" ::: "memory")
#define VM_WAIT() asm volatile("s_waitcnt vmcnt(0)" ::: "memory")
__device__ __forceinline__ unsigned f2bf(float f) { unsigned u = __builtin_bit_cast(unsigned, f); return (u + 0x7fffu + ((u >> 16) & 1u)) >> 16; }
__device__ __forceinline__ unsigned pk2(float lo, float hi) { return f2bf(lo) | (f2bf(hi) << 16); }
__device__ __forceinline__ float bf2f(unsigned short h) { return __builtin_bit_cast(float, (unsigned)h << 16); }
__device__ __forceinline__ float wave_sum(float v) {
#pragma unroll
    for (int o = 1; o < 64; o <<= 1) v += __shfl_xor(v, o);
    return v;
}
#define XB_TMO      128
#define XB_XCNT(j)  (256  + 64 * (j))
#define XB_XSUB(j)  (1280 + 64 * (j))
#define XB_XGEN(j)  (2304 + 64 * (j))
#define XB_TOP      3328
#define XB_TOPGEN   3392
#define XCD_BAR_WORDS 3456
#define XB_SPIN_CAP (1u << 18)

__device__ __forceinline__ unsigned xb_ld(unsigned* p)              { return __hip_atomic_load(p, __ATOMIC_RELAXED, __HIP_MEMORY_SCOPE_AGENT); }
__device__ __forceinline__ unsigned xb_add(unsigned* p, unsigned v) { return __hip_atomic_fetch_add(p, v, __ATOMIC_RELAXED, __HIP_MEMORY_SCOPE_AGENT); }
__device__ __forceinline__ unsigned xb_xcc_id() { return (unsigned)__builtin_amdgcn_s_getreg((3 << 11) | 20) & 0xFu; }
#define XB_SPIN(cond, bar) do { unsigned _sp = 0; while (cond) { __builtin_amdgcn_s_sleep(1); \
    if ((++_sp & 255u) == 0u) { if (xb_ld(&(bar)[XB_TMO])) break; if (_sp > XB_SPIN_CAP) { atomicAdd(&(bar)[XB_TMO], 1u); break; } } } } while (0)

struct XcdBarrier {
    unsigned* bar; unsigned x;
    volatile LAS unsigned* st;
};

__device__ __forceinline__ XcdBarrier xcd_barrier_post(unsigned* bar, volatile LAS unsigned* st) {
    XcdBarrier b; b.bar = bar; b.x = xb_xcc_id(); b.st = st;
    if (threadIdx.x == 0) (void)xb_add(&bar[XB_XCNT(b.x)], 1u);
    return b;
}
__device__ __forceinline__ void xcd_barrier_complete(unsigned* bar, unsigned x, unsigned& nloc, unsigned& nx) {
    const unsigned G = gridDim.x * gridDim.y * gridDim.z;
    unsigned sum, cnt, mine, sp = 0u;
    for (;;) {
        sum = 0u; cnt = 0u; mine = 0u;
#pragma unroll
        for (unsigned j = 0; j < 16; ++j) { const unsigned c = xb_ld(&bar[XB_XCNT(j)]); sum += c; cnt += (c > 0u) ? 1u : 0u; mine = (j == x) ? c : mine; }
        if (sum == G) break;
        __builtin_amdgcn_s_sleep(1);
        if ((++sp & 255u) == 0u) { if (xb_ld(&bar[XB_TMO])) break; if (sp > XB_SPIN_CAP) { atomicAdd(&bar[XB_TMO], 1u); break; } }
    }
    nloc = mine > 0u ? mine : 1u; nx = cnt > 0u ? cnt : 1u;
}

__device__ __forceinline__ void xcd_barrier(const XcdBarrier& b) {
    asm volatile("s_waitcnt vmcnt(0)" ::: "memory");
    __syncthreads();
    if (threadIdx.x == 0) {
        unsigned* bar = b.bar;
        __builtin_amdgcn_s_waitcnt(0);
        unsigned nloc = b.st[0], nx = b.st[1];
        if (nloc == 0u) { xcd_barrier_complete(bar, b.x, nloc, nx); b.st[0] = nloc; b.st[1] = nx; }
        const unsigned old = xb_add(&bar[XB_XSUB(b.x)], 1u);
        const unsigned gen = old / nloc;
        if (old + 1u == (gen + 1u) * nloc) {
            __builtin_amdgcn_fence(__ATOMIC_RELEASE, "agent");
            asm volatile("s_waitcnt vmcnt(0)" ::: "memory");
            const unsigned og = xb_add(&bar[XB_TOP], 1u);
            const unsigned tg = og / nx;
            if (og + 1u == (tg + 1u) * nx) xb_add(&bar[XB_TOPGEN], 1u);
            else XB_SPIN(xb_ld(&bar[XB_TOPGEN]) == tg, bar);
            __builtin_amdgcn_fence(__ATOMIC_ACQUIRE, "agent");
            xb_add(&bar[XB_XGEN(b.x)], 1u);
            asm volatile("s_waitcnt vmcnt(0)" ::: "memory");
        } else {
            XB_SPIN(xb_ld(&bar[XB_XGEN(b.x)]) == gen, bar);
            __builtin_amdgcn_fence(__ATOMIC_ACQUIRE, "agent");
            asm volatile("s_waitcnt vmcnt(0)" ::: "memory");
        }
    }
    __syncthreads();
}
namespace pg8 {
#define PG8_LAS __attribute__((address_space(3)))
typedef unsigned short bf16_t;
typedef short bf16x8 __attribute__((ext_vector_type(8)));
typedef float f32x4 __attribute__((ext_vector_type(4)));
typedef unsigned u32x4 __attribute__((ext_vector_type(4)));
constexpr int BM = 256, BK = 64, HALF = 128, HTB = HALF * BK * 2  , STAGE_BYTES = 8 * HTB, NXCD = 8, WGM = 8;

__host__ __device__ __forceinline__ int lds_byte(int r, int c) { const int st = (r >> 4) * 2 + (c >> 5), rr = r & 15, cc = c & 31, ob = rr * 64 + cc * 2; return st * 1024 + (ob ^ (((ob >> 9) & 1) << 5)); }
__host__ __device__ __forceinline__ void stage_rc(int b, int& R, int& C) { const int st = b / 1024, sb = b % 1024, swz = sb ^ (((sb >> 9) & 1) << 5); R = (st >> 1) * 16 + swz / 64; C = (st & 1) * 32 + (swz % 64) / 2; }
__host__ __device__ __forceinline__ int perm32(int rho) { const int n = rho >> 4, i = rho & 15; return 8 * (i >> 2) + 4 * n + (i & 3); }

struct Unit { int pm, pn; };
struct Gemm { const bf16_t* A; const bf16_t* Bt; int M, N, K; };

struct StaticOrder {
    int nM, nN, nwg, G, c;
    __host__ __device__ void init(int M, int N, int G_, int c_) { nM = M / BM; nN = N / BM; nwg = nM * nN; G = G_; c = c_; }
    __host__ __device__ bool next(int i, Unit& u) const {
        const long L = (long)i * G + c; if (L >= nwg) return false;
        int wgid = (int)L; { const int q = nwg / NXCD, r = nwg % NXCD, xcd = wgid % NXCD, off = wgid / NXCD; wgid = (xcd < r ? xcd * (q + 1) : r * (q + 1) + (xcd - r) * q) + off; }
        const int nig = WGM * nN, gid = wgid / nig, fm = gid * WGM, gsz = (nM - fm) < WGM ? (nM - fm) : WGM;
        u.pm = fm + ((wgid % nig) % gsz); u.pn = (wgid % nig) / gsz; return true;
    }
    __device__ __forceinline__ void a_ready(const Unit&) const {}
    __device__ __forceinline__ void done(const Unit&) const {}
};

__device__ __forceinline__ unsigned cvt_pk_bf16(float lo, float hi) { unsigned r; asm volatile("v_cvt_pk_bf16_f32 %0, %1, %2" : "=v"(r) : "v"(lo), "v"(hi)); return r; }
typedef float f32x2 __attribute__((ext_vector_type(2)));
__device__ __forceinline__ f32x2 gelu_pk(f32x2 v) {
    const f32x2 av = __builtin_elementwise_abs(v), d = av * 0.2316418882f + 1.0f;
    f32x2 t; t.x = __builtin_amdgcn_rcpf(d.x); t.y = __builtin_amdgcn_rcpf(d.y);
    f32x2 q = t * 0.5307027145f + (-0.7265760135f); q = q * t + 0.7107068705f; q = q * t + (-0.142248368f); q = q * t + 0.127414796f; q = q * t;
    const f32x2 s = (v * v) * (-0.72134752044f);
    f32x2 e; e.x = __builtin_amdgcn_exp2f(s.x); e.y = __builtin_amdgcn_exp2f(s.y);
    const f32x2 m = v * (q * e), r = v - m;
    f32x2 o; o.x = v.x < 0.f ? m.x : r.x; o.y = v.y < 0.f ? m.y : r.y; return o;
}

template <int ACT  > struct EpiBf16 {
    static constexpr bool PERM = true, AFTER_DRAIN = false; static_assert(ACT == 0 || ACT == 1, "EpiBf16: ACT is 0 (none) or 1 (gelu_pk)");
    bf16_t* O; int ldc; const float* bias; int split_cols; size_t split_stride; float scale0;
    __device__ __forceinline__ void operator()(const f32x4 (&acc)[2][2][4][2], const Unit& u, int wr, int wc, int fr, int fq) const {
        const int row0 = u.pm * BM + wr * 64 + fr; int colt = u.pn * BM; bf16_t* base = O;
        float sc = 1.f; if (split_cols) { const int t = colt / split_cols; base += (size_t)t * split_stride; colt -= t * split_cols; if (t == 0) sc = scale0; }
        const int col0 = colt + wc * 32 + 8 * fq, bcol0 = u.pn * BM + wc * 32 + 8 * fq;
        f32x4 bv[2][2];
#pragma unroll
        for (int bj = 0; bj < 2; ++bj)
#pragma unroll
            for (int n = 0; n < 2; ++n) bv[bj][n] = bias ? *(const f32x4*)(bias + bcol0 + bj * HALF + 4 * n) : (f32x4){0.f, 0.f, 0.f, 0.f};
#pragma unroll
        for (int ai = 0; ai < 2; ++ai)
#pragma unroll
            for (int m = 0; m < 4; ++m) { bf16_t* rowp = base + (size_t)(row0 + ai * HALF + m * 16) * ldc + col0;
#pragma unroll
                for (int bj = 0; bj < 2; ++bj) { f32x4 v0 = acc[ai][bj][m][0] + bv[bj][0], v1 = acc[ai][bj][m][1] + bv[bj][1];
                    if (ACT == 1) { f32x2 a = gelu_pk((f32x2){v0[0], v0[1]}), b = gelu_pk((f32x2){v0[2], v0[3]}), c = gelu_pk((f32x2){v1[0], v1[1]}), d = gelu_pk((f32x2){v1[2], v1[3]});
                        v0 = (f32x4){a.x, a.y, b.x, b.y}; v1 = (f32x4){c.x, c.y, d.x, d.y}; }
                    v0 = v0 * sc; v1 = v1 * sc; u32x4 w; w.x = cvt_pk_bf16(v0[0], v0[1]); w.y = cvt_pk_bf16(v0[2], v0[3]); w.z = cvt_pk_bf16(v1[0], v1[1]); w.w = cvt_pk_bf16(v1[2], v1[3]);
                    *(u32x4*)(rowp + bj * HALF) = w; } }
    }
};

struct PanelStats {
    unsigned* xbuf;
    unsigned* cnt;
    unsigned* tmo;
    int ntn; float eps;
    unsigned code;
    __device__ __forceinline__ bool run(const f32x4 (&v)[2][2][4][2], const Unit& u, int wr, int wc, int fr, int fq, PG8_LAS unsigned char* lds, int wid, int lane) const {
        typedef float f32x2v __attribute__((ext_vector_type(2)));
        PG8_LAS f32x2v* P = (PG8_LAS f32x2v*)lds;
        PG8_LAS f32x2v* S = (PG8_LAS f32x2v*)(lds + 8192);
        PG8_LAS unsigned* flag = (PG8_LAS unsigned*)(lds + 8192 + 2048);
#pragma unroll
        for (int ai = 0; ai < 2; ++ai)
#pragma unroll
            for (int m = 0; m < 4; ++m) {
                float s = 0.f;
#pragma unroll
                for (int bj = 0; bj < 2; ++bj)
#pragma unroll
                    for (int n = 0; n < 2; ++n) { const f32x4 x = v[ai][bj][m][n]; s += (x[0] + x[1]) + (x[2] + x[3]); }
                s += __shfl_xor(s, 16); s += __shfl_xor(s, 32);
                const float mw = s * (1.0f / 64.0f); float q = 0.f;
#pragma unroll
                for (int bj = 0; bj < 2; ++bj)
#pragma unroll
                    for (int n = 0; n < 2; ++n) { const f32x4 d = v[ai][bj][m][n] - mw; q += (d[0] * d[0] + d[1] * d[1]) + (d[2] * d[2] + d[3] * d[3]); }
                q += __shfl_xor(q, 16); q += __shfl_xor(q, 32);
                if (fq == 0) P[(ai * HALF + wr * 64 + m * 16 + fr) * 4 + wc] = (f32x2v){mw, q};
            }
        asm volatile("s_waitcnt lgkmcnt(0)" ::: "memory"); __builtin_amdgcn_s_barrier(); asm volatile("" ::: "memory");
#if defined(BROKEN_EXCHANGE_NO_WAIT)
#warning BROKEN CONTROL BUILD: the row-statistics exchange does not wait; results are wrong by design
        if (blockIdx.x >= 64) { const long long t0_ = clock64(); while (clock64() - t0_ < 60000) __builtin_amdgcn_s_sleep(8); }
#endif
        const int row = wid * 32 + (lane & 31);
        if (lane < 32) {
            const f32x2v a = P[row * 4 + 0], b = P[row * 4 + 1], c = P[row * 4 + 2], d = P[row * 4 + 3];
            const float mt = (a.x + b.x + c.x + d.x) * 0.25f;
            const float da = a.x - mt, db = b.x - mt, dc = c.x - mt, dd = d.x - mt;
            const float m2 = (a.y + b.y) + (c.y + d.y) + 64.0f * ((da * da + db * db) + (dc * dc + dd * dd));
            unsigned long long* slot = (unsigned long long*)xbuf + ((size_t)(u.pm * BM + row) * 4 + u.pn);
            __hip_atomic_store(slot, ((unsigned long long)__float_as_uint(m2) << 32) | __float_as_uint(mt), __ATOMIC_RELAXED, __HIP_MEMORY_SCOPE_AGENT);
        }
        asm volatile("s_waitcnt vmcnt(0)" ::: "memory");
        if (lane == 0) __hip_atomic_fetch_add(cnt + 64 * u.pm, 1u, __ATOMIC_RELAXED, __HIP_MEMORY_SCOPE_AGENT);
        if (wid == 0) {
            bool dead = false; const unsigned long long t0 = __builtin_amdgcn_s_memrealtime(); const unsigned want = 8u * (unsigned)ntn;
            for (;;) {
#if defined(BROKEN_EXCHANGE_NO_WAIT)
                break;
#endif
                if ((unsigned)__builtin_amdgcn_readfirstlane(__hip_atomic_load(cnt + 64 * u.pm, __ATOMIC_RELAXED, __HIP_MEMORY_SCOPE_AGENT)) >= want) break;
                if (__builtin_amdgcn_s_memrealtime() - t0 > 2000000ull) {
                    if (lane == 0) { unsigned expect = 0u; __hip_atomic_compare_exchange_strong(tmo + 1, &expect, code | (unsigned)(u.pm & 0xff), __ATOMIC_RELAXED, __ATOMIC_RELAXED, __HIP_MEMORY_SCOPE_AGENT);
                                     __hip_atomic_store(tmo, 1u, __ATOMIC_RELAXED, __HIP_MEMORY_SCOPE_AGENT); }
                    dead = true; break; }
                __builtin_amdgcn_s_sleep(2);
            }
            __builtin_amdgcn_fence(__ATOMIC_ACQUIRE, "agent");
            if (lane == 0) flag[0] = dead ? 1u : 0u;
        }
        asm volatile("s_waitcnt vmcnt(0) lgkmcnt(0)" ::: "memory"); __builtin_amdgcn_s_barrier(); asm volatile("" ::: "memory");
        const bool bad = flag[0] != 0u;
        if (lane < 32) {
            const unsigned long long* slot = (const unsigned long long*)xbuf + (size_t)(u.pm * BM + row) * 4; float mt[4], m2[4]; float ms = 0.f;
#pragma unroll
            for (int t = 0; t < 4; ++t) { if (t < ntn) { const unsigned long long w = __hip_atomic_load(slot + t, __ATOMIC_RELAXED, __HIP_MEMORY_SCOPE_AGENT); mt[t] = __uint_as_float((unsigned)w); m2[t] = __uint_as_float((unsigned)(w >> 32)); } else { mt[t] = 0.f; m2[t] = 0.f; } ms += mt[t]; }
            const float mean = ms / (float)ntn; float q = 0.f;
#pragma unroll
            for (int t = 0; t < 4; ++t) if (t < ntn) { const float dm = mt[t] - mean; q += m2[t] + 256.0f * dm * dm; }
            S[row] = (f32x2v){mean, 1.0f / sqrtf(q / (256.0f * (float)ntn) + eps)};
        }
        asm volatile("s_waitcnt lgkmcnt(0)" ::: "memory"); __builtin_amdgcn_s_barrier(); asm volatile("" ::: "memory");
        return bad;
    }
};
struct EpiLnRes {
    static constexpr bool PERM = false, AFTER_DRAIN = true;
    const float* base; float* out; int ldc; const float* bias; PanelStats st; unsigned poison;
    __device__ __forceinline__ void fused(f32x4 (&acc)[2][2][4][2], const Unit& u, int wr, int wc, int fr, int fq, PG8_LAS unsigned char* lds, int wid, int lane) const {
        typedef float f32x2v __attribute__((ext_vector_type(2)));
        const PG8_LAS f32x2v* S = (const PG8_LAS f32x2v*)(lds + 8192);
        const int col0 = u.pn * BM + wc * 32 + 4 * fq;
#pragma unroll
        for (int bj = 0; bj < 2; ++bj)
#pragma unroll
            for (int n = 0; n < 2; ++n) { const f32x4 bv = bias ? *(const f32x4*)(bias + col0 + bj * HALF + n * 16) : (f32x4){0.f, 0.f, 0.f, 0.f};
#pragma unroll
                for (int ai = 0; ai < 2; ++ai)
#pragma unroll
                    for (int m = 0; m < 4; ++m) acc[ai][bj][m][n] += bv; }
        f32x4 pre[4][2][2];
#pragma unroll
        for (int m = 0; m < 4; ++m) { const size_t off = (size_t)(u.pm * BM + wr * 64 + m * 16 + fr) * ldc + col0;
#pragma unroll
            for (int bj = 0; bj < 2; ++bj)
#pragma unroll
                for (int n = 0; n < 2; ++n) pre[m][bj][n] = *(const f32x4*)(base + off + bj * HALF + n * 16); }
        const bool bad = st.run(acc, u, wr, wc, fr, fq, lds, wid, lane) || poison != 0u;
        const float qnan = __builtin_nanf("");
#pragma unroll
        for (int ai = 0; ai < 2; ++ai)
#pragma unroll
            for (int m = 0; m < 4; ++m) { const int r = ai * HALF + wr * 64 + m * 16 + fr; const f32x2v sr = S[r]; const size_t off = (size_t)(u.pm * BM + r) * ldc + col0;
#pragma unroll
                for (int bj = 0; bj < 2; ++bj)
#pragma unroll
                    for (int n = 0; n < 2; ++n) { const f32x4 bs = ai == 0 ? pre[m][bj][n] : *(const f32x4*)(base + off + bj * HALF + n * 16); f32x4 o = bs + (acc[ai][bj][m][n] - sr.x) * sr.y;
                        if (bad) o = (f32x4){qnan, qnan, qnan, qnan}; *(f32x4*)(out + off + bj * HALF + n * 16) = o; }
                if (m & 1) asm volatile("" ::: "memory"); }
    }
};
struct EpiLnResLn {
    static constexpr bool PERM = false, AFTER_DRAIN = true;
    const float* base; float* out; bf16_t* xn; int ldc; const float* bias; PanelStats st1, st2; unsigned poison;
    __device__ __forceinline__ void fused(f32x4 (&acc)[2][2][4][2], const Unit& u, int wr, int wc, int fr, int fq, PG8_LAS unsigned char* lds, int wid, int lane) const {
        typedef float f32x2v __attribute__((ext_vector_type(2))); typedef unsigned u32x2v __attribute__((ext_vector_type(2)));
        const PG8_LAS f32x2v* S = (const PG8_LAS f32x2v*)(lds + 8192);
        const int col0 = u.pn * BM + wc * 32 + 4 * fq;
#pragma unroll
        for (int bj = 0; bj < 2; ++bj)
#pragma unroll
            for (int n = 0; n < 2; ++n) { const f32x4 bv = bias ? *(const f32x4*)(bias + col0 + bj * HALF + n * 16) : (f32x4){0.f, 0.f, 0.f, 0.f};
#pragma unroll
                for (int ai = 0; ai < 2; ++ai)
#pragma unroll
                    for (int m = 0; m < 4; ++m) acc[ai][bj][m][n] += bv; }
        bool bad = st1.run(acc, u, wr, wc, fr, fq, lds, wid, lane) || poison != 0u;
        const float qnan = __builtin_nanf("");
#pragma unroll
        for (int ai = 0; ai < 2; ++ai)
#pragma unroll
            for (int m = 0; m < 4; ++m) { const int r = ai * HALF + wr * 64 + m * 16 + fr; const f32x2v sr = S[r]; const size_t off = (size_t)(u.pm * BM + r) * ldc + col0;
#pragma unroll
                for (int bj = 0; bj < 2; ++bj)
#pragma unroll
                    for (int n = 0; n < 2; ++n) { const f32x4 bs = *(const f32x4*)(base + off + bj * HALF + n * 16); acc[ai][bj][m][n] = bs + (acc[ai][bj][m][n] - sr.x) * sr.y; }
                asm volatile("" : "+v"(acc[ai][0][m][0]), "+v"(acc[ai][0][m][1]), "+v"(acc[ai][1][m][0]), "+v"(acc[ai][1][m][1]));
                if (m & 1) asm volatile("" ::: "memory"); }
        const bool bad1 = bad;
        bad = st2.run(acc, u, wr, wc, fr, fq, lds, wid, lane) || bad;
#pragma unroll
        for (int ai = 0; ai < 2; ++ai)
#pragma unroll
            for (int m = 0; m < 4; ++m) { const int r = ai * HALF + wr * 64 + m * 16 + fr; const f32x2v sr = S[r]; const size_t off = (size_t)(u.pm * BM + r) * ldc + col0;
#pragma unroll
                for (int bj = 0; bj < 2; ++bj)
#pragma unroll
                    for (int n = 0; n < 2; ++n) { const f32x4 x1 = acc[ai][bj][m][n]; *(f32x4*)(out + off + bj * HALF + n * 16) = bad1 ? (f32x4){qnan, qnan, qnan, qnan} : x1;
                        const f32x4 o = (x1 - sr.x) * sr.y; u32x2v w; w.x = cvt_pk_bf16(o[0], o[1]); w.y = cvt_pk_bf16(o[2], o[3]);
                        if (bad) { w.x = 0x7fc07fc0u; w.y = 0x7fc07fc0u; } *(u32x2v*)(xn + off + bj * HALF + n * 16) = w; }
                asm volatile("" ::: "memory"); }
    }
};

template <class Epi, class Sched, bool ALIGN_EPI = false, bool SP2 = false>
__device__ __forceinline__ void gemm_phase(PG8_LAS unsigned char* lds, const Gemm g, const Sched& S, const Epi& E) {
    int tid = threadIdx.x; asm volatile("" : "+v"(tid));
    const int wid = __builtin_amdgcn_readfirstlane(tid >> 6), lane = tid & 63, wr = wid >> 2, wc = wid & 3, fr = lane & 15, fq = lane >> 4;
    const int K = g.K, nt = K / BK;
    unsigned voffA[2], voffB[2];
#pragma unroll
    for (int i = 0; i < 2; ++i) { int R, C; stage_rc(tid * 16 + i * 8192, R, C); const int Rb = Epi::PERM ? ((R & ~31) + perm32(R & 31)) : R;
        voffA[i] = (unsigned)(R * K + C) * 2u; voffB[i] = (unsigned)(Rb * K + C) * 2u; }
    const size_t kstep = (size_t)(BK * 2);
    const size_t hstep = (size_t)HALF * K * 2;
    const size_t tstep = 2 * hstep;
    const unsigned ldsw = (unsigned)wid * 1024u;
    const int aoff = lds_byte(wr * 64 + fr, fq * 8), boff = lds_byte(wc * 32 + fr, fq * 8);
#define PG8_SA(b, h) (((b) * 2 + (h)) * HTB)
#define PG8_SB(b, h) ((4 + (b) * 2 + (h)) * HTB)
#define PG8_STAGE(bufoff, gbase, voff) do { _Pragma("unroll") for (int _i = 0; _i < 2; ++_i) \
        __builtin_amdgcn_global_load_lds((const unsigned*)((const char*)(gbase) + (voff)[_i]), (PG8_LAS unsigned*)(lds + (bufoff) + ldsw + _i * 8192), 16, 0, 0); } while (0)
#define PG8_LDA(dst, b, h) do { _Pragma("unroll") for (int m = 0; m < 4; ++m) _Pragma("unroll") for (int k = 0; k < 2; ++k) dst[m][k] = *(const PG8_LAS bf16x8*)(lds + PG8_SA(b, h) + aoff + m * 2048 + k * 1024); } while (0)
#define PG8_LDB(dst, b, h) do { _Pragma("unroll") for (int n = 0; n < 2; ++n) _Pragma("unroll") for (int k = 0; k < 2; ++k) dst[n][k] = *(const PG8_LAS bf16x8*)(lds + PG8_SB(b, h) + boff + n * 2048 + k * 1024); } while (0)
#define PG8_MMA(ai, bj, At, Bt) do { __builtin_amdgcn_s_setprio(1); _Pragma("unroll") for (int m = 0; m < 4; ++m) _Pragma("unroll") for (int n = 0; n < 2; ++n) _Pragma("unroll") for (int k = 0; k < 2; ++k) \
        acc[ai][bj][m][n] = __builtin_amdgcn_mfma_f32_16x16x32_bf16(Bt[n][k], At[m][k], acc[ai][bj][m][n], 0, 0, 0); __builtin_amdgcn_s_setprio(0); } while (0)
#define PG8_WAIT_V(n) asm volatile("s_waitcnt vmcnt(" #n ")" ::: "memory")
#define PG8_WAIT_L(n) asm volatile("s_waitcnt lgkmcnt(" #n ")" ::: "memory")
#define PG8_BAR __builtin_amdgcn_s_barrier()
#define PG8_SCHED __builtin_amdgcn_sched_barrier(0)
    Unit cur, nxt; int ui = 0;
    if (!S.next(0, cur)) return;
    f32x4 acc[2][2][4][2];
#pragma unroll
    for (int a = 0; a < 2; ++a)
#pragma unroll
        for (int b = 0; b < 2; ++b)
#pragma unroll
            for (int m = 0; m < 4; ++m)
#pragma unroll
                for (int n = 0; n < 2; ++n) acc[a][b][m][n] = (f32x4){0.f, 0.f, 0.f, 0.f};
    bf16x8 At[4][2], B0[2][2], B1[2][2];
    const char* cA = (const char*)g.A + (size_t)cur.pm * tstep; const char* cB = (const char*)g.Bt + (size_t)cur.pn * tstep;
    S.a_ready(cur);
    if constexpr (SP2) {
        PG8_STAGE(PG8_SB(0, 0), cB, voffB); PG8_STAGE(PG8_SB(0, 1), cB + hstep, voffB); PG8_STAGE(PG8_SA(0, 0), cA, voffA); PG8_STAGE(PG8_SA(0, 1), cA + hstep, voffA);
        if (wr == 1) PG8_BAR;
        PG8_WAIT_V(2); PG8_BAR;
        PG8_STAGE(PG8_SB(1, 0), cB + kstep, voffB); PG8_STAGE(PG8_SA(1, 0), cA + kstep, voffA); PG8_STAGE(PG8_SB(1, 1), cB + hstep + kstep, voffB);
        PG8_WAIT_V(6); PG8_BAR;
    } else {
        PG8_STAGE(PG8_SB(0, 0), cB, voffB); PG8_STAGE(PG8_SA(0, 0), cA, voffA); PG8_STAGE(PG8_SB(0, 1), cB + hstep, voffB); PG8_STAGE(PG8_SA(0, 1), cA + hstep, voffA);
        if (wr == 1) PG8_BAR;
        PG8_WAIT_V(4); PG8_BAR;
        PG8_STAGE(PG8_SB(1, 0), cB + kstep, voffB); PG8_STAGE(PG8_SA(1, 0), cA + kstep, voffA); PG8_STAGE(PG8_SB(1, 1), cB + hstep + kstep, voffB);
        PG8_WAIT_V(6); PG8_BAR;
    }
    for (;;) {
        const bool has_next = S.next(ui + 1, nxt);
        const char* nA = has_next ? (const char*)g.A + (size_t)nxt.pm * tstep : cA; const char* nB = has_next ? (const char*)g.Bt + (size_t)nxt.pn * tstep : cB;
        for (int t = 0; t < nt; t += 2) {
            const bool last = (t == nt - 2);
            const char* a1 = cA + (size_t)(t + 1) * kstep;
            const char* a2 = last ? nA : cA + (size_t)(t + 2) * kstep; const char* b2 = last ? nB : cB + (size_t)(t + 2) * kstep;
            const char* a3 = a2 + kstep; const char* b3 = b2 + kstep;
            if (last && has_next) S.a_ready(nxt);
            if constexpr (SP2) {
            PG8_LDB(B0, 0, 0); PG8_LDB(B1, 0, 1); PG8_SCHED; PG8_LDA(At, 0, 0); PG8_STAGE(PG8_SA(1, 1), a1 + hstep, voffA);
            PG8_WAIT_V(8); PG8_WAIT_L(0); PG8_BAR; PG8_MMA(0, 0, At, B0); PG8_MMA(0, 1, At, B1); PG8_BAR; PG8_SCHED;
            PG8_LDA(At, 0, 1); PG8_STAGE(PG8_SB(0, 0), b2, voffB); PG8_STAGE(PG8_SB(0, 1), b2 + hstep, voffB); PG8_STAGE(PG8_SA(0, 0), a2, voffA);
            PG8_WAIT_V(8); PG8_WAIT_L(0); PG8_BAR; PG8_MMA(1, 0, At, B0); PG8_MMA(1, 1, At, B1); PG8_BAR; PG8_SCHED;
            PG8_LDB(B0, 1, 0); PG8_LDB(B1, 1, 1); PG8_SCHED; PG8_LDA(At, 1, 0); PG8_STAGE(PG8_SA(0, 1), a2 + hstep, voffA);
            PG8_WAIT_V(8); PG8_WAIT_L(0); PG8_BAR; PG8_MMA(0, 0, At, B0); PG8_MMA(0, 1, At, B1); PG8_BAR; PG8_SCHED;
            PG8_LDA(At, 1, 1); PG8_STAGE(PG8_SB(1, 0), b3, voffB); PG8_STAGE(PG8_SB(1, 1), b3 + hstep, voffB); PG8_STAGE(PG8_SA(1, 0), a3, voffA);
            PG8_WAIT_V(8); PG8_WAIT_L(0); PG8_BAR; PG8_MMA(1, 0, At, B0); PG8_MMA(1, 1, At, B1); PG8_BAR; PG8_SCHED;
            } else {
            PG8_LDB(B0, 0, 0); PG8_SCHED; PG8_LDA(At, 0, 0); PG8_STAGE(PG8_SA(1, 1), a1 + hstep, voffA);
            PG8_WAIT_L(8); PG8_BAR; PG8_WAIT_L(0); PG8_MMA(0, 0, At, B0); PG8_BAR; PG8_SCHED;
            PG8_LDB(B1, 0, 1); PG8_STAGE(PG8_SB(0, 0), b2, voffB);
            PG8_BAR; PG8_WAIT_L(0); PG8_MMA(0, 1, At, B1); PG8_BAR;
            PG8_LDA(At, 0, 1); PG8_STAGE(PG8_SA(0, 0), a2, voffA);
            PG8_BAR; PG8_WAIT_L(0); PG8_MMA(1, 0, At, B0); PG8_BAR; PG8_SCHED;
            PG8_STAGE(PG8_SB(0, 1), b2 + hstep, voffB);
            PG8_WAIT_V(6); PG8_BAR; PG8_MMA(1, 1, At, B1); PG8_BAR;
            PG8_LDB(B0, 1, 0); PG8_SCHED; PG8_LDA(At, 1, 0); PG8_STAGE(PG8_SA(0, 1), a2 + hstep, voffA);
            PG8_WAIT_L(8); PG8_BAR; PG8_WAIT_L(0); PG8_MMA(0, 0, At, B0); PG8_BAR; PG8_SCHED;
            PG8_LDB(B1, 1, 1); PG8_STAGE(PG8_SB(1, 0), b3, voffB);
            PG8_BAR; PG8_WAIT_L(0); PG8_MMA(0, 1, At, B1); PG8_BAR;
            PG8_LDA(At, 1, 1); PG8_STAGE(PG8_SA(1, 0), a3, voffA);
            PG8_BAR; PG8_WAIT_L(0); PG8_MMA(1, 0, At, B0); PG8_BAR; PG8_SCHED;
            PG8_STAGE(PG8_SB(1, 1), b3 + hstep, voffB);
            PG8_WAIT_V(6); PG8_BAR; PG8_MMA(1, 1, At, B1); PG8_BAR;
            }
        }
        if constexpr (ALIGN_EPI) { if (wr == 0) PG8_BAR; }
        if constexpr (!Epi::AFTER_DRAIN) { E(acc, cur, wr, wc, fr, fq); S.done(cur); }
        if (!has_next) break;
#pragma unroll
        for (int a = 0; a < 2; ++a)
#pragma unroll
            for (int b = 0; b < 2; ++b)
#pragma unroll
                for (int m = 0; m < 4; ++m)
#pragma unroll
                    for (int n = 0; n < 2; ++n) acc[a][b][m][n] = (f32x4){0.f, 0.f, 0.f, 0.f};
        cur = nxt; cA = nA; cB = nB; ++ui;
        if constexpr (ALIGN_EPI) { if (wr == 1) PG8_BAR; }
    }
    PG8_WAIT_V(0);
    if constexpr (!ALIGN_EPI) { if (wr == 0) PG8_BAR; }
    PG8_BAR;
    if constexpr (Epi::AFTER_DRAIN) { E.fused(acc, cur, wr, wc, fr, fq, lds, wid, lane); S.done(cur); }
#undef PG8_SA
#undef PG8_SB
#undef PG8_STAGE
#undef PG8_LDA
#undef PG8_LDB
#undef PG8_MMA
#undef PG8_WAIT_V
#undef PG8_WAIT_L
#undef PG8_BAR
#undef PG8_SCHED
}
}

#ifndef PG8_SP2
#define PG8_SP2 true
#endif
#ifndef PG8_ALIGN
#define PG8_ALIGN true
#endif
namespace att {
constexpr int NW = 8, QBLK = 32, KVBLK = 64;
constexpr int SHM_V = KVBLK * 128 * 2, SHM_K = KVBLK * 64 * 2, SHM_ATTN = 2 * SHM_V + 2 * SHM_K + NW * 64 * 4;
#define KSWZ64(row, colB) ((row) * 128 + ((colB) ^ ((((row) >> 1) & 7) << 4)))
#define SBAR() __builtin_amdgcn_sched_barrier(0)
__device__ __forceinline__ int crow(int r, int hi) { return (r & 3) + 8 * (r >> 2) + 4 * hi; }
__device__ __forceinline__ unsigned cvtpk(float lo, float hi) { unsigned r; asm volatile("v_cvt_pk_bf16_f32 %0, %1, %2" : "=v"(r) : "v"(lo), "v"(hi)); return r; }
__device__ __forceinline__ void expA(f32x16& p) {
#pragma unroll
    for (int r = 0; r < 16; ++r) p[r] = __builtin_amdgcn_exp2f(p[r]);
}
__device__ __forceinline__ void finishSM(f32x16& p0, f32x16& p1, float& l_reg, bf16x8& pa0, bf16x8& pa1, bf16x8& pa2, bf16x8& pa3) {
#pragma unroll
    for (int r = 0; r < 16; ++r) p1[r] = __builtin_amdgcn_exp2f(p1[r]);
    float ps = 0;
#pragma unroll
    for (int r = 0; r < 16; ++r) ps += p0[r];
#pragma unroll
    for (int r = 0; r < 16; ++r) ps += p1[r];
    l_reg += ps;
#define PK4(P, BASE, OUT) do { unsigned a0 = cvtpk(P[BASE + 0], P[BASE + 1]), a1 = cvtpk(P[BASE + 2], P[BASE + 3]);   \
    unsigned b0 = cvtpk(P[BASE + 4], P[BASE + 5]), b1 = cvtpk(P[BASE + 6], P[BASE + 7]);                              \
    auto r0 = __builtin_amdgcn_permlane32_swap(a0, b0, false, false); auto r1 = __builtin_amdgcn_permlane32_swap(a1, b1, false, false); \
    v4u w = {r0[0], r1[0], r0[1], r1[1]}; OUT = *reinterpret_cast<bf16x8*>(&w); } while (0)
    PK4(p0, 0, pa0); PK4(p0, 8, pa1); PK4(p1, 0, pa2); PK4(p1, 8, pa3);
#undef PK4
}
__device__ __forceinline__ void softHalf(f32x16& p, float& l_reg, bf16x8& paLo, bf16x8& paHi) {
#pragma unroll
    for (int r = 0; r < 16; ++r) p[r] = __builtin_amdgcn_exp2f(p[r]);
    float ps = 0;
#pragma unroll
    for (int r = 0; r < 16; ++r) ps += p[r];
    l_reg += ps;
#define PK4(P, BASE, OUT) do { unsigned a0 = cvtpk(P[BASE + 0], P[BASE + 1]), a1 = cvtpk(P[BASE + 2], P[BASE + 3]);   \
    unsigned b0 = cvtpk(P[BASE + 4], P[BASE + 5]), b1 = cvtpk(P[BASE + 6], P[BASE + 7]);                              \
    auto r0 = __builtin_amdgcn_permlane32_swap(a0, b0, false, false); auto r1 = __builtin_amdgcn_permlane32_swap(a1, b1, false, false); \
    v4u w = {r0[0], r1[0], r0[1], r1[1]}; OUT = *reinterpret_cast<bf16x8*>(&w); } while (0)
    PK4(p, 0, paLo); PK4(p, 8, paHi);
#undef PK4
}
__device__ __forceinline__ void qkt(f32x16& p0, f32x16& p1, const char* Ks, const bf16x8* qr, int r32, int hi) {
    p0 = f32x16{}; p1 = f32x16{};
#pragma unroll
    for (int d0 = 0; d0 < 4; ++d0) { const int cb = (d0 * 16 + hi * 8) * 2;
        const bf16x8 b0 = *reinterpret_cast<const bf16x8*>(Ks + KSWZ64(r32, cb));
        const bf16x8 b1 = *reinterpret_cast<const bf16x8*>(Ks + KSWZ64(32 + r32, cb));
        p0 = __builtin_amdgcn_mfma_f32_32x32x16_bf16(b0, qr[d0], p0, 0, 0, 0);
        p1 = __builtin_amdgcn_mfma_f32_32x32x16_bf16(b1, qr[d0], p1, 0, 0, 0); }
}
__device__ __forceinline__ int v_st(int k, int c) { const int kk = (k & ~0xC) | ((k & 4) << 1) | ((k & 8) >> 1); return ((kk >> 3) * 4 + (c >> 5)) * 512 + ((kk & 7) * 32 + (c & 31)) * 2; }
__device__ __forceinline__ int v_rd_base(int lane) { return ((lane & 3) << 3) | (((lane >> 2) & 3) << 6) | (((lane >> 4) & 1) << 5) | (((lane >> 5) & 1) << 8); }
constexpr int v_rd_off(int d0, int ks, int half) { return d0 * 512 + ks * 4096 + half * 2048; }
template <int OFF> __device__ __forceinline__ s16x4 tr_read(int vb) {
    s16x4 r; asm volatile("ds_read_b64_tr_b16 %0, %1 offset:%2" : "=&v"(r) : "v"(vb), "i"(OFF) : "memory"); return r;
}
template <int D0> __device__ __forceinline__ void pv_one(f32x16& od, int vb, bf16x8 pa0, bf16x8 pa1, bf16x8 pa2, bf16x8 pa3) {
    const s16x4 l0 = tr_read<v_rd_off(D0, 0, 0)>(vb), h0 = tr_read<v_rd_off(D0, 0, 1)>(vb), l1 = tr_read<v_rd_off(D0, 1, 0)>(vb), h1 = tr_read<v_rd_off(D0, 1, 1)>(vb);
    const s16x4 l2 = tr_read<v_rd_off(D0, 2, 0)>(vb), h2 = tr_read<v_rd_off(D0, 2, 1)>(vb), l3 = tr_read<v_rd_off(D0, 3, 0)>(vb), h3 = tr_read<v_rd_off(D0, 3, 1)>(vb);
    asm volatile("s_waitcnt lgkmcnt(0)" ::: "memory"); SBAR();
#define PK(L, H) (bf16x8){L[0], L[1], L[2], L[3], H[0], H[1], H[2], H[3]}
    od = __builtin_amdgcn_mfma_f32_32x32x16_bf16(pa0, PK(l0, h0), od, 0, 0, 0);
    od = __builtin_amdgcn_mfma_f32_32x32x16_bf16(pa1, PK(l1, h1), od, 0, 0, 0);
    od = __builtin_amdgcn_mfma_f32_32x32x16_bf16(pa2, PK(l2, h2), od, 0, 0, 0);
    od = __builtin_amdgcn_mfma_f32_32x32x16_bf16(pa3, PK(l3, h3), od, 0, 0, 0);
#undef PK
}
template <int KS> __device__ __forceinline__ void pv_ks(f32x16* o, int vb, bf16x8 pa) {
    const s16x4 l0 = tr_read<v_rd_off(0, KS, 0)>(vb), h0 = tr_read<v_rd_off(0, KS, 1)>(vb), l1 = tr_read<v_rd_off(1, KS, 0)>(vb), h1 = tr_read<v_rd_off(1, KS, 1)>(vb);
    const s16x4 l2 = tr_read<v_rd_off(2, KS, 0)>(vb), h2 = tr_read<v_rd_off(2, KS, 1)>(vb), l3 = tr_read<v_rd_off(3, KS, 0)>(vb), h3 = tr_read<v_rd_off(3, KS, 1)>(vb);
    asm volatile("s_waitcnt lgkmcnt(0)" ::: "memory"); SBAR();
#define PK(L, H) (bf16x8){L[0], L[1], L[2], L[3], H[0], H[1], H[2], H[3]}
    o[0] = __builtin_amdgcn_mfma_f32_32x32x16_bf16(pa, PK(l0, h0), o[0], 0, 0, 0);
    o[1] = __builtin_amdgcn_mfma_f32_32x32x16_bf16(pa, PK(l1, h1), o[1], 0, 0, 0);
    o[2] = __builtin_amdgcn_mfma_f32_32x32x16_bf16(pa, PK(l2, h2), o[2], 0, 0, 0);
    o[3] = __builtin_amdgcn_mfma_f32_32x32x16_bf16(pa, PK(l3, h3), o[3], 0, 0, 0);
#undef PK
}
__device__ __forceinline__ void pv_d0(f32x16* o, int vb, bf16x8 pa0, bf16x8 pa1, bf16x8 pa2, bf16x8 pa3) {
    pv_one<0>(o[0], vb, pa0, pa1, pa2, pa3); pv_one<1>(o[1], vb, pa0, pa1, pa2, pa3); pv_one<2>(o[2], vb, pa0, pa1, pa2, pa3); pv_one<3>(o[3], vb, pa0, pa1, pa2, pa3);
}
__device__ __forceinline__ void attn_unit(const bf16* __restrict__ Qb, const bf16* __restrict__ Kh, const bf16* __restrict__ Vh, bf16* __restrict__ Ob, int seq, char* lds) {
    int tid = threadIdx.x; asm volatile("" : "+v"(tid));
    const int wid = tid >> 6, lane = tid & 63, r32 = lane & 31, hi = lane >> 5;
    char* V_lds = lds; char* K_lds = lds + 2 * SHM_V;
    float* wsf = (float*)(lds + 2 * SHM_V + 2 * SHM_K) + wid * 64;
    float l_reg = 0; f32x16 o[4] = {}; bf16x8 qr[4];
    const bf16* Qw = Qb + (long)(wid * QBLK + r32) * 64 + hi * 8;
#pragma unroll
    for (int d0 = 0; d0 < 4; ++d0) qr[d0] = *reinterpret_cast<const bf16x8*>(Qw + d0 * 16);
    const int sr = tid >> 4, sc = (tid & 15) * 8, vst0 = v_st(sr, sc), vst1 = v_st(32 + sr, sc);
    const int kr = tid >> 3, kc = (tid & 7) * 8, kst = KSWZ64(kr, kc * 2);
    const int vb0 = (int)(uintptr_t)V_lds + v_rd_base(lane);
    struct { bf16x8 vs0, vs1, ks0; } sr_[1];
    const unsigned voff0 = (unsigned)((sr * 128 + sc) * 2), koff0 = (unsigned)((kr * 64 + kc) * 2);
#define SLOAD(i, k0) do { const char* vt_ = (const char*)Vh + (size_t)(k0) * 256; const char* kt_ = (const char*)Kh + (size_t)(k0) * 128; \
    sr_[i].vs0 = *reinterpret_cast<const bf16x8*>(vt_ + voff0); sr_[i].vs1 = *reinterpret_cast<const bf16x8*>(vt_ + 32 * 256 + voff0); \
    sr_[i].ks0 = *reinterpret_cast<const bf16x8*>(kt_ + koff0); } while (0)
#define SWRITE(b, i) do { *(bf16x8*)(V_lds + (b) * SHM_V + vst0) = sr_[i].vs0; *(bf16x8*)(V_lds + (b) * SHM_V + vst1) = sr_[i].vs1; \
    *(bf16x8*)(K_lds + (b) * SHM_K + kst) = sr_[i].ks0; } while (0)
#define SWAIT() asm volatile("s_waitcnt vmcnt(0)" ::: "memory")
    f32x16 pA0, pA1, pB0, pB1; bf16x8 pa0, pa1, pa2, pa3; const int NT = seq / KVBLK;
    constexpr int SE = 0, SO = 0;
    SLOAD(SE, 0); asm volatile("s_waitcnt vmcnt(0)" ::: "memory"); SWRITE(0, SE); __syncthreads();
    qkt(pA0, pA1, K_lds, qr, r32, hi); softHalf(pA0, l_reg, pa0, pa1);
    SLOAD(SO, KVBLK);
    SWAIT(); SWRITE(1, SO); __syncthreads();
    for (int j = 1; j + 1 < NT; j += 2) {
        SBAR(); qkt(pB0, pB1, K_lds + SHM_K, qr, r32, hi); pv_ks<0>(o, vb0, pa0); SBAR();
        softHalf(pA1, l_reg, pa2, pa3); SBAR();
        SLOAD(SO, (j + 1) * KVBLK); SBAR();
        pv_ks<1>(o, vb0, pa1); pv_ks<2>(o, vb0, pa2); pv_ks<3>(o, vb0, pa3); SBAR();
        softHalf(pB0, l_reg, pa0, pa1); SBAR();
        __syncthreads(); SWAIT(); SWRITE(0, SE);
        __syncthreads();
        SBAR(); qkt(pA0, pA1, K_lds, qr, r32, hi); pv_ks<0>(o, vb0 + SHM_V, pa0); SBAR();
        softHalf(pB1, l_reg, pa2, pa3); SBAR();
        SLOAD(SE, (j + 2) * KVBLK); SBAR();
        pv_ks<1>(o, vb0 + SHM_V, pa1); pv_ks<2>(o, vb0 + SHM_V, pa2); pv_ks<3>(o, vb0 + SHM_V, pa3); SBAR();
        softHalf(pA0, l_reg, pa0, pa1); SBAR();
        __syncthreads(); SWAIT(); SWRITE(1, SO);
        __syncthreads();
    }
    SBAR(); qkt(pB0, pB1, K_lds + SHM_K, qr, r32, hi); pv_ks<0>(o, vb0, pa0); SBAR();
    softHalf(pA1, l_reg, pa2, pa3); SBAR();
    pv_ks<1>(o, vb0, pa1); pv_ks<2>(o, vb0, pa2); pv_ks<3>(o, vb0, pa3); SBAR();
    softHalf(pB0, l_reg, pa0, pa1); SBAR();
    pv_ks<0>(o, vb0 + SHM_V, pa0); SBAR();
    softHalf(pB1, l_reg, pa2, pa3); SBAR();
    pv_ks<1>(o, vb0 + SHM_V, pa1); pv_ks<2>(o, vb0 + SHM_V, pa2); pv_ks<3>(o, vb0 + SHM_V, pa3);
    { auto rr = __builtin_amdgcn_permlane32_swap(__float_as_uint(l_reg), __float_as_uint(l_reg), false, false); l_reg = __uint_as_float(rr[0]) + __uint_as_float(rr[1]); }
    if (hi == 0) wsf[r32] = l_reg; asm volatile("s_waitcnt lgkmcnt(0)" ::: "memory");
    float rli[16];
#pragma unroll
    for (int r = 0; r < 16; ++r) rli[r] = __builtin_amdgcn_rcpf(wsf[crow(r, hi)]);
    bf16* Ow = Ob + (long)(wid * QBLK) * 128;
    {
        char* stg = lds + 53248 + wid * 8192;
#pragma unroll
        for (int r = 0; r < 16; ++r) { const int orow = crow(r, hi);
#pragma unroll
            for (int d0 = 0; d0 < 4; ++d0) *(unsigned short*)(stg + (orow * 128 + d0 * 32 + r32) * 2) = (unsigned short)f2bf(o[d0][r] * rli[r]); }
        asm volatile("s_waitcnt lgkmcnt(0)" ::: "memory");
#pragma unroll
        for (int i = 0; i < 8; ++i) { const int row = i * 4 + (lane >> 4), ch = lane & 15; const v4u v = *(const v4u*)(stg + row * 256 + ch * 16); *(v4u*)(Ow + (long)row * 128 + ch * 8) = v; }
    }
    __syncthreads();
#undef SLOAD
#undef SWRITE
#undef SWAIT
}
#undef SBAR
}
namespace ret {
using namespace att;
#define SBAR() __builtin_amdgcn_sched_barrier(0)
__device__ __forceinline__ int v_st64(int k, int c) { const int kk = (k & ~0xC) | ((k & 4) << 1) | ((k & 8) >> 1); return ((kk >> 3) * 2 + (c >> 5)) * 512 + ((kk & 7) * 32 + (c & 31)) * 2; }
constexpr int v_rd_off64(int d0, int ks, int half) { return d0 * 512 + ks * 2048 + half * 1024; }
__device__ __forceinline__ float log2_sigmoid(float x) { return -log1pf(expf(-x)) * 1.4426950408889634f; }
__device__ __forceinline__ bf16x8 scale8(bf16x8 v, float s) {
    v4u w = *reinterpret_cast<v4u*>(&v), o;
#pragma unroll
    for (int i = 0; i < 4; ++i) { const float lo = __builtin_bit_cast(float, w[i] << 16) * s, hi = __builtin_bit_cast(float, w[i] & 0xffff0000u) * s; o[i] = pk2(lo, hi); }
    return *reinterpret_cast<bf16x8*>(&o);
}
__device__ __forceinline__ void state_unit(const bf16* __restrict__ Kc, const bf16* __restrict__ Vc, float* __restrict__ Sf, float* __restrict__ Sb, float lgf2, float lgb2, char* lds) {
    int tid = threadIdx.x; asm volatile("" : "+v"(tid));
    const int wid = tid >> 6, lane = tid & 63, r32 = lane & 31, hi = lane >> 5;
    const int sr = tid >> 4, sc = (tid & 15) * 8, vst0 = v_st(sr, sc), vst1 = v_st(32 + sr, sc);
    const int kr = tid >> 3, kc = (tid & 7) * 8, kst = v_st64(kr, kc);
#pragma unroll
    for (int t = 0; t < 4; ++t) {
        const bf16x8 a0 = *reinterpret_cast<const bf16x8*>(Vc + (size_t)(64 * t + sr) * 128 + sc), a1 = *reinterpret_cast<const bf16x8*>(Vc + (size_t)(64 * t + 32 + sr) * 128 + sc);
        const bf16x8 k0 = *reinterpret_cast<const bf16x8*>(Kc + (size_t)(64 * t + kr) * 64 + kc);
        const int i = 64 * t + kr;
        const float wf = __builtin_amdgcn_exp2f((float)(255 - i) * lgf2), wb = __builtin_amdgcn_exp2f((float)i * lgb2);
        *(bf16x8*)(lds + t * 32768 + vst0) = a0; *(bf16x8*)(lds + t * 32768 + vst1) = a1;
        *(bf16x8*)(lds + t * 32768 + 16384 + kst) = scale8(k0, wf); *(bf16x8*)(lds + t * 32768 + 24576 + kst) = scale8(k0, wb);
    }
    __syncthreads();
    const int dblk = wid >> 2, eblk = wid & 3;
    const int vb = (int)(uintptr_t)lds + v_rd_base(lane);
    f32x16 accf = {}, accb = {};
#pragma unroll
    for (int t = 0; t < 4; ++t) {
#pragma unroll
        for (int ks = 0; ks < 4; ++ks) {
            s16x4 vl, vh, fl, fh, bl, bh;
            const int vo = vb + t * 32768 + eblk * 512 + ks * 4096, ko = vb + t * 32768 + 16384 + dblk * 512 + ks * 2048;
            asm volatile("ds_read_b64_tr_b16 %0, %1" : "=&v"(vl) : "v"(vo) : "memory");
            asm volatile("ds_read_b64_tr_b16 %0, %1 offset:2048" : "=&v"(vh) : "v"(vo) : "memory");
            asm volatile("ds_read_b64_tr_b16 %0, %1" : "=&v"(fl) : "v"(ko) : "memory");
            asm volatile("ds_read_b64_tr_b16 %0, %1 offset:1024" : "=&v"(fh) : "v"(ko) : "memory");
            asm volatile("ds_read_b64_tr_b16 %0, %1 offset:8192" : "=&v"(bl) : "v"(ko) : "memory");
            asm volatile("ds_read_b64_tr_b16 %0, %1 offset:9216" : "=&v"(bh) : "v"(ko) : "memory");
            asm volatile("s_waitcnt lgkmcnt(0)" ::: "memory"); SBAR();
            const bf16x8 vf = (bf16x8){vl[0], vl[1], vl[2], vl[3], vh[0], vh[1], vh[2], vh[3]};
            const bf16x8 kf = (bf16x8){fl[0], fl[1], fl[2], fl[3], fh[0], fh[1], fh[2], fh[3]};
            const bf16x8 kb = (bf16x8){bl[0], bl[1], bl[2], bl[3], bh[0], bh[1], bh[2], bh[3]};
            accf = __builtin_amdgcn_mfma_f32_32x32x16_bf16(kf, vf, accf, 0, 0, 0);
            accb = __builtin_amdgcn_mfma_f32_32x32x16_bf16(kb, vf, accb, 0, 0, 0);
        }
    }
#pragma unroll
    for (int r = 0; r < 16; ++r) { const int d = 32 * dblk + crow(r, hi), e = 32 * eblk + r32;
        Sf[d * 128 + e] = accf[r]; Sb[d * 128 + e] = accb[r]; }
    __syncthreads();
}
__device__ __forceinline__ void out_unit(const bf16* __restrict__ Qc, const bf16* __restrict__ Kc, const bf16* __restrict__ Vc, const float* __restrict__ ST, int c,
                                         const bf16* __restrict__ RGc, const float* __restrict__ gnorm, bf16* __restrict__ MIXc, float lgf2, float lgb2, char* lds) {
    int tid = threadIdx.x; asm volatile("" : "+v"(tid));
    const int wid = tid >> 6, lane = tid & 63, r32 = lane & 31, hi = lane >> 5;
    const int sr = tid >> 4, sc = (tid & 15) * 8, vst0 = v_st(sr, sc), vst1 = v_st(32 + sr, sc);
    const int kr = tid >> 3, kc = (tid & 7) * 8, kst = KSWZ64(kr, kc * 2);
#pragma unroll
    for (int t = 0; t < 4; ++t) {
        const bf16x8 a0 = *reinterpret_cast<const bf16x8*>(Vc + (size_t)(64 * t + sr) * 128 + sc), a1 = *reinterpret_cast<const bf16x8*>(Vc + (size_t)(64 * t + 32 + sr) * 128 + sc);
        const bf16x8 k0 = *reinterpret_cast<const bf16x8*>(Kc + (size_t)(64 * t + kr) * 64 + kc);
        *(bf16x8*)(lds + 32768 + t * 16384 + vst0) = a0; *(bf16x8*)(lds + 32768 + t * 16384 + vst1) = a1;
        *(bf16x8*)(lds + t * 8192 + kst) = k0;
    }
    {
        float rf[2][8], rb[2][8];
#pragma unroll
        for (int q = 0; q < 2; ++q)
#pragma unroll
            for (int j = 0; j < 8; ++j) { rf[q][j] = 0.f; rb[q][j] = 0.f; }
        for (int g3 = 0; g3 < 9; g3 += 3) {
            f32x4 sv[3][2][2]; float wf[3], wb[3];
#pragma unroll
            for (int u = 0; u < 3; ++u) { const int cp = g3 + u; const bool fwd = cp < c;
                const float wgt = cp == c ? 0.f : (fwd ? __builtin_amdgcn_exp2f((float)(256 * (c - 1 - cp)) * lgf2) : __builtin_amdgcn_exp2f((float)(256 * (cp - c - 1)) * lgb2));
                wf[u] = fwd ? wgt : 0.f; wb[u] = fwd ? 0.f : wgt;
                const float* S = ST + ((size_t)cp * 2 + (fwd ? 0 : 1)) * 8192;
#pragma unroll
                for (int q = 0; q < 2; ++q) { sv[u][q][0] = *(const f32x4*)(S + (sr + 32 * q) * 128 + sc); sv[u][q][1] = *(const f32x4*)(S + (sr + 32 * q) * 128 + sc + 4); } }
#pragma unroll
            for (int u = 0; u < 3; ++u)
#pragma unroll
                for (int q = 0; q < 2; ++q)
#pragma unroll
                    for (int j = 0; j < 8; ++j) { const float v = sv[u][q][j >> 2][j & 3]; rf[q][j] += wf[u] * v; rb[q][j] += wb[u] * v; }
        }
        {
            const float wgt = __builtin_amdgcn_exp2f((float)(256 * (8 - c)) * lgb2);
            const float* S = ST + 8192;
#pragma unroll
            for (int q = 0; q < 2; ++q) { const f32x4 s0 = *(const f32x4*)(S + (sr + 32 * q) * 128 + sc), s1 = *(const f32x4*)(S + (sr + 32 * q) * 128 + sc + 4);
                rb[q][0] += wgt * s0.x; rb[q][1] += wgt * s0.y; rb[q][2] += wgt * s0.z; rb[q][3] += wgt * s0.w; rb[q][4] += wgt * s1.x; rb[q][5] += wgt * s1.y; rb[q][6] += wgt * s1.z; rb[q][7] += wgt * s1.w; }
        }
#pragma unroll
        for (int q = 0; q < 2; ++q) {
            v4u of, ob;
            of.x = pk2(rf[q][0], rf[q][1]); of.y = pk2(rf[q][2], rf[q][3]); of.z = pk2(rf[q][4], rf[q][5]); of.w = pk2(rf[q][6], rf[q][7]);
            ob.x = pk2(rb[q][0], rb[q][1]); ob.y = pk2(rb[q][2], rb[q][3]); ob.z = pk2(rb[q][4], rb[q][5]); ob.w = pk2(rb[q][6], rb[q][7]);
            *(v4u*)(lds + 98304 + (q ? vst1 : vst0)) = of; *(v4u*)(lds + 114688 + (q ? vst1 : vst0)) = ob;
        }
    }
    bf16x8 qr[4];
    const bf16* Qw = Qc + (long)(wid * 32 + r32) * 64 + hi * 8;
#pragma unroll
    for (int d0 = 0; d0 < 4; ++d0) qr[d0] = *reinterpret_cast<const bf16x8*>(Qw + d0 * 16);
    __syncthreads();
    const int i = wid * 32 + r32;
    f32x16 o[4] = {};
    const int vb0 = (int)(uintptr_t)lds + v_rd_base(lane);
#pragma unroll 1
    for (int t = 0; t < 4; ++t) {
        f32x16 p0, p1;
        qkt(p0, p1, lds + t * 8192, qr, r32, hi);
        const float fi = (float)(i - 64 * t - 4 * hi);
#pragma unroll
        for (int r = 0; r < 16; ++r) {
            const float d0 = fi - (float)((r & 3) + 8 * (r >> 2)), d1 = d0 - 32.f;
            const float x0 = d0 >= 0.f ? d0 * lgf2 : -d0 * lgb2, x1 = d1 >= 0.f ? d1 * lgf2 : -d1 * lgb2;
            p0[r] *= __builtin_amdgcn_exp2f(x0); p1[r] *= __builtin_amdgcn_exp2f(x1);
        }
        bf16x8 pa0, pa1, pa2, pa3;
#define PK4(P, BASE, OUT) do { unsigned a0 = cvtpk(P[BASE + 0], P[BASE + 1]), a1 = cvtpk(P[BASE + 2], P[BASE + 3]);   \
    unsigned b0 = cvtpk(P[BASE + 4], P[BASE + 5]), b1 = cvtpk(P[BASE + 6], P[BASE + 7]);                              \
    auto r0 = __builtin_amdgcn_permlane32_swap(a0, b0, false, false); auto r1 = __builtin_amdgcn_permlane32_swap(a1, b1, false, false); \
    v4u w = {r0[0], r1[0], r0[1], r1[1]}; OUT = *reinterpret_cast<bf16x8*>(&w); } while (0)
        PK4(p0, 0, pa0); PK4(p0, 8, pa1); PK4(p1, 0, pa2); PK4(p1, 8, pa3);
#undef PK4
        SBAR();
        pv_d0(o, vb0 + 32768 + t * 16384, pa0, pa1, pa2, pa3);
    }
    {
        const float af = __builtin_amdgcn_exp2f((float)(i + 1) * lgf2), ab = __builtin_amdgcn_exp2f((float)(256 - i) * lgb2);
        SBAR();
        pv_d0(o, vb0 + 98304, scale8(qr[0], af), scale8(qr[1], af), scale8(qr[2], af), scale8(qr[3], af));
        pv_d0(o, vb0 + 114688, scale8(qr[0], ab), scale8(qr[1], ab), scale8(qr[2], ab), scale8(qr[3], ab));
    }
    __syncthreads();
    {
        float* stg = (float*)(lds + wid * 16384);
#pragma unroll
        for (int r = 0; r < 16; ++r) { const int orow = crow(r, hi);
#pragma unroll
            for (int d0 = 0; d0 < 4; ++d0) stg[orow * 128 + d0 * 32 + r32] = o[d0][r]; }
        const int c0 = (lane & 15) * 8, rq = lane >> 4;
        v4u gv[8];
#pragma unroll
        for (int i = 0; i < 8; ++i) gv[i] = *(const v4u*)(RGc + (size_t)(wid * 32 + i * 4 + rq) * 512 + c0);
        const f32x4 gn0 = *(const f32x4*)(gnorm + c0), gn1 = *(const f32x4*)(gnorm + c0 + 4);
        asm volatile("s_waitcnt lgkmcnt(0)" ::: "memory");
#pragma unroll
        for (int i = 0; i < 8; ++i) { const int row = i * 4 + rq;
            const f32x4 y0 = *(const f32x4*)(stg + row * 128 + c0), y1 = *(const f32x4*)(stg + row * 128 + c0 + 4);
            float ss = (y0.x * y0.x + y0.y * y0.y) + (y0.z * y0.z + y0.w * y0.w) + (y1.x * y1.x + y1.y * y1.y) + (y1.z * y1.z + y1.w * y1.w);
            ss += __int_as_float(__builtin_amdgcn_update_dpp(0, __float_as_int(ss), 0xB1, 0xf, 0xf, true));
            ss += __int_as_float(__builtin_amdgcn_update_dpp(0, __float_as_int(ss), 0x4E, 0xf, 0xf, true));
            ss += __int_as_float(__builtin_amdgcn_update_dpp(0, __float_as_int(ss), 0x141, 0xf, 0xf, true));
            ss += __int_as_float(__builtin_amdgcn_update_dpp(0, __float_as_int(ss), 0x140, 0xf, 0xf, true));
            const float rstd = rsqrtf(ss * (1.f / 128.f) + 1e-6f);
            float yv[8] = {y0.x, y0.y, y0.z, y0.w, y1.x, y1.y, y1.z, y1.w}; const float gnv[8] = {gn0.x, gn0.y, gn0.z, gn0.w, gn1.x, gn1.y, gn1.z, gn1.w};
            v4u ov;
#pragma unroll
            for (int j = 0; j < 4; ++j) { const float ga = __builtin_bit_cast(float, gv[i][j] << 16), gb = __builtin_bit_cast(float, gv[i][j] & 0xffff0000u);
                const float sa = ga * __builtin_amdgcn_rcpf(1.f + __expf(-ga)), sb = gb * __builtin_amdgcn_rcpf(1.f + __expf(-gb));
                ov[j] = pk2(yv[2 * j] * rstd * gnv[2 * j] * sa, yv[2 * j + 1] * rstd * gnv[2 * j + 1] * sb); }
            *(v4u*)(MIXc + (size_t)(wid * 32 + row) * 1024 + c0) = ov;
        }
    }
    __syncthreads();
}
#undef SBAR
}
namespace peer {
#ifndef PEER_DOT2
#define PEER_DOT2 0
#endif
using att::crow;
typedef __bf16 bf16x2_t __attribute__((ext_vector_type(2)));
__device__ __forceinline__ unsigned fkey(float f) { const unsigned u = __float_as_uint(f); return u ^ ((unsigned)((int)u >> 31) | 0x80000000u); }
__device__ __forceinline__ float kval(unsigned k) { const unsigned u = (k & 0x80000000u) ? (k ^ 0x80000000u) : ~k; return __uint_as_float(u); }
#define KSWZ256(row, colB) ((row) * 256 + ((colB) ^ (((row) & 7) << 4)))
template <int N> __device__ __forceinline__ void bitonic_sort_desc(unsigned (&a)[N]) {
#pragma unroll
    for (int k = 2; k <= N; k <<= 1)
#pragma unroll
        for (int j = k >> 1; j > 0; j >>= 1)
#pragma unroll
            for (int i = 0; i < N; ++i) { const int l = i ^ j;
                if (l > i) { const bool desc = (i & k) == 0; const unsigned mx = a[i] > a[l] ? a[i] : a[l], mn = a[i] > a[l] ? a[l] : a[i]; a[i] = desc ? mx : mn; a[l] = desc ? mn : mx; } }
}
template <int N> __device__ __forceinline__ void bitonic_merge_desc(unsigned (&a)[N]) {
#pragma unroll
    for (int j = N >> 1; j > 0; j >>= 1)
#pragma unroll
        for (int i = 0; i < N; ++i) { const int l = i ^ j;
            if (l > i) { const unsigned mx = a[i] > a[l] ? a[i] : a[l], mn = a[i] > a[l] ? a[l] : a[i]; a[i] = mx; a[l] = mn; } }
}
__device__ __forceinline__ void merge_top16(unsigned (&Lst)[16], const unsigned (&S)[16]) {
#pragma unroll
    for (int i = 0; i < 16; ++i) Lst[i] = Lst[i] > S[15 - i] ? Lst[i] : S[15 - i];
    bitonic_merge_desc<16>(Lst);
}
__device__ __forceinline__ float max8_dpp(float a) {
    a = fmaxf(a, __int_as_float(__builtin_amdgcn_update_dpp(0, __float_as_int(a), 0xB1, 0xf, 0xf, true)));
    a = fmaxf(a, __int_as_float(__builtin_amdgcn_update_dpp(0, __float_as_int(a), 0x4E, 0xf, 0xf, true)));
    a = fmaxf(a, __int_as_float(__builtin_amdgcn_update_dpp(0, __float_as_int(a), 0x141, 0xf, 0xf, true)));
    return a;
}
__device__ __forceinline__ void quant_h2_wave(int t0w, int c, const bf16* __restrict__ x1a, const float* __restrict__ ssq, const float* __restrict__ mod,
                                              unsigned char* __restrict__ HQ, float* __restrict__ HS, int lane) {
    const int s = lane & 7, k0 = 256 * c + 32 * s;
#pragma unroll
    for (int pass = 0; pass < 2; ++pass) {
        const int t = t0w + pass * 8 + (lane >> 3), b = t >> 11;
        const f32x4 s0 = *(const f32x4*)(ssq + (size_t)t * 16), s1 = *(const f32x4*)(ssq + (size_t)t * 16 + 4), s2 = *(const f32x4*)(ssq + (size_t)t * 16 + 8), s3 = *(const f32x4*)(ssq + (size_t)t * 16 + 12);
        const float tot = ((s0.x + s0.y) + (s0.z + s0.w)) + ((s1.x + s1.y) + (s1.z + s1.w)) + ((s2.x + s2.y) + (s2.z + s2.w)) + ((s3.x + s3.y) + (s3.z + s3.w));
        const float rstd = rsqrtf(tot * (1.f / 1024.f) + 1e-6f);
        const float* be = mod + (size_t)b * 6144 + 3 * 1024 + k0;
        f32x4 hv[8]; float am = 0.f;
#pragma unroll
        for (int u = 0; u < 4; ++u) { const v4u xa = *(const v4u*)(x1a + (size_t)t * 1024 + k0 + 8 * u);
#pragma unroll
            for (int hh = 0; hh < 2; ++hh) { const unsigned w0 = xa[2 * hh], w1 = xa[2 * hh + 1];
                const f32x4 xv = {__builtin_bit_cast(float, w0 << 16), __builtin_bit_cast(float, w0 & 0xffff0000u), __builtin_bit_cast(float, w1 << 16), __builtin_bit_cast(float, w1 & 0xffff0000u)};
                const f32x4 h = xv * rstd + *(const f32x4*)(be + 8 * u + 4 * hh); hv[2 * u + hh] = h;
                am = fmaxf(am, fmaxf(fmaxf(fabsf(h.x), fabsf(h.y)), fmaxf(fabsf(h.z), fabsf(h.w)))); } }
        am = max8_dpp(am);
        const float sc = am > 0.f ? 119.f / am : 0.f;
        v4u oa, ob;
#pragma unroll
        for (int k = 0; k < 4; ++k) { unsigned wa = 0u, wb = 0u;
#pragma unroll
            for (int i = 0; i < 8; ++i) { const float f = (i < 4) ? hv[2 * k][i] : hv[2 * k + 1][i - 4]; const int q = (int)rintf(f * sc); const int ahi = (q + 8) >> 4, blo = q - 16 * ahi;
                wa |= ((unsigned)ahi & 15u) << (4 * i); wb |= ((unsigned)blo & 15u) << (4 * i); }
            oa[k] = wa; ob[k] = wb; }
        unsigned char* dst = HQ + ((size_t)c * 16384 + t) * 256 + 32 * s;
        *(v4u*)dst = oa; *(v4u*)(dst + 16) = ob;
        if (s == 0) HS[(size_t)c * 16384 + t] = am * (1.f / 119.f);
    }
}
__device__ __forceinline__ void topk_p_lds(const bf16* __restrict__ skf, const char* qlds, int r32, int hi, unsigned (&Lst)[16]) {
    bf16x8 bq[8];
#pragma unroll
    for (int ks = 0; ks < 8; ++ks) bq[ks] = *reinterpret_cast<const bf16x8*>(qlds + ((2 * ks + hi) * 32 + r32) * 16);
#pragma unroll
    for (int kb = 0; kb < 4; ++kb) {
        bf16x8 a[8];
#pragma unroll
        for (int ks = 0; ks < 8; ++ks) a[ks] = *reinterpret_cast<const bf16x8*>(skf + (size_t)((((kb * 8 + ks) * 2 + hi) * 32 + r32) * 8));
        f32x16 acc = {};
#pragma unroll
        for (int ks = 0; ks < 8; ++ks) acc = __builtin_amdgcn_mfma_f32_32x32x16_bf16(a[ks], bq[ks], acc, 0, 0, 0);
        unsigned S[16];
#pragma unroll
        for (int r = 0; r < 16; ++r) S[r] = (fkey(acc[r]) & ~127u) | (unsigned)(32 * kb + crow(r, hi));
        bitonic_sort_desc<16>(S);
        if (kb == 0) {
#pragma unroll
            for (int r = 0; r < 16; ++r) Lst[r] = S[r];
        } else merge_top16(Lst, S);
    }
    unsigned Y[16];
#pragma unroll
    for (int s = 0; s < 16; ++s) { auto rr = __builtin_amdgcn_permlane32_swap(Lst[s], Lst[s], false, false); Y[s] = hi ? rr[0] : rr[1]; }
    merge_top16(Lst, Y);
}
__device__ __forceinline__ void select_wave_lds(const bf16* __restrict__ skf_h, char* qtile, int h, int* __restrict__ pidx, float* __restrict__ pgate, int wid, int lane) {
    const int r32 = lane & 31, hi = lane >> 5;
    unsigned T0[16], T1[16];
    topk_p_lds(skf_h, qtile + (wid * 2 + 0) * 8192, r32, hi, T0);
    topk_p_lds(skf_h + 4 * 8 * 2 * 32 * 8, qtile + (wid * 2 + 1) * 8192, r32, hi, T1);
    asm volatile("s_waitcnt lgkmcnt(0)" ::: "memory");
    unsigned short* tab = (unsigned short*)(qtile + wid * 16384) + lane;
    unsigned C[16], R1[16], X[32];
#define PEER_CAND(a, b, cid, dst) do { const float sum_ = kval(T0[a] & ~127u) + kval(T1[b] & ~127u); dst = (fkey(sum_) & ~63u) | (unsigned)(cid); \
        tab[(cid) * 64] = (unsigned short)((T0[a] & 127u) * 128u + (T1[b] & 127u)); } while (0)
#pragma unroll
    for (int b = 0; b < 16; ++b) PEER_CAND(0, b, 15 - b, C[b]);
#pragma unroll
    for (int b = 0; b < 16; ++b) { if (b < 8) PEER_CAND(1, b, 23 - b, R1[b]); else R1[b] = 0u; }
    {   int xi = 0;
#pragma unroll
        for (int a = 2; a < 16; ++a)
#pragma unroll
            for (int b = 0; b < 16; ++b) if ((a + 1) * (b + 1) <= 16) { PEER_CAND(a, b, 24 + xi, X[xi]); ++xi; }
#pragma unroll
        for (int q = 26; q < 32; ++q) X[q] = 0u;
    }
#undef PEER_CAND
    merge_top16(C, R1);
    bitonic_sort_desc<32>(X);
    {   unsigned X16[16];
#pragma unroll
        for (int q = 0; q < 16; ++q) X16[q] = X[q];
        merge_top16(C, X16); }
    asm volatile("s_waitcnt lgkmcnt(0)" ::: "memory");
    float v[16]; float sum = 0.f; const float mx = kval(C[0] & ~63u);
#pragma unroll
    for (int s = 0; s < 16; ++s) { v[s] = __expf(kval(C[s] & ~63u) - mx); sum += v[s]; }
    const float inv = 1.f / sum;
    int ex[16];
#pragma unroll
    for (int s = 0; s < 16; ++s) ex[s] = (int)tab[(C[s] & 63u) * 64];
    if (hi == 0) {
        int* pi = pidx + (size_t)(wid * 32 + r32) * 128 + h * 16; float* pg = pgate + (size_t)(wid * 32 + r32) * 128 + h * 16;
#pragma unroll
        for (int s = 0; s < 16; s += 4) { *(int4*)(pi + s) = make_int4(ex[s], ex[s + 1], ex[s + 2], ex[s + 3]); *(f32x4*)(pg + s) = (f32x4){v[s] * inv, v[s + 1] * inv, v[s + 2] * inv, v[s + 3] * inv}; }
    }
}
__device__ __forceinline__ void cvt_row_fp8(const float* __restrict__ src, unsigned char* __restrict__ T8, float* __restrict__ inv_scale, int e, int lane) {
    f32x4 v[4]; float am = 0.f;
#pragma unroll
    for (int j = 0; j < 4; ++j) { v[j] = *(const f32x4*)(src + (size_t)e * 1024 + 16 * lane + 4 * j);
        am = fmaxf(am, fmaxf(fmaxf(fabsf(v[j].x), fabsf(v[j].y)), fmaxf(fabsf(v[j].z), fabsf(v[j].w)))); }
#pragma unroll
    for (int o = 1; o < 64; o <<= 1) am = fmaxf(am, __shfl_xor(am, o));
    const int ex = (int)((__float_as_uint(am) >> 23) & 0xffu) - 127;
    const int k = (am > 0.f) ? (7 - ex) : 0;
    const int kc = k > 120 ? 120 : (k < -120 ? -120 : k);
    const float sc = __uint_as_float((unsigned)(127 + kc) << 23), isc = __uint_as_float((unsigned)(127 - kc) << 23);
    v4u o;
#pragma unroll
    for (int j = 0; j < 4; ++j) { int pk = 0;
        pk = __builtin_amdgcn_cvt_pk_fp8_f32(v[j].x * sc, v[j].y * sc, pk, false); pk = __builtin_amdgcn_cvt_pk_fp8_f32(v[j].z * sc, v[j].w * sc, pk, true); o[j] = (unsigned)pk; }
    *(v4u*)(T8 + ((size_t)(lane >> 3) * 16384 + e) * 128 + 16 * (lane & 7)) = o;
    if (lane == 0) inv_scale[e] = isc;
}
__device__ __forceinline__ unsigned fp4_code(float y) { const int q = (int)rintf(y); return (unsigned)q & 15u; }
__device__ __forceinline__ unsigned spread4(unsigned h16) { unsigned y = h16 & 0xffffu; y = (y | (y << 8)) & 0x00ff00ffu; y = (y | (y << 4)) & 0x0f0f0f0fu; return y; }
__device__ __forceinline__ void cvt_row_fp4(const float* __restrict__ src, unsigned char* __restrict__ T4, float* __restrict__ inv_scale, int e, int lane) {
    f32x4 v[4]; float am = 0.f;
#pragma unroll
    for (int j = 0; j < 4; ++j) { v[j] = *(const f32x4*)(src + (size_t)e * 1024 + 16 * lane + 4 * j);
        am = fmaxf(am, fmaxf(fmaxf(fabsf(v[j].x), fabsf(v[j].y)), fmaxf(fabsf(v[j].z), fabsf(v[j].w)))); }
#pragma unroll
    for (int o = 1; o < 64; o <<= 1) am = fmaxf(am, __shfl_xor(am, o));
    const float sc = am > 0.f ? 7.f / am : 0.f;
    unsigned n0 = 0u, n1 = 0u;
#pragma unroll
    for (int i = 0; i < 8; ++i) { n0 |= fp4_code(v[i >> 2][i & 3] * sc) << (4 * i); n1 |= fp4_code(v[2 + (i >> 2)][i & 3] * sc) << (4 * i); }
    const unsigned p0 = (unsigned)__builtin_amdgcn_update_dpp(0, (int)n0, 0xB1, 0xf, 0xf, true), p1 = (unsigned)__builtin_amdgcn_update_dpp(0, (int)n1, 0xB1, 0xf, 0xf, true);
    if ((lane & 1) == 0) {
        v4u o;
        o.x = spread4(n0) | (spread4(p0) << 4); o.y = spread4(n0 >> 16) | (spread4(p0 >> 16) << 4);
        o.z = spread4(n1) | (spread4(p1) << 4); o.w = spread4(n1 >> 16) | (spread4(p1 >> 16) << 4);
        *(v4u*)(T4 + ((size_t)(lane >> 4) * 16384 + e) * 128 + 16 * ((lane & 15) >> 1)) = o;
    }
    if (lane == 0) inv_scale[e] = am * (1.f / (7.f * 16.f));
}
__device__ __forceinline__ void cvt_row_i4(const float* __restrict__ src, unsigned char* __restrict__ T4, float* __restrict__ inv_scale, int e, int lane) {
    f32x4 v[4]; float am = 0.f;
#pragma unroll
    for (int j = 0; j < 4; ++j) { v[j] = *(const f32x4*)(src + (size_t)e * 1024 + 16 * lane + 4 * j);
        am = fmaxf(am, fmaxf(fmaxf(fabsf(v[j].x), fabsf(v[j].y)), fmaxf(fabsf(v[j].z), fabsf(v[j].w)))); }
#pragma unroll
    for (int o = 1; o < 64; o <<= 1) am = fmaxf(am, __shfl_xor(am, o));
    const float sc = am > 0.f ? 7.f / am : 0.f;
    v2u o;
#pragma unroll
    for (int k = 0; k < 2; ++k) { unsigned w = 0u;
#pragma unroll
        for (int i = 0; i < 8; ++i) { const int q = (int)rintf(v[2 * k + (i >> 2)][i & 3] * sc); w |= ((unsigned)q & 15u) << (4 * i); }
        o[k] = w; }
    *(v2u*)(T4 + ((size_t)(lane >> 4) * 16384 + e) * 128 + 8 * (lane & 15)) = o;
    if (lane == 0) inv_scale[e] = am * (1.f / 7.f);
}
__device__ __forceinline__ int sum8_dpp_i(int a) {
    a += __builtin_amdgcn_update_dpp(0, a, 0xB1, 0xf, 0xf, true);
    a += __builtin_amdgcn_update_dpp(0, a, 0x4E, 0xf, 0xf, true);
    a += __builtin_amdgcn_update_dpp(0, a, 0x141, 0xf, 0xf, true);
    return a;
}
__device__ __forceinline__ float gelu_exact(float x) { return 0.5f * x * (1.f + erff(x * 0.70710678118654752f)); }
struct Rows { v4u v[16]; };
__device__ __forceinline__ void issue_rows(Rows& R, const unsigned short* __restrict__ idxrow, const unsigned char* __restrict__ base  , unsigned loff  , int r) {
#pragma unroll
    for (int i = 0; i < 16; ++i) { const unsigned e = idxrow[8 * i + r]; R.v[i] = *(const v4u*)(base + (e * 128u + loff)); }
}
__device__ __forceinline__ float sum8_dpp(float a) {
    a += __int_as_float(__builtin_amdgcn_update_dpp(0, __float_as_int(a), 0xB1, 0xf, 0xf, true));
    a += __int_as_float(__builtin_amdgcn_update_dpp(0, __float_as_int(a), 0x4E, 0xf, 0xf, true));
    a += __int_as_float(__builtin_amdgcn_update_dpp(0, __float_as_int(a), 0x141, 0xf, 0xf, true));
    return a;
}
__device__ __forceinline__ float xor8_dpp(float a) { return __int_as_float(__builtin_amdgcn_update_dpp(0, __float_as_int(a), 0x128, 0xf, 0xf, true)); }
typedef float f32x2 __attribute__((ext_vector_type(2)));
typedef _Float16 f16x2 __attribute__((ext_vector_type(2)));
__device__ __forceinline__ void dec16p(const v4u raw, f32x2 (&f)[8]) {
#pragma unroll
    for (int j = 0; j < 4; ++j) { f[2 * j] = __builtin_amdgcn_cvt_pk_f32_fp8((int)raw[j], false); f[2 * j + 1] = __builtin_amdgcn_cvt_pk_f32_fp8((int)raw[j], true); }
}
template <int OFF = 65536>
__device__ __forceinline__ void stage_idx(const int* __restrict__ pidx, int t0, char* lds, int tid) {
#pragma unroll
    for (int k = 0; k < 8; ++k) { const int q = tid + 512 * k;
        const int4 v = *(const int4*)(pidx + (size_t)t0 * 128 + (size_t)q * 4);
        v2u o; o.x = (unsigned)v.x | ((unsigned)v.y << 16); o.y = (unsigned)v.z | ((unsigned)v.w << 16);
        *(v2u*)(lds + OFF + q * 8) = o; }
}
__device__ __forceinline__ int reduce8_i(const int (&v)[8], int s) {
    const bool b2 = (s & 4) != 0, b1 = (s & 2) != 0, b0 = (s & 1) != 0;
    int q4[4], q2[2];
#pragma unroll
    for (int k = 0; k < 4; ++k) { const int keep = b2 ? v[k + 4] : v[k], send = b2 ? v[k] : v[k + 4]; q4[k] = keep + __builtin_amdgcn_update_dpp(0, send, 0x141, 0xf, 0xf, true); }
#pragma unroll
    for (int k = 0; k < 2; ++k) { const int keep = b1 ? q4[k + 2] : q4[k], send = b1 ? q4[k] : q4[k + 2]; q2[k] = keep + __builtin_amdgcn_update_dpp(0, send, 0x4E, 0xf, 0xf, true); }
    const int keep = b0 ? q2[1] : q2[0], send = b0 ? q2[0] : q2[1];
    return keep + __builtin_amdgcn_update_dpp(0, send, 0xB1, 0xf, 0xf, true);
}
__device__ __forceinline__ void gatherA_stream(int c, int tile0, int tstep, int ntiles, const unsigned char* __restrict__ HQ,
                                               const int* __restrict__ pidx, const unsigned char* __restrict__ UT4, bf16* __restrict__ part, char* lds) {
    int tid = threadIdx.x; asm volatile("" : "+v"(tid));
    const int wid = tid >> 6, lane = tid & 63, r = lane >> 3, s = lane & 7;
    const int N = ntiles * 16;
    if (N <= 0) return;
    const unsigned char* base = UT4 + (size_t)c * 16384 * 128; const unsigned loff = 16u * (unsigned)s, l4 = 4u * (unsigned)lane;
    const unsigned char* hqc = HQ + (size_t)c * 16384 * 256; const unsigned char* pib = (const unsigned char*)pidx;
    bf16* partc = part + (size_t)c * 16384 * 128 + 8 * s + r;
    LAS unsigned char* ring = (LAS unsigned char*)lds + wid * 16384;
    LAS unsigned char* meta = (LAS unsigned char*)lds + 132096 + wid * 1536;
#define PEER_TOK(n) ((tile0 + ((n) >> 4) * tstep) * 128 + wid * 16 + ((n) & 15))
#define PEER_ISSUE_H(n) do { const unsigned t_ = (unsigned)PEER_TOK(n); \
        __builtin_amdgcn_global_load_lds((const unsigned*)(hqc + (t_ * 256u + l4)), (LAS unsigned*)(meta + ((n) & 1) * 256), 4, 0, 0); } while (0)
#define PEER_ISSUE_I(n) do { const unsigned t_ = (unsigned)PEER_TOK(n); \
        __builtin_amdgcn_global_load_lds((const unsigned*)(pib + (t_ * 512u + l4)), (LAS unsigned*)(meta + 512 + ((n) & 1) * 512), 4, 0, 0); \
        __builtin_amdgcn_global_load_lds((const unsigned*)(pib + (t_ * 512u + 256u + l4)), (LAS unsigned*)(meta + 512 + ((n) & 1) * 512 + 256), 4, 0, 0); } while (0)
#define PEER_LOAD_IDX(n) do { _Pragma("unroll") for (int i_ = 0; i_ < 16; ++i_) idxv[i_] = *(const LAS unsigned*)(meta + 512 + ((n) & 1) * 512 + (8 * i_ + r) * 4); } while (0)
#define PEER_ISSUE_ROW(i) __builtin_amdgcn_global_load_lds((const unsigned*)(base + (idxv[i] * 128u + loff)), (LAS unsigned*)(ring + (i) * 1024), 16, 0, 0)
#define PEER_READ_ROW(i) (*(const LAS v4u*)(ring + (i) * 1024 + lane * 16))
#define PEER_DOT_A(rw, i) do { int a_ = __builtin_amdgcn_sdot8((int)rw[0], (int)ha[0], 0, false), b_ = __builtin_amdgcn_sdot8((int)rw[0], (int)hb[0], 0, false); \
        a_ = __builtin_amdgcn_sdot8((int)rw[1], (int)ha[1], a_, false); b_ = __builtin_amdgcn_sdot8((int)rw[1], (int)hb[1], b_, false); \
        a_ = __builtin_amdgcn_sdot8((int)rw[2], (int)ha[2], a_, false); b_ = __builtin_amdgcn_sdot8((int)rw[2], (int)hb[2], b_, false); \
        a_ = __builtin_amdgcn_sdot8((int)rw[3], (int)ha[3], a_, false); b_ = __builtin_amdgcn_sdot8((int)rw[3], (int)hb[3], b_, false); \
        pr[(i) & 7] = a_ * 16 + b_; \
        if ((i) == 7) res0 = reduce8_i(pr, s); else if ((i) == 15) res1 = reduce8_i(pr, s); } while (0)
#define PEER_VMWAIT(N) asm volatile("s_waitcnt vmcnt(" #N ")" ::: "memory")
#define PEER_LOAD_H(n) do { ha = *(const LAS v4u*)(meta + ((n) & 1) * 256 + 32 * s); hb = *(const LAS v4u*)(meta + ((n) & 1) * 256 + 32 * s + 16); } while (0)
    unsigned idxv[16]; v4u ha, hb, rcur, rnext; int pr[8];
    PEER_ISSUE_H(0); PEER_ISSUE_I(0); PEER_ISSUE_I(N > 1 ? 1 : 0);
    PEER_VMWAIT(0);
    PEER_LOAD_IDX(0);
#pragma unroll
    for (int i = 0; i < 16; ++i) PEER_ISSUE_ROW(i);
    PEER_VMWAIT(15);
    rcur = PEER_READ_ROW(0);
#pragma unroll 1
    for (int n = 0; n < N - 1; ++n) {
        int res0 = 0, res1 = 0;
        PEER_LOAD_IDX(n + 1);
        PEER_ISSUE_H(n + 1); { const int n2 = n + 2 < N ? n + 2 : N - 1; PEER_ISSUE_I(n2); }
        PEER_LOAD_H(n);
#pragma unroll
        for (int i = 0; i < 16; ++i) {
            if (i < 15) PEER_VMWAIT(17); else PEER_VMWAIT(14);
            rnext = PEER_READ_ROW((i + 1) & 15);
            PEER_DOT_A(rcur, i);
            asm volatile("s_waitcnt lgkmcnt(1)" ::: "memory");
            PEER_ISSUE_ROW(i);
            rcur = rnext;
        }
        bf16* prow = partc + (size_t)PEER_TOK(n) * 128; prow[0] = (bf16)f2bf((float)res0); prow[64] = (bf16)f2bf((float)res1);
    }
    {   int res0 = 0, res1 = 0;
        PEER_LOAD_H(N - 1);
        PEER_VMWAIT(14); rnext = PEER_READ_ROW(1);  PEER_DOT_A(rcur, 0);  rcur = rnext;
        PEER_VMWAIT(13); rnext = PEER_READ_ROW(2);  PEER_DOT_A(rcur, 1);  rcur = rnext;
        PEER_VMWAIT(12); rnext = PEER_READ_ROW(3);  PEER_DOT_A(rcur, 2);  rcur = rnext;
        PEER_VMWAIT(11); rnext = PEER_READ_ROW(4);  PEER_DOT_A(rcur, 3);  rcur = rnext;
        PEER_VMWAIT(10); rnext = PEER_READ_ROW(5);  PEER_DOT_A(rcur, 4);  rcur = rnext;
        PEER_VMWAIT(9);  rnext = PEER_READ_ROW(6);  PEER_DOT_A(rcur, 5);  rcur = rnext;
        PEER_VMWAIT(8);  rnext = PEER_READ_ROW(7);  PEER_DOT_A(rcur, 6);  rcur = rnext;
        PEER_VMWAIT(7);  rnext = PEER_READ_ROW(8);  PEER_DOT_A(rcur, 7);  rcur = rnext;
        PEER_VMWAIT(6);  rnext = PEER_READ_ROW(9);  PEER_DOT_A(rcur, 8);  rcur = rnext;
        PEER_VMWAIT(5);  rnext = PEER_READ_ROW(10); PEER_DOT_A(rcur, 9);  rcur = rnext;
        PEER_VMWAIT(4);  rnext = PEER_READ_ROW(11); PEER_DOT_A(rcur, 10); rcur = rnext;
        PEER_VMWAIT(3);  rnext = PEER_READ_ROW(12); PEER_DOT_A(rcur, 11); rcur = rnext;
        PEER_VMWAIT(2);  rnext = PEER_READ_ROW(13); PEER_DOT_A(rcur, 12); rcur = rnext;
        PEER_VMWAIT(1);  rnext = PEER_READ_ROW(14); PEER_DOT_A(rcur, 13); rcur = rnext;
        PEER_VMWAIT(0);  rnext = PEER_READ_ROW(15); PEER_DOT_A(rcur, 14); rcur = rnext;
        PEER_DOT_A(rcur, 15);
        bf16* prow = partc + (size_t)PEER_TOK(N - 1) * 128; prow[0] = (bf16)f2bf((float)res0); prow[64] = (bf16)f2bf((float)res1);
    }
#undef PEER_TOK
#undef PEER_ISSUE_H
#undef PEER_ISSUE_I
#undef PEER_LOAD_IDX
#undef PEER_ISSUE_ROW
#undef PEER_READ_ROW
#undef PEER_DOT_A
#undef PEER_VMWAIT
#undef PEER_LOAD_H
}
typedef int v2i32 __attribute__((ext_vector_type(2)));
typedef int v4i32 __attribute__((ext_vector_type(4)));
__device__ __forceinline__ void gatherB_stream(int c, int tile0, int tstep, int ntiles, float* out, const float* __restrict__ mod, const unsigned* __restrict__ pw,
                                               const unsigned char* __restrict__ VT4, char* lds) {
    int tid = threadIdx.x; asm volatile("" : "+v"(tid));
    const int wid = tid >> 6, lane = tid & 63, r = lane >> 3, g = lane >> 4, li = lane & 15;
    const int N = ntiles * 16;
    if (N <= 0) return;
    const int colb = 256 * c + 64 * g + li;
    float gt[2][4];
#pragma unroll
    for (int k = 0; k < 2; ++k) { const int tl = tile0 + (k < ntiles ? k : 0) * tstep; const float* gp = mod + (size_t)((tl * 128) >> 11) * 6144 + 5 * 1024 + colb;
#pragma unroll
        for (int u = 0; u < 4; ++u) gt[k][u] = gp[16 * u]; }
    asm volatile("s_waitcnt vmcnt(0)" ::: "memory");
#pragma unroll
    for (int k = 0; k < 2; ++k)
#pragma unroll
        for (int u = 0; u < 4; ++u) asm volatile("" : "+v"(gt[k][u]));
    const unsigned char* base = VT4 + (size_t)c * 16384 * 128; const unsigned l4 = 4u * (unsigned)lane;
    const unsigned loff0 = 16u * (unsigned)((lane & 7) ^ (r >> 1)), loff1 = loff0 ^ 64u;
    const unsigned char* pwb = (const unsigned char*)pw;
    LAS unsigned char* ring = (LAS unsigned char*)lds + wid * 16384;
    LAS unsigned char* meta = (LAS unsigned char*)lds + 132096 + wid * 512;
    LAS unsigned char* xslot = (LAS unsigned char*)lds + 136192 + wid * 1024;
    const unsigned char* xb = (const unsigned char*)(out + 256 * c);
    unsigned tra[8];
#pragma unroll
    for (int t = 0; t < 8; ++t) tra[t] = (unsigned)(g * 1024 + (li >> 1) * 128 + ((t ^ (li >> 2) ^ (4 * (g & 1))) * 16) + 8 * (li & 1));
    const int m4 = li & 3;
    const unsigned aoffs = (unsigned)((m4 == 1 ? 384 : 256) + 8 * g);
#define PEER_TOK(n) ((tile0 + ((n) >> 4) * tstep) * 128 + wid * 16 + ((n) & 15))
#define PEER_ISSUE_W(n) do { const unsigned t_ = (unsigned)PEER_TOK(n); \
        __builtin_amdgcn_global_load_lds((const unsigned*)(pwb + (t_ * 512u + l4)), (LAS unsigned*)(meta), 4, 0, 0); \
        __builtin_amdgcn_global_load_lds((const unsigned*)(pwb + (t_ * 512u + 256u + l4)), (LAS unsigned*)(meta + 256), 4, 0, 0); } while (0)
#define PEER_ISSUE_X(n) do { const unsigned t_ = (unsigned)PEER_TOK(n); \
        __builtin_amdgcn_global_load_lds((const unsigned*)(xb + ((size_t)t_ * 4096u + 4u * l4)), (LAS unsigned*)(xslot), 16, 0, 0); } while (0)
#define PEER_LOAD_IDX() do { _Pragma("unroll") for (int i_ = 0; i_ < 16; ++i_) idxv[i_] = *(const LAS unsigned short*)(meta + (8 * i_ + r) * 2); } while (0)
#define PEER_ISSUE_ROW(i) __builtin_amdgcn_global_load_lds((const unsigned*)(base + ((idxv[i] & 0x3fffu) * 128u + (((i) & 1) ? loff1 : loff0))), (LAS unsigned*)(ring + (i) * 1024), 16, 0, 0)
#define PEER_LOAD_A(AOP, WS) do { _Pragma("unroll") for (int q_ = 0; q_ < 2; ++q_) { const v2u a_ = *(const LAS v2u*)(meta + aoffs + 64 * q_), b_ = *(const LAS v2u*)(meta + aoffs + 64 * q_ + 32); \
            v4i32 z_; z_[0] = m4 < 2 ? (int)a_.x : 0; z_[1] = m4 < 2 ? (int)a_.y : 0; z_[2] = m4 < 2 ? (int)b_.x : 0; z_[3] = m4 < 2 ? (int)b_.y : 0; AOP[q_] = z_; } \
        const v2u d_ = *(const LAS v2u*)(meta); \
        const int kb_ = (int)(((d_.x >> 14) & 3u) | (((d_.x >> 30) & 3u) << 2) | (((d_.y >> 14) & 3u) << 4) | (((d_.y >> 30) & 3u) << 6)); \
        WS = __uint_as_float((unsigned)(255 - kb_) << 23); } while (0)
#define PEER_WIDEN(x, L, H) do { L = (int)((((unsigned)(x)) << 4) & 0xf0f0f0f0u); H = (int)(((unsigned)(x)) & 0xf0f0f0f0u); } while (0)
#define PEER_KSTEP_B(Q) do { _Pragma("unroll") for (int t_ = 0; t_ < 8; ++t_) { \
            const v2i32 b0_ = __builtin_amdgcn_ds_read_tr8_b64_v2i32((LAS v2i32*)(ring + (Q) * 8192 + tra[t_])); \
            const v2i32 b1_ = __builtin_amdgcn_ds_read_tr8_b64_v2i32((LAS v2i32*)(ring + (Q) * 8192 + 4096 + tra[t_])); \
            v4i32 lo_, hi_; PEER_WIDEN(b0_[0], lo_[0], hi_[0]); PEER_WIDEN(b0_[1], lo_[1], hi_[1]); PEER_WIDEN(b1_[0], lo_[2], hi_[2]); PEER_WIDEN(b1_[1], lo_[3], hi_[3]); \
            acc[2 * t_] = __builtin_amdgcn_mfma_i32_16x16x64_i8(aop[Q], lo_, acc[2 * t_], 0, 0, 0); \
            acc[2 * t_ + 1] = __builtin_amdgcn_mfma_i32_16x16x64_i8(aop[Q], hi_, acc[2 * t_ + 1], 0, 0, 0); } \
        asm volatile("s_waitcnt lgkmcnt(0)" ::: "memory"); } while (0)
#define PEER_VMWAIT(N) asm volatile("s_waitcnt vmcnt(" #N ")" ::: "memory")
#define PEER_FINISH_B(n) do { const int t_ = PEER_TOK(n); const bool k1_ = ((n) >> 4) != 0; \
        float* o_ = out + (size_t)t_ * 1024 + colb; \
        _Pragma("unroll") for (int u_ = 0; u_ < 4; ++u_) { \
            const v4i32 s_ = g == 0 ? acc[u_] : (g == 1 ? acc[4 + u_] : (g == 2 ? acc[8 + u_] : acc[12 + u_])); \
            const float x_ = *(const LAS float*)(xslot + (64 * g + 16 * u_ + li) * 4); \
            o_[16 * u_] = x_ + (k1_ ? gt[1][u_] : gt[0][u_]) * (((float)s_[0] + (float)s_[1] * (1.f / 128.f)) * wscale); } \
        asm volatile("s_waitcnt lgkmcnt(0)" ::: "memory"); \
        _Pragma("unroll") for (int q_ = 0; q_ < 16; ++q_) acc[q_] = (v4i32){0, 0, 0, 0}; } while (0)
    unsigned idxv[16]; v4i32 aop[2], aopn[2]; v4i32 acc[16]; float wscale, wscalen;
#pragma unroll
    for (int q = 0; q < 16; ++q) acc[q] = (v4i32){0, 0, 0, 0};
    PEER_ISSUE_W(0);
    PEER_VMWAIT(0);
    PEER_LOAD_IDX(); PEER_LOAD_A(aop, wscale);
    asm volatile("s_waitcnt lgkmcnt(0)" ::: "memory");
    PEER_ISSUE_W(N > 1 ? 1 : 0);
#pragma unroll
    for (int i = 0; i < 16; ++i) PEER_ISSUE_ROW(i);
    PEER_VMWAIT(16);
#pragma unroll 1
    for (int n = 0; n < N - 1; ++n) {
        PEER_LOAD_IDX(); PEER_LOAD_A(aopn, wscalen);
        asm volatile("s_waitcnt lgkmcnt(0)" ::: "memory");
        { const int n2 = n + 2 < N ? n + 2 : N - 1; PEER_ISSUE_W(n2); }
        PEER_ISSUE_X(n);
        PEER_VMWAIT(11); PEER_KSTEP_B(0);
        PEER_ISSUE_ROW(0);  PEER_ISSUE_ROW(1);  PEER_ISSUE_ROW(2);  PEER_ISSUE_ROW(3);  PEER_ISSUE_ROW(4);  PEER_ISSUE_ROW(5);  PEER_ISSUE_ROW(6);  PEER_ISSUE_ROW(7);
        PEER_VMWAIT(11); PEER_KSTEP_B(1);
        PEER_ISSUE_ROW(8);  PEER_ISSUE_ROW(9);  PEER_ISSUE_ROW(10); PEER_ISSUE_ROW(11); PEER_ISSUE_ROW(12); PEER_ISSUE_ROW(13); PEER_ISSUE_ROW(14); PEER_ISSUE_ROW(15);
        PEER_VMWAIT(16);
        PEER_FINISH_B(n);
        aop[0] = aopn[0]; aop[1] = aopn[1];
        wscale = wscalen;
    }
    {
        PEER_ISSUE_X(N - 1);
        PEER_VMWAIT(9); PEER_KSTEP_B(0);
        PEER_VMWAIT(1); PEER_KSTEP_B(1);
        PEER_VMWAIT(0);
        PEER_FINISH_B(N - 1);
    }
#undef PEER_TOK
#undef PEER_ISSUE_W
#undef PEER_ISSUE_X
#undef PEER_LOAD_IDX
#undef PEER_ISSUE_ROW
#undef PEER_LOAD_A
#undef PEER_WIDEN
#undef PEER_KSTEP_B
#undef PEER_VMWAIT
#undef PEER_FINISH_B
}
}
namespace mk {
#ifndef MK_CTX_IN_P1
#define MK_CTX_IN_P1 0
#endif
#ifndef MK_DUP
#define MK_DUP -1
#endif
constexpr int NWAVES = 8, NTHR = 512;
constexpr int D = 1024, NB = 8, L = 2048, CT = 256, LT = L + CT, INC = 3072, NMODC = 6 * D;
constexpr int M1 = NB * LT;
constexpr int M2 = NB * L;
constexpr float EPS = 1e-6f;
constexpr float C2 = 0.125f * 1.4426950408889634f;
constexpr size_t MiB = 1u << 20;
constexpr size_t WS_CTL = 0, CTL_ZERO_BYTES = 64 * 1024;
constexpr size_t WS_MOD = 1 * MiB;
constexpr size_t WS_TAB = WS_MOD + 256 * 1024;
constexpr size_t WS_ALPHA2 = WS_TAB + 512 * 1024;
constexpr size_t WS_BIASQ = WS_ALPHA2 + 32 * 1024;
constexpr size_t WS_SSQ = 2 * MiB;
constexpr size_t WS_WIN = 3 * MiB;
constexpr size_t WS_WOUT = 9 * MiB;
constexpr size_t WS_WQ = 11 * MiB;
constexpr size_t WS_SUBK = 15 * MiB;
constexpr size_t WS_PU = 16 * MiB;
constexpr size_t WS_PV = 32 * MiB;
constexpr size_t WS_SU = 48 * MiB, WS_SV = 49 * MiB;
constexpr size_t WS_PART = 116 * MiB;
constexpr size_t WS_A = 80 * MiB;
constexpr size_t WS_HB = WS_A, WS_OD = WS_A, WS_X1A = WS_A;
constexpr size_t WS_B = 116 * MiB;
constexpr size_t WS_RQ = WS_B;
constexpr size_t WS_RK = WS_RQ + 8 * MiB;
constexpr size_t WS_RV = WS_RK + 9 * MiB;
constexpr size_t WS_RG = WS_RV + 18 * MiB;
constexpr size_t WS_DQ = WS_RG + 16 * MiB;
constexpr size_t WS_DK = WS_DQ + 16 * MiB;
constexpr size_t WS_DV = WS_DK + 18 * MiB;
constexpr size_t WS_ST = 219 * MiB;
constexpr size_t WS_MIX = WS_DQ;
constexpr size_t WS_QP = WS_B;
constexpr size_t WS_HQ = 180 * MiB;
constexpr size_t WS_HS = 196 * MiB;
constexpr size_t WS_PIDX = 200 * MiB;
constexpr size_t WS_PGATE = 208 * MiB;
constexpr size_t WS_END = 237 * MiB;
constexpr int CW_BAR = 1024;
static_assert((CW_BAR + XCD_BAR_WORDS) * 4 <= (int)CTL_ZERO_BYTES, "barrier words inside the memset region");
constexpr int RING_BYTES = 131072, MISC_OFF = RING_BYTES + 320, LDS_BYTES = 147456;

struct Args { const float* in[19]; float* out; unsigned char* ws; int ph_lo, ph_hi; };

template <int R, bool SILU>
__device__ __forceinline__ void gemv_rows(const float* const (&src)[R], const float* __restrict__ W, int N, const float* __restrict__ bias, float* __restrict__ out, int out_stride, LAS float* lds) {
    LAS float* s = lds; LAS float* part = lds + R * 1024;
    const int tid = threadIdx.x;
    bool did = false;
    for (int cb = blockIdx.x; cb < N / 32; cb += gridDim.x) {
        if (!did) {
            for (int i = tid; i < R * 1024; i += NTHR) { const int r = i >> 10, k = i & 1023; float v = 0.f;
#pragma unroll
                for (int q = 0; q < R; ++q) if (q == r) v = src[q][k];
                s[i] = SILU ? v / (1.f + expf(-v)) : v; }
            __syncthreads(); did = true;
        }
        const int cc = tid & 31, ks = tid >> 5;
        float acc[R];
#pragma unroll
        for (int r = 0; r < R; ++r) acc[r] = 0.f;
        const float* wp = W + (size_t)(ks * 64) * N + cb * 32 + cc;
#pragma unroll
        for (int k0 = 0; k0 < 64; k0 += 16) {
            float w[16];
#pragma unroll
            for (int k = 0; k < 16; ++k) w[k] = wp[(size_t)(k0 + k) * N];
#pragma unroll
            for (int k = 0; k < 16; ++k)
#pragma unroll
                for (int r = 0; r < R; ++r) acc[r] += s[r * 1024 + ks * 64 + k0 + k] * w[k]; }
#pragma unroll
        for (int r = 0; r < R; ++r) part[(ks * R + r) * 32 + cc] = acc[r];
        __syncthreads();
        if (tid < R * 32) { const int r = tid >> 5, c2 = tid & 31; float t = 0.f;
#pragma unroll
            for (int q = 0; q < 16; ++q) t += part[(q * R + r) * 32 + c2];
            out[(size_t)r * out_stride + cb * 32 + c2] = t + (bias ? bias[cb * 32 + c2] : 0.f); }
        __syncthreads();
    }
}
__device__ __forceinline__ void transpose_item(const float* __restrict__ W, int K, int N, bf16* __restrict__ WT, int k0, int n0, int n_dst0, LAS float* scr, int lane) {
#pragma unroll 8
    for (int i = 0; i < 32; ++i) { const int kk = 2 * i + (lane >> 5); scr[kk * 33 + (lane & 31)] = W[(size_t)(k0 + kk) * N + n0 + (lane & 31)]; }
    LDS_WAIT(); asm volatile("" ::: "memory");
    const int c = lane & 7;
#pragma unroll
    for (int j = 0; j < 4; ++j) { const int n = (lane >> 3) + 8 * j; const LAS float* sp = scr + (8 * c) * 33 + n;
        v4u o; o.x = pk2(sp[0 * 33], sp[1 * 33]); o.y = pk2(sp[2 * 33], sp[3 * 33]); o.z = pk2(sp[4 * 33], sp[5 * 33]); o.w = pk2(sp[6 * 33], sp[7 * 33]);
        *(v4u*)(WT + (size_t)(n_dst0 + n) * K + k0 + 8 * c) = o; }
    LDS_WAIT(); asm volatile("" ::: "memory");
}
__host__ __device__ __forceinline__ int win_perm(int q_abs) { const int T = q_abs >> 8, q = q_abs & 255; return T * 256 + 128 * ((q >> 5) & 1) + 32 * (q >> 6) + (q & 31); }


struct EpiInProj {
    static constexpr bool PERM = false, AFTER_DRAIN = false;
    bf16 *RQ, *RK, *RV, *RG, *DQ, *DK, *DV; const float* tab; const float* qkg;
    __device__ __forceinline__ void operator()(const pg8::f32x4 (&acc)[2][2][4][2], const pg8::Unit& u, int wr, int wc, int fr, int fq) const {
        const int b = u.pm / 9, w = u.pm % 9, pn = u.pn; const bool isctx = (w == 0);
        const int grp = (pn == 0) ? 0 : (pn == 1) ? 1 : (pn < 4) ? 2 : (pn < 6) ? 3 : (pn < 8) ? 4 : (pn < 10) ? 5 : 6;
        f32x4 gq[2][2];
        if (grp == 4 || grp == 5) {
#pragma unroll
            for (int bj = 0; bj < 2; ++bj)
#pragma unroll
                for (int n = 0; n < 2; ++n) gq[bj][n] = *(const f32x4*)(qkg + (grp == 5 ? 64 : 0) + 32 * bj + 16 * n + 4 * fq);
        }
#pragma unroll
        for (int ai = 0; ai < 2; ++ai)
#pragma unroll
            for (int m = 0; m < 4; ++m) {
                const int rl = 128 * ai + 64 * wr + 16 * m + fr;
                const int tok = 256 * w + rl;
                const int l = tok - 256;
                f32x4 v[2][2];
#pragma unroll
                for (int bj = 0; bj < 2; ++bj)
#pragma unroll
                    for (int n = 0; n < 2; ++n) v[bj][n] = acc[ai][bj][m][n];
                if (grp == 4 || grp == 5) {
                    float ss = 0.f;
#pragma unroll
                    for (int bj = 0; bj < 2; ++bj)
#pragma unroll
                        for (int n = 0; n < 2; ++n) ss += (v[bj][n].x * v[bj][n].x + v[bj][n].y * v[bj][n].y) + (v[bj][n].z * v[bj][n].z + v[bj][n].w * v[bj][n].w);
                    ss += __shfl_xor(ss, 16); ss += __shfl_xor(ss, 32);
                    const float rstd = rsqrtf(ss * (1.f / 64.f) + EPS);
#pragma unroll
                    for (int bj = 0; bj < 2; ++bj)
#pragma unroll
                        for (int n = 0; n < 2; ++n) v[bj][n] = v[bj][n] * rstd * gq[bj][n];
                }
                const bool rope = (grp == 0 || grp == 1 || grp == 4 || grp == 5) && !isctx;
                if (rope) {
#pragma unroll
                    for (int bj = 0; bj < 2; ++bj) {
                        const f32x4 cs = *(const f32x4*)(tab + (size_t)l * 64 + 16 * bj + 4 * fq), sn = *(const f32x4*)(tab + (size_t)l * 64 + 32 + 16 * bj + 4 * fq);
                        const f32x4 x0 = v[bj][0], x1 = v[bj][1];
                        v[bj][0] = x0 * cs - x1 * sn; v[bj][1] = x1 * cs + x0 * sn;
                    }
                }
                float scl = 1.f; bf16* dst;
                if (grp == 0) { dst = RQ + ((size_t)(b * 4 + wc) * L + l) * 64; }
                else if (grp == 1) { dst = RK + ((size_t)(b * 4 + wc) * LT + tok) * 64; scl = 0.125f; }
                else if (grp == 2) { dst = RV + ((size_t)(b * 4 + 2 * (pn - 2) + (wc >> 1)) * LT + tok) * 128 + 64 * (wc & 1); }
                else if (grp == 3) { dst = RG + ((size_t)b * L + l) * 512 + 256 * (pn - 4) + 64 * wc; }
                else if (grp == 4) { dst = DQ + ((size_t)(b * 8 + 4 * (pn - 6) + wc) * L + l) * 64; scl = C2; }
                else if (grp == 5) { dst = DK + ((size_t)(b * 8 + 4 * (pn - 8) + wc) * LT + tok) * 64; }
                else { dst = DV + ((size_t)(b * 4 + 2 * (pn - 10) + (wc >> 1)) * LT + tok) * 128 + 64 * (wc & 1); }
#pragma unroll
                for (int bj = 0; bj < 2; ++bj)
#pragma unroll
                    for (int n = 0; n < 2; ++n) { const f32x4 o = v[bj][n] * scl; v2u pk; pk.x = pk2(o.x, o.y); pk.y = pk2(o.z, o.w);
                        *(v2u*)(dst + 32 * bj + 16 * n + 4 * fq) = pk; }
            }
    }
};
struct InSched {
    int xcd, slot, nslots;
    __device__ __forceinline__ void init(int G, int c) { xcd = c % 8; slot = c / 8; nslots = G / 8; }
#if MK_CTX_IN_P1
    __device__ __forceinline__ bool next(int i, pg8::Unit& u) const {
        const int idx = i * nslots + slot;
        if (idx >= 96) return false;
        u.pn = idx >> 3; u.pm = 9 * xcd + 1 + (idx & 7); return true;
    }
#else
    __device__ __forceinline__ bool next(int i, pg8::Unit& u) const {
        int idx = i * nslots + slot;
        if (idx >= 103) return false;
        int pn = 0, w = 0;
#pragma unroll
        for (int p = 0; p < 12; ++p) {
            const bool cn = (p == 1 || p == 2 || p == 3 || p >= 8); const int cnt = cn ? 9 : 8;
            if (idx >= 0 && idx < cnt) { pn = p; w = cn ? idx : idx + 1; idx = -1000; }
            else idx -= cnt;
        }
        u.pm = 9 * xcd + w; u.pn = pn; return true;
    }
#endif
    __device__ __forceinline__ void a_ready(const pg8::Unit&) const {}
    __device__ __forceinline__ void done(const pg8::Unit&) const {}
};
struct OneUnit {
    int pm, pn;
    __device__ __forceinline__ bool next(int i, pg8::Unit& u) const { if (i > 0) return false; u.pm = pm; u.pn = pn; return true; }
    __device__ __forceinline__ void a_ready(const pg8::Unit&) const {}
    __device__ __forceinline__ void done(const pg8::Unit&) const {}
};

struct EpiOutProj {
    static constexpr bool PERM = false, AFTER_DRAIN = false;
    static constexpr int MB = 2;
    const float* x; float* out; bf16* x1a; const float* mod; const float* alpha2; float* ssq;
    __device__ __forceinline__ void operator()(const pg8::f32x4 (&acc)[2][2][4][2], const pg8::Unit& u, int wr, int wc, int fr, int fq) const {
        const int b = u.pm >> 3;
        const int col0 = u.pn * 256 + wc * 32 + 4 * fq;
        f32x4 gt[2][2], al[2][2];
#pragma unroll
        for (int bj = 0; bj < 2; ++bj)
#pragma unroll
            for (int n = 0; n < 2; ++n) { gt[bj][n] = *(const f32x4*)(mod + (size_t)b * NMODC + 2 * D + col0 + bj * 128 + n * 16); al[bj][n] = *(const f32x4*)(alpha2 + (size_t)b * D + col0 + bj * 128 + n * 16); }
#pragma unroll
        for (int ai = 0; ai < 2; ++ai)
#pragma unroll
            for (int mh = 0; mh < 4; mh += MB) {
                f32x4 xv[MB][2][2];
#pragma unroll
                for (int mm = 0; mm < MB; ++mm) { const size_t row = (size_t)u.pm * 256 + ai * 128 + wr * 64 + (mh + mm) * 16 + fr;
#pragma unroll
                    for (int bj = 0; bj < 2; ++bj)
#pragma unroll
                        for (int n = 0; n < 2; ++n) xv[mm][bj][n] = *(const f32x4*)(x + row * D + col0 + bj * 128 + n * 16); }
#pragma unroll
                for (int mm = 0; mm < MB; ++mm) { const int m = mh + mm;
                    const size_t row = (size_t)u.pm * 256 + ai * 128 + wr * 64 + m * 16 + fr;
                    float ss = 0.f;
#pragma unroll
                    for (int bj = 0; bj < 2; ++bj)
#pragma unroll
                        for (int n = 0; n < 2; ++n) { const size_t off = row * D + col0 + bj * 128 + n * 16;
                            const f32x4 x1 = xv[mm][bj][n] + gt[bj][n] * acc[ai][bj][m][n];
                            *(f32x4*)(out + off) = x1; ss += (x1.x * x1.x + x1.y * x1.y) + (x1.z * x1.z + x1.w * x1.w);
                            const f32x4 xa = x1 * al[bj][n]; v2u pk; pk.x = pk2(xa.x, xa.y); pk.y = pk2(xa.z, xa.w); *(v2u*)(x1a + off) = pk; }
                    ss += __shfl_xor(ss, 16); ss += __shfl_xor(ss, 32);
                    if (fq == 0) ssq[row * 16 + u.pn * 4 + wc] = ss;
                }
            }
    }
};
struct EpiQuery {
    static constexpr bool PERM = true, AFTER_DRAIN = false;
    bf16* qp; const float* biasq; const float* ssq;
    __device__ __forceinline__ void operator()(const pg8::f32x4 (&acc)[2][2][4][2], const pg8::Unit& u, int wr, int wc, int fr, int fq) const {
        const int b = u.pm >> 3;
        const int col0 = u.pn * 256 + wc * 32 + 8 * fq;
        f32x4 bv[2][2];
#pragma unroll
        for (int bj = 0; bj < 2; ++bj)
#pragma unroll
            for (int n = 0; n < 2; ++n) bv[bj][n] = *(const f32x4*)(biasq + (size_t)b * 2048 + col0 + bj * 128 + 4 * n);
#pragma unroll
        for (int ai = 0; ai < 2; ++ai)
#pragma unroll
            for (int m = 0; m < 4; ++m) {
                const size_t row = (size_t)u.pm * 256 + ai * 128 + wr * 64 + m * 16 + fr;
                const f32x4 s0 = *(const f32x4*)(ssq + row * 16), s1 = *(const f32x4*)(ssq + row * 16 + 4), s2 = *(const f32x4*)(ssq + row * 16 + 8), s3 = *(const f32x4*)(ssq + row * 16 + 12);
                const float tot = ((s0.x + s0.y) + (s0.z + s0.w)) + ((s1.x + s1.y) + (s1.z + s1.w)) + ((s2.x + s2.y) + (s2.z + s2.w)) + ((s3.x + s3.y) + (s3.z + s3.w));
                const float rstd = rsqrtf(tot * (1.f / D) + EPS);
#pragma unroll
                for (int bj = 0; bj < 2; ++bj) { const f32x4 v0 = acc[ai][bj][m][0] * rstd + bv[bj][0], v1 = acc[ai][bj][m][1] * rstd + bv[bj][1];
                    v4u w; w.x = pk2(v0.x, v0.y); w.y = pk2(v0.z, v0.w); w.z = pk2(v1.x, v1.y); w.w = pk2(v1.z, v1.w);
                    const int kg = 4 * wc + fq;
                    *(v4u*)(qp + ((((row >> 5) * 8 + u.pn) * 2 + bj) * 16 + kg) * 256 + (row & 31) * 8) = w; }
            }
    }
};

struct EpiQuerySelect {
    static constexpr bool PERM = true, AFTER_DRAIN = true;
    const float* biasq; const float* ssq; const bf16* skf; int* pidx; float* pgate;
    __device__ __forceinline__ void fused(pg8::f32x4 (&acc)[2][2][4][2], const pg8::Unit& u, int wr, int wc, int fr, int fq, PG8_LAS unsigned char* lds, int wid, int lane) const {
        const int b = u.pm >> 3;
        const int col0 = u.pn * 256 + wc * 32 + 8 * fq, kg = 4 * wc + fq;
        f32x4 bv[2][2];
#pragma unroll
        for (int bj = 0; bj < 2; ++bj)
#pragma unroll
            for (int n = 0; n < 2; ++n) bv[bj][n] = *(const f32x4*)(biasq + (size_t)b * 2048 + col0 + bj * 128 + 4 * n);
#pragma unroll
        for (int ai = 0; ai < 2; ++ai)
#pragma unroll
            for (int m = 0; m < 4; ++m) {
                const int rl = ai * 128 + wr * 64 + m * 16 + fr; const size_t row = (size_t)u.pm * 256 + rl;
                const f32x4 s0 = *(const f32x4*)(ssq + row * 16), s1 = *(const f32x4*)(ssq + row * 16 + 4), s2 = *(const f32x4*)(ssq + row * 16 + 8), s3 = *(const f32x4*)(ssq + row * 16 + 12);
                const float tot = ((s0.x + s0.y) + (s0.z + s0.w)) + ((s1.x + s1.y) + (s1.z + s1.w)) + ((s2.x + s2.y) + (s2.z + s2.w)) + ((s3.x + s3.y) + (s3.z + s3.w));
                const float rstd = rsqrtf(tot * (1.f / D) + EPS);
#pragma unroll
                for (int bj = 0; bj < 2; ++bj) { const f32x4 v0 = acc[ai][bj][m][0] * rstd + bv[bj][0], v1 = acc[ai][bj][m][1] * rstd + bv[bj][1];
                    v4u w; w.x = pk2(v0.x, v0.y); w.y = pk2(v0.z, v0.w); w.z = pk2(v1.x, v1.y); w.w = pk2(v1.z, v1.w);
                    *(LAS v4u*)(lds + ((((rl >> 5) * 2 + bj) * 16 + kg) * 512 + (rl & 31) * 16)) = w; }
            }
        asm volatile("s_waitcnt lgkmcnt(0)" ::: "memory"); __builtin_amdgcn_s_barrier(); asm volatile("" ::: "memory");
        peer::select_wave_lds(skf + (size_t)u.pn * (2 * 4 * 8 * 2 * 32 * 8), (char*)lds, u.pn, pidx + (size_t)u.pm * 256 * 128, pgate + (size_t)u.pm * 256 * 128, wid, lane);
    }
};

__global__ void __launch_bounds__(NTHR, 2) mega(Args args) {
    extern __shared__ __attribute__((aligned(16))) unsigned char lds_raw[];
    LAS unsigned char* lds = (LAS unsigned char*)lds_raw;
    volatile LAS unsigned* MISC = (volatile LAS unsigned*)(lds + MISC_OFF);
    const int tid = threadIdx.x, lane = tid & 63, wave = __builtin_amdgcn_readfirstlane(tid >> 6);
    const int G = gridDim.x;
    const int gw = blockIdx.x * NWAVES + wave, NGW = G * NWAVES;
    unsigned char* ws = args.ws;
    const float* x = args.in[0]; const float* cnd = args.in[1]; const float* ctx = args.in[2]; const float* cctx = args.in[3];
    const float* w_mod = args.in[4]; const float* b_mod = args.in[5]; const float* g1 = args.in[6]; const float* g2 = args.in[7];
    const float* w_in = args.in[8]; const float* qkg = args.in[11];
    const float* w_out = args.in[14]; const float* wq = args.in[15];
    const float* subk = args.in[16]; const float* pu = args.in[17]; const float* pv = args.in[18];
    float* mod = (float*)(ws + WS_MOD); float* tab = (float*)(ws + WS_TAB); float* alpha2 = (float*)(ws + WS_ALPHA2); float* biasq = (float*)(ws + WS_BIASQ);
    bf16* WinT = (bf16*)(ws + WS_WIN); bf16* WoutT = (bf16*)(ws + WS_WOUT); bf16* WqT = (bf16*)(ws + WS_WQ); bf16* SubK = (bf16*)(ws + WS_SUBK);
    unsigned char* UT8 = ws + WS_PU; unsigned char* VT8 = ws + WS_PV; float* SUs = (float*)(ws + WS_SU); float* SVs = (float*)(ws + WS_SV); bf16* HB = (bf16*)(ws + WS_HB);

    for (int u = tid; u < (LDS_BYTES - RING_BYTES) / 4; u += NTHR) ((LAS unsigned*)(lds + RING_BYTES))[u] = 0u;
    __syncthreads();
    XcdBarrier bar = xcd_barrier_post((unsigned*)(ws + WS_CTL) + CW_BAR, MISC + 8);
    const int lo = args.ph_lo, hi = args.ph_hi;
#define IN(k) (lo <= (k) && (k) < hi)
#define SEAM(k) do { if (IN(k) && IN((k) + 1)) xcd_barrier(bar); } while (0)

    if (IN(0)) { for (int rep = 0; rep < (MK_DUP == 0 ? 2 : 1); ++rep) {
        {   const float* const rows[9] = {cnd, cnd + D, cnd + 2 * D, cnd + 3 * D, cnd + 4 * D, cnd + 5 * D, cnd + 6 * D, cnd + 7 * D, cctx};
            gemv_rows<9, true>(rows, w_mod, NMODC, b_mod, mod, NMODC, (LAS float*)lds); }
        LAS float* scr = (LAS float*)(lds + 57344 + wave * 8448);
        constexpr int I_IN = 16 * 96, I_OUT = 16 * 32, I_Q = 16 * 64;
        for (int it = gw; it < I_IN + I_OUT + I_Q; it += NGW) {
            int r = it;
            if (r < I_IN) { const int kb = r / 96, nb = r % 96; transpose_item(w_in, D, INC, WinT, 64 * kb, 32 * nb, win_perm(32 * nb), scr, lane); continue; } r -= I_IN;
            if (r < I_OUT) { const int kb = r / 32, nb = r % 32; transpose_item(w_out, D, D, WoutT, 64 * kb, 32 * nb, 32 * nb, scr, lane); continue; } r -= I_OUT;
            { const int kb = r / 64, nb = r % 64; transpose_item(wq, D, 2048, WqT, 64 * kb, 32 * nb, 32 * nb, scr, lane); }
        }
        const size_t gt = (size_t)blockIdx.x * NTHR + tid, GT = (size_t)G * NTHR;
        for (size_t i = gt; i < (size_t)8 * 2 * 128 * 128 / 8; i += GT) {
            const int ii = (int)i, hp = ii >> 11, n = (ii >> 4) & 127, c8 = ii & 15;
            const f32x4 a = *(const f32x4*)(subk + (size_t)ii * 8), bq4 = *(const f32x4*)(subk + (size_t)ii * 8 + 4);
            v4u o; o.x = pk2(a.x, a.y); o.y = pk2(a.z, a.w); o.z = pk2(bq4.x, bq4.y); o.w = pk2(bq4.z, bq4.w);
            *(v4u*)(SubK + (size_t)((((hp * 4 + (n >> 5)) * 8 + (c8 >> 1)) * 2 + (c8 & 1)) * 32 + (n & 31)) * 8) = o; }
        for (size_t i = gt; i < (size_t)L * 32; i += GT) {
            const int l = (int)(i >> 5), a = (int)((i >> 4) & 1), q = (int)(i & 15);
            const float f = powf(10000.f, -(float)q / 16.f); const float pos = a == 0 ? (float)(l >> 6) : (float)(l & 63); const float ang = pos * f;
            tab[l * 64 + a * 16 + q] = cosf(ang); tab[l * 64 + 32 + a * 16 + q] = sinf(ang);
        }
    if (MK_DUP == 0 && rep == 0) xcd_barrier(bar); } }
    SEAM(0);
    if (IN(1)) { for (int rep = 0; rep < (MK_DUP == 1 ? 2 : 1); ++rep) {
        const int NCTXWG = MK_CTX_IN_P1 ? 56 : G, nlat = G - NCTXWG;
        const bool ctxwg = nlat > 0 && (int)blockIdx.x >= nlat;
        const int cu_ = (int)blockIdx.x - nlat, cb_ = cu_ / 7, cj_ = cu_ % 7;
        const int mi0 = ctxwg ? wave : (int)blockIdx.x * NWAVES + wave, mstep = ctxwg ? NWAVES : (nlat > 0 ? nlat : G) * NWAVES, mcnt = ctxwg ? CT : (nlat > 0 ? M2 : M1);
        for (int mi = mi0; mi < mcnt; mi += 4 * mstep) {
            f32x4 v[4][4]; float ss[4]; int mrow_[4]; bool ok[4];
#pragma unroll
            for (int q = 0; q < 4; ++q) {
                const int mq = mi + q * mstep; ok[q] = mq < mcnt; const int mqq = ok[q] ? mq : mi;
                const int m = ctxwg ? cb_ * LT + mqq : (nlat > 0 ? (mqq >> 11) * LT + CT + (mqq & 2047) : mqq);
                mrow_[q] = m;
                const int b = m / LT, w = m % LT;
                const float* src = w < CT ? ctx + ((size_t)b * CT + w) * D : x + ((size_t)b * L + (w - CT)) * D;
                ss[q] = 0.f;
#pragma unroll
                for (int j2 = 0; j2 < 4; ++j2) { v[q][j2] = ((const f32x4*)src)[lane + 64 * j2]; }
            }
#pragma unroll
            for (int q = 0; q < 4; ++q) {
#pragma unroll
                for (int j2 = 0; j2 < 4; ++j2) ss[q] += (v[q][j2].x * v[q][j2].x + v[q][j2].y * v[q][j2].y) + (v[q][j2].z * v[q][j2].z + v[q][j2].w * v[q][j2].w);
                ss[q] = wave_sum(ss[q]);
            }
#pragma unroll
            for (int q = 0; q < 4; ++q) {
                if (!ok[q]) continue;
                const int m = mrow_[q]; const int b = m / LT, w = m % LT;
                const float* mrow = mod + (size_t)(w < CT ? 8 : b) * NMODC;
                const float rstd = rsqrtf(ss[q] * (1.f / D) + EPS);
#pragma unroll
                for (int j2 = 0; j2 < 4; ++j2) { const int k0 = 4 * lane + 256 * j2;
                    const f32x4 g = *(const f32x4*)(g1 + k0), sc = *(const f32x4*)(mrow + D + k0), sh = *(const f32x4*)(mrow + k0);
                    const f32x4 y = v[q][j2] * rstd * g; const f32x4 h = y * (sc + 1.f) + sh;
                    v2u pk; pk.x = pk2(h.x, h.y); pk.y = pk2(h.z, h.w);
                    *(v2u*)(HB + (size_t)m * D + k0) = pk; }
            }
        }
        if (ctxwg) {
            asm volatile("s_waitcnt vmcnt(0)" ::: "memory"); __syncthreads();
            const int pnl[7] = {1, 2, 3, 8, 9, 10, 11};
            int pn = 1;
#pragma unroll
            for (int q = 0; q < 7; ++q) if (q == cj_) pn = pnl[q];
            pg8::Gemm g{HB, WinT, M1, INC, D}; OneUnit S{9 * cb_, pn};
            EpiInProj E{(bf16*)(ws + WS_RQ), (bf16*)(ws + WS_RK), (bf16*)(ws + WS_RV), (bf16*)(ws + WS_RG), (bf16*)(ws + WS_DQ), (bf16*)(ws + WS_DK), (bf16*)(ws + WS_DV), tab, qkg};
            pg8::gemm_phase<EpiInProj, OneUnit, PG8_ALIGN, PG8_SP2>(lds, g, S, E);
            __syncthreads();
        }
        for (int i = blockIdx.x * NTHR + tid; i < NB * D; i += G * NTHR) { const int b = i >> 10, k = i & 1023; alpha2[i] = g2[k] * (1.f + mod[(size_t)b * NMODC + 4 * D + k]); }
        {   const float* const rows[8] = {mod + 3 * D, mod + NMODC + 3 * D, mod + 2 * NMODC + 3 * D, mod + 3 * NMODC + 3 * D, mod + 4 * NMODC + 3 * D, mod + 5 * NMODC + 3 * D, mod + 6 * NMODC + 3 * D, mod + 7 * NMODC + 3 * D};
            __syncthreads();
            gemv_rows<8, false>(rows, wq, 2048, nullptr, biasq, 2048, (LAS float*)lds); }
    if (MK_DUP == 1 && rep == 0) xcd_barrier(bar); } }
    SEAM(1);
    if (IN(2)) { for (int rep = 0; rep < (MK_DUP == 2 ? 2 : 1); ++rep) {
        __syncthreads();
        pg8::Gemm g{HB, WinT, M1, INC, D}; InSched S; S.init(G, (int)blockIdx.x);
        EpiInProj E{(bf16*)(ws + WS_RQ), (bf16*)(ws + WS_RK), (bf16*)(ws + WS_RV), (bf16*)(ws + WS_RG), (bf16*)(ws + WS_DQ), (bf16*)(ws + WS_DK), (bf16*)(ws + WS_DV), tab, qkg};
        pg8::gemm_phase<EpiInProj, InSched, PG8_ALIGN, PG8_SP2>(lds, g, S, E);
#if !MK_CTX_IN_P1
        {
            const int nslots = G >> 3, rr = 103 % nslots, xcd = (int)blockIdx.x & 7, slot = (int)blockIdx.x >> 3;
            const bool freewg = rr == 0 || slot >= rr;
            const int fidx = rr == 0 ? (int)blockIdx.x : (slot - rr) * 8 + xcd, nfree = rr == 0 ? G : (nslots - rr) * 8;
            if (freewg && rep == 0)
                for (int e = fidx * NWAVES + wave; e < 2 * 16384; e += nfree * NWAVES) { if (e < 16384) peer::cvt_row_i4(pu, UT8, SUs, e, lane); else peer::cvt_row_fp4(pv, VT8, SVs, e - 16384, lane); }
        }
#endif
    if (MK_DUP == 2 && rep == 0) xcd_barrier(bar); } }
    SEAM(2);
    if (IN(3)) { for (int rep = 0; rep < (MK_DUP == 3 ? 2 : 1); ++rep) {
        __syncthreads();
        const bf16* DQb = (const bf16*)(ws + WS_DQ); const bf16* DKb = (const bf16*)(ws + WS_DK); const bf16* DVb = (const bf16*)(ws + WS_DV); bf16* ODb = (bf16*)(ws + WS_OD);
        for (int idx = blockIdx.x; idx < 512; idx += G) {
            const int b = idx & 7, rest = idx >> 3, hp = rest >> 3, qb = rest & 7;
            att::attn_unit(DQb + ((size_t)(b * 8 + hp) * L + qb * 256) * 64, DKb + (size_t)(b * 8 + hp) * LT * 64, DVb + (size_t)(b * 4 + (hp >> 1)) * LT * 128,
                           ODb + ((size_t)(b * 8 + hp) * L + qb * 256) * 128, LT, (char*)lds_raw);
        }
        const float* decay = args.in[9];
        for (int idx = blockIdx.x; idx < 288; idx += G) {
            const int b = idx & 7, rest = idx >> 3, h = rest / 9, c = rest % 9;
            float* st = (float*)(ws + WS_ST) + ((size_t)((b * 4 + h) * 9 + c) * 2) * 8192;
            ret::state_unit((const bf16*)(ws + WS_RK) + ((size_t)(b * 4 + h) * LT + 256 * c) * 64, (const bf16*)(ws + WS_RV) + ((size_t)(b * 4 + h) * LT + 256 * c) * 128,
                            st, st + 8192, ret::log2_sigmoid(decay[h]), ret::log2_sigmoid(decay[4 + h]), (char*)lds_raw);
        }
    if (MK_DUP == 3 && rep == 0) xcd_barrier(bar); } }
    SEAM(3);
    if (IN(4)) { for (int rep = 0; rep < (MK_DUP == 4 ? 2 : 1); ++rep) {
        __syncthreads();
        const float* decay = args.in[9]; const float* ret_g = args.in[10]; const float* lamp = args.in[12]; const float* diff_g = args.in[13];
        bf16* MIX = (bf16*)(ws + WS_MIX);
        for (int idx = blockIdx.x; idx < 256; idx += G) {
            const int b = idx & 7, rest = idx >> 3, h = rest >> 3, blk = rest & 7, c = blk + 1;
            ret::out_unit((const bf16*)(ws + WS_RQ) + ((size_t)(b * 4 + h) * L + 256 * blk) * 64, (const bf16*)(ws + WS_RK) + ((size_t)(b * 4 + h) * LT + 256 * c) * 64,
                          (const bf16*)(ws + WS_RV) + ((size_t)(b * 4 + h) * LT + 256 * c) * 128, (const float*)(ws + WS_ST) + (size_t)(b * 4 + h) * 9 * 2 * 8192, c,
                          (const bf16*)(ws + WS_RG) + ((size_t)b * L + 256 * blk) * 512 + h * 128, ret_g + h * 128, MIX + ((size_t)b * L + 256 * blk) * D + h * 128,
                          ret::log2_sigmoid(decay[h]), ret::log2_sigmoid(decay[4 + h]), (char*)lds_raw);
        }
        {
            float a = lamp[lane] * lamp[64 + lane], b2 = lamp[128 + lane] * lamp[192 + lane];
            a = wave_sum(a); b2 = wave_sum(b2);
            const float lam_init = 0.2f, lam = expf(a) - expf(b2) + lam_init;
            const bf16* ODb = (const bf16*)(ws + WS_OD);
            const int h = lane >> 4, e0 = (lane & 15) * 8;
            const f32x4 g0 = *(const f32x4*)(diff_g + h * 128 + e0), g1v = *(const f32x4*)(diff_g + h * 128 + e0 + 4);
            for (int t0 = gw; t0 < M2; t0 += 4 * NGW) {
                v4u p0[4], p1[4];
#pragma unroll
                for (int u = 0; u < 4; ++u) { const int t = t0 + u * NGW < M2 ? t0 + u * NGW : t0; const int b = t >> 11, l = t & 2047;
                    p0[u] = *(const v4u*)(ODb + ((size_t)(b * 8 + 2 * h) * L + l) * 128 + e0); p1[u] = *(const v4u*)(ODb + ((size_t)(b * 8 + 2 * h + 1) * L + l) * 128 + e0); }
#pragma unroll
                for (int u = 0; u < 4; ++u) {
                    const int t = t0 + u * NGW;
                    float y[8]; float ss = 0.f;
#pragma unroll
                    for (int j = 0; j < 4; ++j) {
                        y[2 * j] = __builtin_bit_cast(float, p0[u][j] << 16) - lam * __builtin_bit_cast(float, p1[u][j] << 16);
                        y[2 * j + 1] = __builtin_bit_cast(float, p0[u][j] & 0xffff0000u) - lam * __builtin_bit_cast(float, p1[u][j] & 0xffff0000u);
                        ss += y[2 * j] * y[2 * j] + y[2 * j + 1] * y[2 * j + 1]; }
                    ss += __shfl_xor(ss, 1); ss += __shfl_xor(ss, 2); ss += __shfl_xor(ss, 4); ss += __shfl_xor(ss, 8);
                    const float rstd = rsqrtf(ss * (1.f / 128.f) + EPS) * (1.f - lam_init);
                    v4u o; o.x = pk2(y[0] * rstd * g0.x, y[1] * rstd * g0.y); o.y = pk2(y[2] * rstd * g0.z, y[3] * rstd * g0.w);
                    o.z = pk2(y[4] * rstd * g1v.x, y[5] * rstd * g1v.y); o.w = pk2(y[6] * rstd * g1v.z, y[7] * rstd * g1v.w);
                    if (t < M2) *(v4u*)(MIX + (size_t)t * D + 512 + h * 128 + e0) = o;
                }
            }
        }
    if (MK_DUP == 4 && rep == 0) xcd_barrier(bar); } }
    SEAM(4);
    if (IN(5)) { for (int rep = 0; rep < (MK_DUP == 5 ? 2 : 1); ++rep) {
        __syncthreads();
        pg8::Gemm g{(const bf16*)(ws + WS_MIX), WoutT, M2, D, D}; pg8::StaticOrder S; S.init(M2, D, G, (int)blockIdx.x);
        EpiOutProj E{x, args.out, (bf16*)(ws + WS_X1A), mod, alpha2, (float*)(ws + WS_SSQ)};
        pg8::gemm_phase<EpiOutProj, pg8::StaticOrder, PG8_ALIGN, PG8_SP2>(lds, g, S, E);
    if (MK_DUP == 5 && rep == 0) xcd_barrier(bar); } }
    SEAM(5);
    if (IN(6)) { for (int rep = 0; rep < (MK_DUP == 6 ? 2 : 1); ++rep) {
        pg8::Gemm g{(const bf16*)(ws + WS_X1A), WqT, M2, 2048, D}; pg8::StaticOrder S0; S0.init(M2, 2048, G, (int)blockIdx.x);
        EpiQuerySelect E{biasq, (const float*)(ws + WS_SSQ), SubK, (int*)(ws + WS_PIDX), (float*)(ws + WS_PGATE)};
        for (int i = 0; ; ++i) {
            pg8::Unit u; if (!S0.next(i, u)) break;
            __syncthreads();
            OneUnit S{u.pm, u.pn};
            pg8::gemm_phase<EpiQuerySelect, OneUnit, false, PG8_SP2>(lds, g, S, E);
            peer::quant_h2_wave(u.pm * 256 + (u.pn & 1) * 128 + wave * 16, u.pn >> 1, (const bf16*)(ws + WS_X1A), (const float*)(ws + WS_SSQ), mod, ws + WS_HQ, (float*)(ws + WS_HS), lane);
        }
    if (MK_DUP == 6 && rep == 0) xcd_barrier(bar); } }
    SEAM(6);
    if (IN(8)) { for (int rep = 0; rep < (MK_DUP == 8 ? 2 : 1); ++rep) {
        __syncthreads();
        const int c = blockIdx.x & 3, half = (blockIdx.x >> 2) & 1, nj = G >> 3, j = blockIdx.x >> 3;
        peer::gatherA_stream(c, half * (M2 / 256) + j, nj, (M2 / 256 - j + nj - 1) / nj, ws + WS_HQ, (const int*)(ws + WS_PIDX), UT8, (bf16*)(ws + WS_PART), (char*)lds_raw);
        __syncthreads();
    if (MK_DUP == 8 && rep == 0) xcd_barrier(bar); } }
    SEAM(8);
    if (IN(9)) {
        const bf16* part = (const bf16*)(ws + WS_PART); const int* pidx = (const int*)(ws + WS_PIDX); float* pg = (float*)(ws + WS_PGATE);
        for (size_t p4 = (size_t)blockIdx.x * NTHR + tid; p4 < (size_t)M2 * 128 / 4; p4 += (size_t)G * NTHR) {
            const size_t p = p4 * 4;
            float d0 = 0.f, d1 = 0.f, d2 = 0.f, d3 = 0.f;
#pragma unroll
            for (int cc = 0; cc < 4; ++cc) { const v2u w = *(const v2u*)(part + (size_t)cc * M2 * 128 + p); const float hs = ((const float*)(ws + WS_HS))[(size_t)cc * M2 + (p >> 7)];
                d0 = fmaf(__builtin_bit_cast(float, w.x << 16), hs, d0); d1 = fmaf(__builtin_bit_cast(float, w.x & 0xffff0000u), hs, d1);
                d2 = fmaf(__builtin_bit_cast(float, w.y << 16), hs, d2); d3 = fmaf(__builtin_bit_cast(float, w.y & 0xffff0000u), hs, d3); }
            const int4 e = *(const int4*)(pidx + p); const f32x4 g = *(const f32x4*)(pg + p);
            f32x4 o;
            o.x = peer::gelu_exact(d0 * SUs[e.x]) * g.x * SVs[e.x]; o.y = peer::gelu_exact(d1 * SUs[e.y]) * g.y * SVs[e.y];
            o.z = peer::gelu_exact(d2 * SUs[e.z]) * g.z * SVs[e.z]; o.w = peer::gelu_exact(d3 * SUs[e.w]) * g.w * SVs[e.w];
            float am = fmaxf(fmaxf(fabsf(o.x), fabsf(o.y)), fmaxf(fabsf(o.z), fabsf(o.w)));
#pragma unroll
            for (int sh = 1; sh < 32; sh <<= 1) am = fmaxf(am, __shfl_xor(am, sh));
            const int ex = (int)((__float_as_uint(am) >> 23) & 0xffu) - 127;
            int kk = am > 0.f ? 6 - ex : 0; kk = kk > 100 ? 100 : (kk < -100 ? -100 : kk);
            const float S = __uint_as_float((unsigned)(127 + kk) << 23);
            const float a0 = o.x * S, a1 = o.y * S, a2 = o.z * S, a3 = o.w * S;
            const float h0 = fmaxf(fminf(rintf(a0), 127.f), -127.f), h1 = fmaxf(fminf(rintf(a1), 127.f), -127.f), h2 = fmaxf(fminf(rintf(a2), 127.f), -127.f), h3 = fmaxf(fminf(rintf(a3), 127.f), -127.f);
            const int hi = ((int)h0 & 0xff) | (((int)h1 & 0xff) << 8) | (((int)h2 & 0xff) << 16) | ((int)h3 << 24);
            const int l0 = (int)fmaxf(fminf(rintf((a0 - h0) * 128.f), 127.f), -127.f), l1 = (int)fmaxf(fminf(rintf((a1 - h1) * 128.f), 127.f), -127.f), l2 = (int)fmaxf(fminf(rintf((a2 - h2) * 128.f), 127.f), -127.f), l3 = (int)fmaxf(fminf(rintf((a3 - h3) * 128.f), 127.f), -127.f);
            const int lo = (l0 & 0xff) | ((l1 & 0xff) << 8) | ((l2 & 0xff) << 16) | (l3 << 24);
            const int a = (int)(p4 & 31); const unsigned kb = (unsigned)(kk + 128);
            unsigned i0 = (unsigned)e.x, i1 = (unsigned)e.y, i2 = (unsigned)e.z, i3 = (unsigned)e.w;
            if (a == 0) { i0 |= (kb & 3u) << 14; i1 |= ((kb >> 2) & 3u) << 14; i2 |= ((kb >> 4) & 3u) << 14; i3 |= ((kb >> 6) & 3u) << 14; }
            unsigned char* row = (unsigned char*)pg + (p4 >> 5) * 512;
            v2u iw; iw.x = i0 | (i1 << 16); iw.y = i2 | (i3 << 16);
            *(v2u*)(row + 8 * a) = iw; *(unsigned*)(row + 256 + 4 * a) = (unsigned)hi; *(unsigned*)(row + 384 + 4 * a) = (unsigned)lo;
        }
    }
    SEAM(9);
    if (IN(10)) {
        __syncthreads();
        const int c = blockIdx.x & 3, half = (blockIdx.x >> 2) & 1, nj = G >> 3, j = blockIdx.x >> 3;
        {   const int nt = (M2 / 256 - j + nj - 1) / nj;
            for (int k0 = 0; k0 < nt; k0 += 2) {
                peer::gatherB_stream(c, half * (M2 / 256) + j + k0 * nj, nj, nt - k0 < 2 ? nt - k0 : 2, args.out, mod, (const unsigned*)(ws + WS_PGATE), VT8, (char*)lds_raw);
                __syncthreads(); } }
    }
#undef IN
#undef SEAM
}
}

#ifndef MK_N_LAUNCHES
#define MK_N_LAUNCHES 1
#endif
extern "C" void kernel_launch(void* const* d_in, const int* in_sizes, int n_in, void* d_out, int out_size, void* d_ws, size_t ws_size, hipStream_t stream) {
    static int grid = 0;
    if (grid == 0) {
        int dev = 0, cus = 0, per_cu = 0;
        if (n_in != 19 || out_size != mk::M2 * mk::D || ws_size < mk::WS_END) { fprintf(stderr, "kernel_launch: unexpected shapes (n_in %d out %d ws %zu)\n", n_in, out_size, ws_size); grid = -1; return; }
        if (hipGetDevice(&dev) != hipSuccess || hipDeviceGetAttribute(&cus, hipDeviceAttributeMultiprocessorCount, dev) != hipSuccess) { grid = -1; return; }
        if (hipFuncSetAttribute((const void*)mk::mega, hipFuncAttributeMaxDynamicSharedMemorySize, mk::LDS_BYTES) != hipSuccess) { fprintf(stderr, "kernel_launch: hipFuncSetAttribute failed\n"); grid = -1; return; }
        if (hipOccupancyMaxActiveBlocksPerMultiprocessor(&per_cu, (const void*)mk::mega, mk::NTHR, mk::LDS_BYTES) != hipSuccess || per_cu < 1) { fprintf(stderr, "kernel_launch: occupancy query says %d blocks per CU\n", per_cu); grid = -1; return; }
        (void)hipGetLastError();
        grid = (cus / 8) * 8;
    }
    if (grid < 0) return;
    (void)in_sizes;
    unsigned char* wsb = (unsigned char*)d_ws;
    (void)hipMemsetAsync(wsb + mk::WS_CTL, 0, mk::CTL_ZERO_BYTES, stream);
#ifdef PROBE_MEMSET2
    (void)hipMemsetAsync(wsb + mk::WS_CTL, 0, mk::CTL_ZERO_BYTES, stream);
#endif
    mk::Args a{};
    for (int i = 0; i < 19; ++i) a.in[i] = (const float*)d_in[i];
    a.out = (float*)d_out; a.ws = wsb;
    if (MK_N_LAUNCHES == 1) { a.ph_lo = 0; a.ph_hi = 11; hipLaunchKernelGGL(mk::mega, dim3(grid), dim3(mk::NTHR), mk::LDS_BYTES, stream, a); }
    else for (int ph = 0; ph < 11; ++ph) { a.ph_lo = ph; a.ph_hi = ph + 1; hipLaunchKernelGGL(mk::mega, dim3(grid), dim3(mk::NTHR), mk::LDS_BYTES, stream, a); }
}
```

```cpp
#include <hip/hip_runtime.h>
#include <cstdio>
#include <cstdint>
#include <math.h>
#define GAS __attribute__((address_space(1)))
#define LAS __attribute__((address_space(3)))
typedef unsigned short bf16;
typedef unsigned v4u __attribute__((ext_vector_type(4)));
typedef unsigned v2u __attribute__((ext_vector_type(2)));
typedef float f32x4 __attribute__((ext_vector_type(4)));
typedef float f32x16 __attribute__((ext_vector_type(16)));
typedef short bf16x8 __attribute__((ext_vector_type(8)));
typedef short s16x4 __attribute__((ext_vector_type(4)));
#define LDS_WAIT() asm volatile("s_waitcnt lgkmcnt(0)" ::: "memory")
#define VM_WAIT() asm volatile("s_waitcnt vmcnt(0)" ::: "memory")
__device__ __forceinline__ unsigned f2bf(float f) { unsigned u = __builtin_bit_cast(unsigned, f); return (u + 0x7fffu + ((u >> 16) & 1u)) >> 16; }
__device__ __forceinline__ unsigned pk2(float lo, float hi) { return f2bf(lo) | (f2bf(hi) << 16); }
__device__ __forceinline__ float bf2f(unsigned short h) { return __builtin_bit_cast(float, (unsigned)h << 16); }
__device__ __forceinline__ float wave_sum(float v) {
#pragma unroll
    for (int o = 1; o < 64; o <<= 1) v += __shfl_xor(v, o);
    return v;
}
#define XB_TMO      128
#define XB_XCNT(j)  (256  + 64 * (j))
#define XB_XSUB(j)  (1280 + 64 * (j))
#define XB_XGEN(j)  (2304 + 64 * (j))
#define XB_TOP      3328
#define XB_TOPGEN   3392
#define XCD_BAR_WORDS 3456
#define XB_SPIN_CAP (1u << 18)

__device__ __forceinline__ unsigned xb_ld(unsigned* p)              { return __hip_atomic_load(p, __ATOMIC_RELAXED, __HIP_MEMORY_SCOPE_AGENT); }
__device__ __forceinline__ unsigned xb_add(unsigned* p, unsigned v) { return __hip_atomic_fetch_add(p, v, __ATOMIC_RELAXED, __HIP_MEMORY_SCOPE_AGENT); }
__device__ __forceinline__ unsigned xb_xcc_id() { return (unsigned)__builtin_amdgcn_s_getreg((3 << 11) | 20) & 0xFu; }
#define XB_SPIN(cond, bar) do { unsigned _sp = 0; while (cond) { __builtin_amdgcn_s_sleep(1); \
    if ((++_sp & 255u) == 0u) { if (xb_ld(&(bar)[XB_TMO])) break; if (_sp > XB_SPIN_CAP) { atomicAdd(&(bar)[XB_TMO], 1u); break; } } } } while (0)

struct XcdBarrier {
    unsigned* bar; unsigned x;
    volatile LAS unsigned* st;
};

__device__ __forceinline__ XcdBarrier xcd_barrier_post(unsigned* bar, volatile LAS unsigned* st) {
    XcdBarrier b; b.bar = bar; b.x = xb_xcc_id(); b.st = st;
    if (threadIdx.x == 0) (void)xb_add(&bar[XB_XCNT(b.x)], 1u);
    return b;
}
__device__ __forceinline__ void xcd_barrier_complete(unsigned* bar, unsigned x, unsigned& nloc, unsigned& nx) {
    const unsigned G = gridDim.x * gridDim.y * gridDim.z;
    unsigned sum, cnt, mine, sp = 0u;
    for (;;) {
        sum = 0u; cnt = 0u; mine = 0u;
#pragma unroll
        for (unsigned j = 0; j < 16; ++j) { const unsigned c = xb_ld(&bar[XB_XCNT(j)]); sum += c; cnt += (c > 0u) ? 1u : 0u; mine = (j == x) ? c : mine; }
        if (sum == G) break;
        __builtin_amdgcn_s_sleep(1);
        if ((++sp & 255u) == 0u) { if (xb_ld(&bar[XB_TMO])) break; if (sp > XB_SPIN_CAP) { atomicAdd(&bar[XB_TMO], 1u); break; } }
    }
    nloc = mine > 0u ? mine : 1u; nx = cnt > 0u ? cnt : 1u;
}

__device__ __forceinline__ void xcd_barrier(const XcdBarrier& b) {
    asm volatile("s_waitcnt vmcnt(0)" ::: "memory");
    __syncthreads();
    if (threadIdx.x == 0) {
        unsigned* bar = b.bar;
        __builtin_amdgcn_s_waitcnt(0);
        unsigned nloc = b.st[0], nx = b.st[1];
        if (nloc == 0u) { xcd_barrier_complete(bar, b.x, nloc, nx); b.st[0] = nloc; b.st[1] = nx; }
        const unsigned old = xb_add(&bar[XB_XSUB(b.x)], 1u);
        const unsigned gen = old / nloc;
        if (old + 1u == (gen + 1u) * nloc) {
            __builtin_amdgcn_fence(__ATOMIC_RELEASE, "agent");
            asm volatile("s_waitcnt vmcnt(0)" ::: "memory");
            const unsigned og = xb_add(&bar[XB_TOP], 1u);
            const unsigned tg = og / nx;
            if (og + 1u == (tg + 1u) * nx) xb_add(&bar[XB_TOPGEN], 1u);
            else XB_SPIN(xb_ld(&bar[XB_TOPGEN]) == tg, bar);
            __builtin_amdgcn_fence(__ATOMIC_ACQUIRE, "agent");
            xb_add(&bar[XB_XGEN(b.x)], 1u);
            asm volatile("s_waitcnt vmcnt(0)" ::: "memory");
        } else {
            XB_SPIN(xb_ld(&bar[XB_XGEN(b.x)]) == gen, bar);
            __builtin_amdgcn_fence(__ATOMIC_ACQUIRE, "agent");
            asm volatile("s_waitcnt vmcnt(0)" ::: "memory");
        }
    }
    __syncthreads();
}
namespace pg8 {
#define PG8_LAS __attribute__((address_space(3)))
typedef unsigned short bf16_t;
typedef short bf16x8 __attribute__((ext_vector_type(8)));
typedef float f32x4 __attribute__((ext_vector_type(4)));
typedef unsigned u32x4 __attribute__((ext_vector_type(4)));
constexpr int BM = 256, BK = 64, HALF = 128, HTB = HALF * BK * 2  , STAGE_BYTES = 8 * HTB, NXCD = 8, WGM = 8;

__host__ __device__ __forceinline__ int lds_byte(int r, int c) { const int st = (r >> 4) * 2 + (c >> 5), rr = r & 15, cc = c & 31, ob = rr * 64 + cc * 2; return st * 1024 + (ob ^ (((ob >> 9) & 1) << 5)); }
__host__ __device__ __forceinline__ void stage_rc(int b, int& R, int& C) { const int st = b / 1024, sb = b % 1024, swz = sb ^ (((sb >> 9) & 1) << 5); R = (st >> 1) * 16 + swz / 64; C = (st & 1) * 32 + (swz % 64) / 2; }
__host__ __device__ __forceinline__ int perm32(int rho) { const int n = rho >> 4, i = rho & 15; return 8 * (i >> 2) + 4 * n + (i & 3); }

struct Unit { int pm, pn; };
struct Gemm { const bf16_t* A; const bf16_t* Bt; int M, N, K; };

struct StaticOrder {
    int nM, nN, nwg, G, c;
    __host__ __device__ void init(int M, int N, int G_, int c_) { nM = M / BM; nN = N / BM; nwg = nM * nN; G = G_; c = c_; }
    __host__ __device__ bool next(int i, Unit& u) const {
        const long L = (long)i * G + c; if (L >= nwg) return false;
        int wgid = (int)L; { const int q = nwg / NXCD, r = nwg % NXCD, xcd = wgid % NXCD, off = wgid / NXCD; wgid = (xcd < r ? xcd * (q + 1) : r * (q + 1) + (xcd - r) * q) + off; }
        const int nig = WGM * nN, gid = wgid / nig, fm = gid * WGM, gsz = (nM - fm) < WGM ? (nM - fm) : WGM;
        u.pm = fm + ((wgid % nig) % gsz); u.pn = (wgid % nig) / gsz; return true;
    }
    __device__ __forceinline__ void a_ready(const Unit&) const {}
    __device__ __forceinline__ void done(const Unit&) const {}
};

__device__ __forceinline__ unsigned cvt_pk_bf16(float lo, float hi) { unsigned r; asm volatile("v_cvt_pk_bf16_f32 %0, %1, %2" : "=v"(r) : "v"(lo), "v"(hi)); return r; }
typedef float f32x2 __attribute__((ext_vector_type(2)));
__device__ __forceinline__ f32x2 gelu_pk(f32x2 v) {
    const f32x2 av = __builtin_elementwise_abs(v), d = av * 0.2316418882f + 1.0f;
    f32x2 t; t.x = __builtin_amdgcn_rcpf(d.x); t.y = __builtin_amdgcn_rcpf(d.y);
    f32x2 q = t * 0.5307027145f + (-0.7265760135f); q = q * t + 0.7107068705f; q = q * t + (-0.142248368f); q = q * t + 0.127414796f; q = q * t;
    const f32x2 s = (v * v) * (-0.72134752044f);
    f32x2 e; e.x = __builtin_amdgcn_exp2f(s.x); e.y = __builtin_amdgcn_exp2f(s.y);
    const f32x2 m = v * (q * e), r = v - m;
    f32x2 o; o.x = v.x < 0.f ? m.x : r.x; o.y = v.y < 0.f ? m.y : r.y; return o;
}

template <int ACT  > struct EpiBf16 {
    static constexpr bool PERM = true, AFTER_DRAIN = false; static_assert(ACT == 0 || ACT == 1, "EpiBf16: ACT is 0 (none) or 1 (gelu_pk)");
    bf16_t* O; int ldc; const float* bias; int split_cols; size_t split_stride; float scale0;
    __device__ __forceinline__ void operator()(const f32x4 (&acc)[2][2][4][2], const Unit& u, int wr, int wc, int fr, int fq) const {
        const int row0 = u.pm * BM + wr * 64 + fr; int colt = u.pn * BM; bf16_t* base = O;
        float sc = 1.f; if (split_cols) { const int t = colt / split_cols; base += (size_t)t * split_stride; colt -= t * split_cols; if (t == 0) sc = scale0; }
        const int col0 = colt + wc * 32 + 8 * fq, bcol0 = u.pn * BM + wc * 32 + 8 * fq;
        f32x4 bv[2][2];
#pragma unroll
        for (int bj = 0; bj < 2; ++bj)
#pragma unroll
            for (int n = 0; n < 2; ++n) bv[bj][n] = bias ? *(const f32x4*)(bias + bcol0 + bj * HALF + 4 * n) : (f32x4){0.f, 0.f, 0.f, 0.f};
#pragma unroll
        for (int ai = 0; ai < 2; ++ai)
#pragma unroll
            for (int m = 0; m < 4; ++m) { bf16_t* rowp = base + (size_t)(row0 + ai * HALF + m * 16) * ldc + col0;
#pragma unroll
                for (int bj = 0; bj < 2; ++bj) { f32x4 v0 = acc[ai][bj][m][0] + bv[bj][0], v1 = acc[ai][bj][m][1] + bv[bj][1];
                    if (ACT == 1) { f32x2 a = gelu_pk((f32x2){v0[0], v0[1]}), b = gelu_pk((f32x2){v0[2], v0[3]}), c = gelu_pk((f32x2){v1[0], v1[1]}), d = gelu_pk((f32x2){v1[2], v1[3]});
                        v0 = (f32x4){a.x, a.y, b.x, b.y}; v1 = (f32x4){c.x, c.y, d.x, d.y}; }
                    v0 = v0 * sc; v1 = v1 * sc; u32x4 w; w.x = cvt_pk_bf16(v0[0], v0[1]); w.y = cvt_pk_bf16(v0[2], v0[3]); w.z = cvt_pk_bf16(v1[0], v1[1]); w.w = cvt_pk_bf16(v1[2], v1[3]);
                    *(u32x4*)(rowp + bj * HALF) = w; } }
    }
};

struct PanelStats {
    unsigned* xbuf;
    unsigned* cnt;
    unsigned* tmo;
    int ntn; float eps;
    unsigned code;
    __device__ __forceinline__ bool run(const f32x4 (&v)[2][2][4][2], const Unit& u, int wr, int wc, int fr, int fq, PG8_LAS unsigned char* lds, int wid, int lane) const {
        typedef float f32x2v __attribute__((ext_vector_type(2)));
        PG8_LAS f32x2v* P = (PG8_LAS f32x2v*)lds;
        PG8_LAS f32x2v* S = (PG8_LAS f32x2v*)(lds + 8192);
        PG8_LAS unsigned* flag = (PG8_LAS unsigned*)(lds + 8192 + 2048);
#pragma unroll
        for (int ai = 0; ai < 2; ++ai)
#pragma unroll
            for (int m = 0; m < 4; ++m) {
                float s = 0.f;
#pragma unroll
                for (int bj = 0; bj < 2; ++bj)
#pragma unroll
                    for (int n = 0; n < 2; ++n) { const f32x4 x = v[ai][bj][m][n]; s += (x[0] + x[1]) + (x[2] + x[3]); }
                s += __shfl_xor(s, 16); s += __shfl_xor(s, 32);
                const float mw = s * (1.0f / 64.0f); float q = 0.f;
#pragma unroll
                for (int bj = 0; bj < 2; ++bj)
#pragma unroll
                    for (int n = 0; n < 2; ++n) { const f32x4 d = v[ai][bj][m][n] - mw; q += (d[0] * d[0] + d[1] * d[1]) + (d[2] * d[2] + d[3] * d[3]); }
                q += __shfl_xor(q, 16); q += __shfl_xor(q, 32);
                if (fq == 0) P[(ai * HALF + wr * 64 + m * 16 + fr) * 4 + wc] = (f32x2v){mw, q};
            }
        asm volatile("s_waitcnt lgkmcnt(0)" ::: "memory"); __builtin_amdgcn_s_barrier(); asm volatile("" ::: "memory");
#if defined(BROKEN_EXCHANGE_NO_WAIT)
#warning BROKEN CONTROL BUILD: the row-statistics exchange does not wait; results are wrong by design
        if (blockIdx.x >= 64) { const long long t0_ = clock64(); while (clock64() - t0_ < 60000) __builtin_amdgcn_s_sleep(8); }
#endif
        const int row = wid * 32 + (lane & 31);
        if (lane < 32) {
            const f32x2v a = P[row * 4 + 0], b = P[row * 4 + 1], c = P[row * 4 + 2], d = P[row * 4 + 3];
            const float mt = (a.x + b.x + c.x + d.x) * 0.25f;
            const float da = a.x - mt, db = b.x - mt, dc = c.x - mt, dd = d.x - mt;
            const float m2 = (a.y + b.y) + (c.y + d.y) + 64.0f * ((da * da + db * db) + (dc * dc + dd * dd));
            unsigned long long* slot = (unsigned long long*)xbuf + ((size_t)(u.pm * BM + row) * 4 + u.pn);
            __hip_atomic_store(slot, ((unsigned long long)__float_as_uint(m2) << 32) | __float_as_uint(mt), __ATOMIC_RELAXED, __HIP_MEMORY_SCOPE_AGENT);
        }
        asm volatile("s_waitcnt vmcnt(0)" ::: "memory");
        if (lane == 0) __hip_atomic_fetch_add(cnt + 64 * u.pm, 1u, __ATOMIC_RELAXED, __HIP_MEMORY_SCOPE_AGENT);
        if (wid == 0) {
            bool dead = false; const unsigned long long t0 = __builtin_amdgcn_s_memrealtime(); const unsigned want = 8u * (unsigned)ntn;
            for (;;) {
#if defined(BROKEN_EXCHANGE_NO_WAIT)
                break;
#endif
                if ((unsigned)__builtin_amdgcn_readfirstlane(__hip_atomic_load(cnt + 64 * u.pm, __ATOMIC_RELAXED, __HIP_MEMORY_SCOPE_AGENT)) >= want) break;
                if (__builtin_amdgcn_s_memrealtime() - t0 > 2000000ull) {
                    if (lane == 0) { unsigned expect = 0u; __hip_atomic_compare_exchange_strong(tmo + 1, &expect, code | (unsigned)(u.pm & 0xff), __ATOMIC_RELAXED, __ATOMIC_RELAXED, __HIP_MEMORY_SCOPE_AGENT);
                                     __hip_atomic_store(tmo, 1u, __ATOMIC_RELAXED, __HIP_MEMORY_SCOPE_AGENT); }
                    dead = true; break; }
                __builtin_amdgcn_s_sleep(2);
            }
            __builtin_amdgcn_fence(__ATOMIC_ACQUIRE, "agent");
            if (lane == 0) flag[0] = dead ? 1u : 0u;
        }
        asm volatile("s_waitcnt vmcnt(0) lgkmcnt(0)" ::: "memory"); __builtin_amdgcn_s_barrier(); asm volatile("" ::: "memory");
        const bool bad = flag[0] != 0u;
        if (lane < 32) {
            const unsigned long long* slot = (const unsigned long long*)xbuf + (size_t)(u.pm * BM + row) * 4; float mt[4], m2[4]; float ms = 0.f;
#pragma unroll
            for (int t = 0; t < 4; ++t) { if (t < ntn) { const unsigned long long w = __hip_atomic_load(slot + t, __ATOMIC_RELAXED, __HIP_MEMORY_SCOPE_AGENT); mt[t] = __uint_as_float((unsigned)w); m2[t] = __uint_as_float((unsigned)(w >> 32)); } else { mt[t] = 0.f; m2[t] = 0.f; } ms += mt[t]; }
            const float mean = ms / (float)ntn; float q = 0.f;
#pragma unroll
            for (int t = 0; t < 4; ++t) if (t < ntn) { const float dm = mt[t] - mean; q += m2[t] + 256.0f * dm * dm; }
            S[row] = (f32x2v){mean, 1.0f / sqrtf(q / (256.0f * (float)ntn) + eps)};
        }
        asm volatile("s_waitcnt lgkmcnt(0)" ::: "memory"); __builtin_amdgcn_s_barrier(); asm volatile("" ::: "memory");
        return bad;
    }
};
struct EpiLnRes {
    static constexpr bool PERM = false, AFTER_DRAIN = true;
    const float* base; float* out; int ldc; const float* bias; PanelStats st; unsigned poison;
    __device__ __forceinline__ void fused(f32x4 (&acc)[2][2][4][2], const Unit& u, int wr, int wc, int fr, int fq, PG8_LAS unsigned char* lds, int wid, int lane) const {
        typedef float f32x2v __attribute__((ext_vector_type(2)));
        const PG8_LAS f32x2v* S = (const PG8_LAS f32x2v*)(lds + 8192);
        const int col0 = u.pn * BM + wc * 32 + 4 * fq;
#pragma unroll
        for (int bj = 0; bj < 2; ++bj)
#pragma unroll
            for (int n = 0; n < 2; ++n) { const f32x4 bv = bias ? *(const f32x4*)(bias + col0 + bj * HALF + n * 16) : (f32x4){0.f, 0.f, 0.f, 0.f};
#pragma unroll
                for (int ai = 0; ai < 2; ++ai)
#pragma unroll
                    for (int m = 0; m < 4; ++m) acc[ai][bj][m][n] += bv; }
        f32x4 pre[4][2][2];
#pragma unroll
        for (int m = 0; m < 4; ++m) { const size_t off = (size_t)(u.pm * BM + wr * 64 + m * 16 + fr) * ldc + col0;
#pragma unroll
            for (int bj = 0; bj < 2; ++bj)
#pragma unroll
                for (int n = 0; n < 2; ++n) pre[m][bj][n] = *(const f32x4*)(base + off + bj * HALF + n * 16); }
        const bool bad = st.run(acc, u, wr, wc, fr, fq, lds, wid, lane) || poison != 0u;
        const float qnan = __builtin_nanf("");
#pragma unroll
        for (int ai = 0; ai < 2; ++ai)
#pragma unroll
            for (int m = 0; m < 4; ++m) { const int r = ai * HALF + wr * 64 + m * 16 + fr; const f32x2v sr = S[r]; const size_t off = (size_t)(u.pm * BM + r) * ldc + col0;
#pragma unroll
                for (int bj = 0; bj < 2; ++bj)
#pragma unroll
                    for (int n = 0; n < 2; ++n) { const f32x4 bs = ai == 0 ? pre[m][bj][n] : *(const f32x4*)(base + off + bj * HALF + n * 16); f32x4 o = bs + (acc[ai][bj][m][n] - sr.x) * sr.y;
                        if (bad) o = (f32x4){qnan, qnan, qnan, qnan}; *(f32x4*)(out + off + bj * HALF + n * 16) = o; }
                if (m & 1) asm volatile("" ::: "memory"); }
    }
};
struct EpiLnResLn {
    static constexpr bool PERM = false, AFTER_DRAIN = true;
    const float* base; float* out; bf16_t* xn; int ldc; const float* bias; PanelStats st1, st2; unsigned poison;
    __device__ __forceinline__ void fused(f32x4 (&acc)[2][2][4][2], const Unit& u, int wr, int wc, int fr, int fq, PG8_LAS unsigned char* lds, int wid, int lane) const {
        typedef float f32x2v __attribute__((ext_vector_type(2))); typedef unsigned u32x2v __attribute__((ext_vector_type(2)));
        const PG8_LAS f32x2v* S = (const PG8_LAS f32x2v*)(lds + 8192);
        const int col0 = u.pn * BM + wc * 32 + 4 * fq;
#pragma unroll
        for (int bj = 0; bj < 2; ++bj)
#pragma unroll
            for (int n = 0; n < 2; ++n) { const f32x4 bv = bias ? *(const f32x4*)(bias + col0 + bj * HALF + n * 16) : (f32x4){0.f, 0.f, 0.f, 0.f};
#pragma unroll
                for (int ai = 0; ai < 2; ++ai)
#pragma unroll
                    for (int m = 0; m < 4; ++m) acc[ai][bj][m][n] += bv; }
        bool bad = st1.run(acc, u, wr, wc, fr, fq, lds, wid, lane) || poison != 0u;
        const float qnan = __builtin_nanf("");
#pragma unroll
        for (int ai = 0; ai < 2; ++ai)
#pragma unroll
            for (int m = 0; m < 4; ++m) { const int r = ai * HALF + wr * 64 + m * 16 + fr; const f32x2v sr = S[r]; const size_t off = (size_t)(u.pm * BM + r) * ldc + col0;
#pragma unroll
                for (int bj = 0; bj < 2; ++bj)
#pragma unroll
                    for (int n = 0; n < 2; ++n) { const f32x4 bs = *(const f32x4*)(base + off + bj * HALF + n * 16); acc[ai][bj][m][n] = bs + (acc[ai][bj][m][n] - sr.x) * sr.y; }
                asm volatile("" : "+v"(acc[ai][0][m][0]), "+v"(acc[ai][0][m][1]), "+v"(acc[ai][1][m][0]), "+v"(acc[ai][1][m][1]));
                if (m & 1) asm volatile("" ::: "memory"); }
        const bool bad1 = bad;
        bad = st2.run(acc, u, wr, wc, fr, fq, lds, wid, lane) || bad;
#pragma unroll
        for (int ai = 0; ai < 2; ++ai)
#pragma unroll
            for (int m = 0; m < 4; ++m) { const int r = ai * HALF + wr * 64 + m * 16 + fr; const f32x2v sr = S[r]; const size_t off = (size_t)(u.pm * BM + r) * ldc + col0;
#pragma unroll
                for (int bj = 0; bj < 2; ++bj)
#pragma unroll
                    for (int n = 0; n < 2; ++n) { const f32x4 x1 = acc[ai][bj][m][n]; *(f32x4*)(out + off + bj * HALF + n * 16) = bad1 ? (f32x4){qnan, qnan, qnan, qnan} : x1;
                        const f32x4 o = (x1 - sr.x) * sr.y; u32x2v w; w.x = cvt_pk_bf16(o[0], o[1]); w.y = cvt_pk_bf16(o[2], o[3]);
                        if (bad) { w.x = 0x7fc07fc0u; w.y = 0x7fc07fc0u; } *(u32x2v*)(xn + off + bj * HALF + n * 16) = w; }
                asm volatile("" ::: "memory"); }
    }
};

template <class Epi, class Sched, bool ALIGN_EPI = false, bool SP2 = false>
__device__ __forceinline__ void gemm_phase(PG8_LAS unsigned char* lds, const Gemm g, const Sched& S, const Epi& E) {
    int tid = threadIdx.x; asm volatile("" : "+v"(tid));
    const int wid = __builtin_amdgcn_readfirstlane(tid >> 6), lane = tid & 63, wr = wid >> 2, wc = wid & 3, fr = lane & 15, fq = lane >> 4;
    const int K = g.K, nt = K / BK;
    unsigned voffA[2], voffB[2];
#pragma unroll
    for (int i = 0; i < 2; ++i) { int R, C; stage_rc(tid * 16 + i * 8192, R, C); const int Rb = Epi::PERM ? ((R & ~31) + perm32(R & 31)) : R;
        voffA[i] = (unsigned)(R * K + C) * 2u; voffB[i] = (unsigned)(Rb * K + C) * 2u; }
    const size_t kstep = (size_t)(BK * 2);
    const size_t hstep = (size_t)HALF * K * 2;
    const size_t tstep = 2 * hstep;
    const unsigned ldsw = (unsigned)wid * 1024u;
    const int aoff = lds_byte(wr * 64 + fr, fq * 8), boff = lds_byte(wc * 32 + fr, fq * 8);
#define PG8_SA(b, h) (((b) * 2 + (h)) * HTB)
#define PG8_SB(b, h) ((4 + (b) * 2 + (h)) * HTB)
#define PG8_STAGE(bufoff, gbase, voff) do { _Pragma("unroll") for (int _i = 0; _i < 2; ++_i) \
        __builtin_amdgcn_global_load_lds((const unsigned*)((const char*)(gbase) + (voff)[_i]), (PG8_LAS unsigned*)(lds + (bufoff) + ldsw + _i * 8192), 16, 0, 0); } while (0)
#define PG8_LDA(dst, b, h) do { _Pragma("unroll") for (int m = 0; m < 4; ++m) _Pragma("unroll") for (int k = 0; k < 2; ++k) dst[m][k] = *(const PG8_LAS bf16x8*)(lds + PG8_SA(b, h) + aoff + m * 2048 + k * 1024); } while (0)
#define PG8_LDB(dst, b, h) do { _Pragma("unroll") for (int n = 0; n < 2; ++n) _Pragma("unroll") for (int k = 0; k < 2; ++k) dst[n][k] = *(const PG8_LAS bf16x8*)(lds + PG8_SB(b, h) + boff + n * 2048 + k * 1024); } while (0)
#define PG8_MMA(ai, bj, At, Bt) do { __builtin_amdgcn_s_setprio(1); _Pragma("unroll") for (int m = 0; m < 4; ++m) _Pragma("unroll") for (int n = 0; n < 2; ++n) _Pragma("unroll") for (int k = 0; k < 2; ++k) \
        acc[ai][bj][m][n] = __builtin_amdgcn_mfma_f32_16x16x32_bf16(Bt[n][k], At[m][k], acc[ai][bj][m][n], 0, 0, 0); __builtin_amdgcn_s_setprio(0); } while (0)
#define PG8_WAIT_V(n) asm volatile("s_waitcnt vmcnt(" #n ")" ::: "memory")
#define PG8_WAIT_L(n) asm volatile("s_waitcnt lgkmcnt(" #n ")" ::: "memory")
#define PG8_BAR __builtin_amdgcn_s_barrier()
#define PG8_SCHED __builtin_amdgcn_sched_barrier(0)
    Unit cur, nxt; int ui = 0;
    if (!S.next(0, cur)) return;
    f32x4 acc[2][2][4][2];
#pragma unroll
    for (int a = 0; a < 2; ++a)
#pragma unroll
        for (int b = 0; b < 2; ++b)
#pragma unroll
            for (int m = 0; m < 4; ++m)
#pragma unroll
                for (int n = 0; n < 2; ++n) acc[a][b][m][n] = (f32x4){0.f, 0.f, 0.f, 0.f};
    bf16x8 At[4][2], B0[2][2], B1[2][2];
    const char* cA = (const char*)g.A + (size_t)cur.pm * tstep; const char* cB = (const char*)g.Bt + (size_t)cur.pn * tstep;
    S.a_ready(cur);
    if constexpr (SP2) {
        PG8_STAGE(PG8_SB(0, 0), cB, voffB); PG8_STAGE(PG8_SB(0, 1), cB + hstep, voffB); PG8_STAGE(PG8_SA(0, 0), cA, voffA); PG8_STAGE(PG8_SA(0, 1), cA + hstep, voffA);
        if (wr == 1) PG8_BAR;
        PG8_WAIT_V(2); PG8_BAR;
        PG8_STAGE(PG8_SB(1, 0), cB + kstep, voffB); PG8_STAGE(PG8_SA(1, 0), cA + kstep, voffA); PG8_STAGE(PG8_SB(1, 1), cB + hstep + kstep, voffB);
        PG8_WAIT_V(6); PG8_BAR;
    } else {
        PG8_STAGE(PG8_SB(0, 0), cB, voffB); PG8_STAGE(PG8_SA(0, 0), cA, voffA); PG8_STAGE(PG8_SB(0, 1), cB + hstep, voffB); PG8_STAGE(PG8_SA(0, 1), cA + hstep, voffA);
        if (wr == 1) PG8_BAR;
        PG8_WAIT_V(4); PG8_BAR;
        PG8_STAGE(PG8_SB(1, 0), cB + kstep, voffB); PG8_STAGE(PG8_SA(1, 0), cA + kstep, voffA); PG8_STAGE(PG8_SB(1, 1), cB + hstep + kstep, voffB);
        PG8_WAIT_V(6); PG8_BAR;
    }
    for (;;) {
        const bool has_next = S.next(ui + 1, nxt);
        const char* nA = has_next ? (const char*)g.A + (size_t)nxt.pm * tstep : cA; const char* nB = has_next ? (const char*)g.Bt + (size_t)nxt.pn * tstep : cB;
        for (int t = 0; t < nt; t += 2) {
            const bool last = (t == nt - 2);
            const char* a1 = cA + (size_t)(t + 1) * kstep;
            const char* a2 = last ? nA : cA + (size_t)(t + 2) * kstep; const char* b2 = last ? nB : cB + (size_t)(t + 2) * kstep;
            const char* a3 = a2 + kstep; const char* b3 = b2 + kstep;
            if (last && has_next) S.a_ready(nxt);
            if constexpr (SP2) {
            PG8_LDB(B0, 0, 0); PG8_LDB(B1, 0, 1); PG8_SCHED; PG8_LDA(At, 0, 0); PG8_STAGE(PG8_SA(1, 1), a1 + hstep, voffA);
            PG8_WAIT_V(8); PG8_WAIT_L(0); PG8_BAR; PG8_MMA(0, 0, At, B0); PG8_MMA(0, 1, At, B1); PG8_BAR; PG8_SCHED;
            PG8_LDA(At, 0, 1); PG8_STAGE(PG8_SB(0, 0), b2, voffB); PG8_STAGE(PG8_SB(0, 1), b2 + hstep, voffB); PG8_STAGE(PG8_SA(0, 0), a2, voffA);
            PG8_WAIT_V(8); PG8_WAIT_L(0); PG8_BAR; PG8_MMA(1, 0, At, B0); PG8_MMA(1, 1, At, B1); PG8_BAR; PG8_SCHED;
            PG8_LDB(B0, 1, 0); PG8_LDB(B1, 1, 1); PG8_SCHED; PG8_LDA(At, 1, 0); PG8_STAGE(PG8_SA(0, 1), a2 + hstep, voffA);
            PG8_WAIT_V(8); PG8_WAIT_L(0); PG8_BAR; PG8_MMA(0, 0, At, B0); PG8_MMA(0, 1, At, B1); PG8_BAR; PG8_SCHED;
            PG8_LDA(At, 1, 1); PG8_STAGE(PG8_SB(1, 0), b3, voffB); PG8_STAGE(PG8_SB(1, 1), b3 + hstep, voffB); PG8_STAGE(PG8_SA(1, 0), a3, voffA);
            PG8_WAIT_V(8); PG8_WAIT_L(0); PG8_BAR; PG8_MMA(1, 0, At, B0); PG8_MMA(1, 1, At, B1); PG8_BAR; PG8_SCHED;
            } else {
            PG8_LDB(B0, 0, 0); PG8_SCHED; PG8_LDA(At, 0, 0); PG8_STAGE(PG8_SA(1, 1), a1 + hstep, voffA);
            PG8_WAIT_L(8); PG8_BAR; PG8_WAIT_L(0); PG8_MMA(0, 0, At, B0); PG8_BAR; PG8_SCHED;
            PG8_LDB(B1, 0, 1); PG8_STAGE(PG8_SB(0, 0), b2, voffB);
            PG8_BAR; PG8_WAIT_L(0); PG8_MMA(0, 1, At, B1); PG8_BAR;
            PG8_LDA(At, 0, 1); PG8_STAGE(PG8_SA(0, 0), a2, voffA);
            PG8_BAR; PG8_WAIT_L(0); PG8_MMA(1, 0, At, B0); PG8_BAR; PG8_SCHED;
            PG8_STAGE(PG8_SB(0, 1), b2 + hstep, voffB);
            PG8_WAIT_V(6); PG8_BAR; PG8_MMA(1, 1, At, B1); PG8_BAR;
            PG8_LDB(B0, 1, 0); PG8_SCHED; PG8_LDA(At, 1, 0); PG8_STAGE(PG8_SA(0, 1), a2 + hstep, voffA);
            PG8_WAIT_L(8); PG8_BAR; PG8_WAIT_L(0); PG8_MMA(0, 0, At, B0); PG8_BAR; PG8_SCHED;
            PG8_LDB(B1, 1, 1); PG8_STAGE(PG8_SB(1, 0), b3, voffB);
            PG8_BAR; PG8_WAIT_L(0); PG8_MMA(0, 1, At, B1); PG8_BAR;
            PG8_LDA(At, 1, 1); PG8_STAGE(PG8_SA(1, 0), a3, voffA);
            PG8_BAR; PG8_WAIT_L(0); PG8_MMA(1, 0, At, B0); PG8_BAR; PG8_SCHED;
            PG8_STAGE(PG8_SB(1, 1), b3 + hstep, voffB);
            PG8_WAIT_V(6); PG8_BAR; PG8_MMA(1, 1, At, B1); PG8_BAR;
            }
        }
        if constexpr (ALIGN_EPI) { if (wr == 0) PG8_BAR; }
        if constexpr (!Epi::AFTER_DRAIN) { E(acc, cur, wr, wc, fr, fq); S.done(cur); }
        if (!has_next) break;
#pragma unroll
        for (int a = 0; a < 2; ++a)
#pragma unroll
            for (int b = 0; b < 2; ++b)
#pragma unroll
                for (int m = 0; m < 4; ++m)
#pragma unroll
                    for (int n = 0; n < 2; ++n) acc[a][b][m][n] = (f32x4){0.f, 0.f, 0.f, 0.f};
        cur = nxt; cA = nA; cB = nB; ++ui;
        if constexpr (ALIGN_EPI) { if (wr == 1) PG8_BAR; }
    }
    PG8_WAIT_V(0);
    if constexpr (!ALIGN_EPI) { if (wr == 0) PG8_BAR; }
    PG8_BAR;
    if constexpr (Epi::AFTER_DRAIN) { E.fused(acc, cur, wr, wc, fr, fq, lds, wid, lane); S.done(cur); }
#undef PG8_SA
#undef PG8_SB
#undef PG8_STAGE
#undef PG8_LDA
#undef PG8_LDB
#undef PG8_MMA
#undef PG8_WAIT_V
#undef PG8_WAIT_L
#undef PG8_BAR
#undef PG8_SCHED
}
}

#ifndef PG8_SP2
#define PG8_SP2 true
#endif
#ifndef PG8_ALIGN
#define PG8_ALIGN true
#endif
namespace att {
constexpr int NW = 8, QBLK = 32, KVBLK = 64;
constexpr int SHM_V = KVBLK * 128 * 2, SHM_K = KVBLK * 64 * 2, SHM_ATTN = 2 * SHM_V + 2 * SHM_K + NW * 64 * 4;
#define KSWZ64(row, colB) ((row) * 128 + ((colB) ^ ((((row) >> 1) & 7) << 4)))
#define SBAR() __builtin_amdgcn_sched_barrier(0)
__device__ __forceinline__ int crow(int r, int hi) { return (r & 3) + 8 * (r >> 2) + 4 * hi; }
__device__ __forceinline__ unsigned cvtpk(float lo, float hi) { unsigned r; asm volatile("v_cvt_pk_bf16_f32 %0, %1, %2" : "=v"(r) : "v"(lo), "v"(hi)); return r; }
__device__ __forceinline__ void expA(f32x16& p) {
#pragma unroll
    for (int r = 0; r < 16; ++r) p[r] = __builtin_amdgcn_exp2f(p[r]);
}
__device__ __forceinline__ void finishSM(f32x16& p0, f32x16& p1, float& l_reg, bf16x8& pa0, bf16x8& pa1, bf16x8& pa2, bf16x8& pa3) {
#pragma unroll
    for (int r = 0; r < 16; ++r) p1[r] = __builtin_amdgcn_exp2f(p1[r]);
    float ps = 0;
#pragma unroll
    for (int r = 0; r < 16; ++r) ps += p0[r];
#pragma unroll
    for (int r = 0; r < 16; ++r) ps += p1[r];
    l_reg += ps;
#define PK4(P, BASE, OUT) do { unsigned a0 = cvtpk(P[BASE + 0], P[BASE + 1]), a1 = cvtpk(P[BASE + 2], P[BASE + 3]);   \
    unsigned b0 = cvtpk(P[BASE + 4], P[BASE + 5]), b1 = cvtpk(P[BASE + 6], P[BASE + 7]);                              \
    auto r0 = __builtin_amdgcn_permlane32_swap(a0, b0, false, false); auto r1 = __builtin_amdgcn_permlane32_swap(a1, b1, false, false); \
    v4u w = {r0[0], r1[0], r0[1], r1[1]}; OUT = *reinterpret_cast<bf16x8*>(&w); } while (0)
    PK4(p0, 0, pa0); PK4(p0, 8, pa1); PK4(p1, 0, pa2); PK4(p1, 8, pa3);
#undef PK4
}
__device__ __forceinline__ void softHalf(f32x16& p, float& l_reg, bf16x8& paLo, bf16x8& paHi) {
#pragma unroll
    for (int r = 0; r < 16; ++r) p[r] = __builtin_amdgcn_exp2f(p[r]);
    float ps = 0;
#pragma unroll
    for (int r = 0; r < 16; ++r) ps += p[r];
    l_reg += ps;
#define PK4(P, BASE, OUT) do { unsigned a0 = cvtpk(P[BASE + 0], P[BASE + 1]), a1 = cvtpk(P[BASE + 2], P[BASE + 3]);   \
    unsigned b0 = cvtpk(P[BASE + 4], P[BASE + 5]), b1 = cvtpk(P[BASE + 6], P[BASE + 7]);                              \
    auto r0 = __builtin_amdgcn_permlane32_swap(a0, b0, false, false); auto r1 = __builtin_amdgcn_permlane32_swap(a1, b1, false, false); \
    v4u w = {r0[0], r1[0], r0[1], r1[1]}; OUT = *reinterpret_cast<bf16x8*>(&w); } while (0)
    PK4(p, 0, paLo); PK4(p, 8, paHi);
#undef PK4
}
__device__ __forceinline__ void qkt(f32x16& p0, f32x16& p1, const char* Ks, const bf16x8* qr, int r32, int hi) {
    p0 = f32x16{}; p1 = f32x16{};
#pragma unroll
    for (int d0 = 0; d0 < 4; ++d0) { const int cb = (d0 * 16 + hi * 8) * 2;
        const bf16x8 b0 = *reinterpret_cast<const bf16x8*>(Ks + KSWZ64(r32, cb));
        const bf16x8 b1 = *reinterpret_cast<const bf16x8*>(Ks + KSWZ64(32 + r32, cb));
        p0 = __builtin_amdgcn_mfma_f32_32x32x16_bf16(b0, qr[d0], p0, 0, 0, 0);
        p1 = __builtin_amdgcn_mfma_f32_32x32x16_bf16(b1, qr[d0], p1, 0, 0, 0); }
}
__device__ __forceinline__ int v_st(int k, int c) { const int kk = (k & ~0xC) | ((k & 4) << 1) | ((k & 8) >> 1); return ((kk >> 3) * 4 + (c >> 5)) * 512 + ((kk & 7) * 32 + (c & 31)) * 2; }
__device__ __forceinline__ int v_rd_base(int lane) { return ((lane & 3) << 3) | (((lane >> 2) & 3) << 6) | (((lane >> 4) & 1) << 5) | (((lane >> 5) & 1) << 8); }
constexpr int v_rd_off(int d0, int ks, int half) { return d0 * 512 + ks * 4096 + half * 2048; }
template <int OFF> __device__ __forceinline__ s16x4 tr_read(int vb) {
    s16x4 r; asm volatile("ds_read_b64_tr_b16 %0, %1 offset:%2" : "=&v"(r) : "v"(vb), "i"(OFF) : "memory"); return r;
}
template <int D0> __device__ __forceinline__ void pv_one(f32x16& od, int vb, bf16x8 pa0, bf16x8 pa1, bf16x8 pa2, bf16x8 pa3) {
    const s16x4 l0 = tr_read<v_rd_off(D0, 0, 0)>(vb), h0 = tr_read<v_rd_off(D0, 0, 1)>(vb), l1 = tr_read<v_rd_off(D0, 1, 0)>(vb), h1 = tr_read<v_rd_off(D0, 1, 1)>(vb);
    const s16x4 l2 = tr_read<v_rd_off(D0, 2, 0)>(vb), h2 = tr_read<v_rd_off(D0, 2, 1)>(vb), l3 = tr_read<v_rd_off(D0, 3, 0)>(vb), h3 = tr_read<v_rd_off(D0, 3, 1)>(vb);
    asm volatile("s_waitcnt lgkmcnt(0)" ::: "memory"); SBAR();
#define PK(L, H) (bf16x8){L[0], L[1], L[2], L[3], H[0], H[1], H[2], H[3]}
    od = __builtin_amdgcn_mfma_f32_32x32x16_bf16(pa0, PK(l0, h0), od, 0, 0, 0);
    od = __builtin_amdgcn_mfma_f32_32x32x16_bf16(pa1, PK(l1, h1), od, 0, 0, 0);
    od = __builtin_amdgcn_mfma_f32_32x32x16_bf16(pa2, PK(l2, h2), od, 0, 0, 0);
    od = __builtin_amdgcn_mfma_f32_32x32x16_bf16(pa3, PK(l3, h3), od, 0, 0, 0);
#undef PK
}
template <int KS> __device__ __forceinline__ void pv_ks(f32x16* o, int vb, bf16x8 pa) {
    const s16x4 l0 = tr_read<v_rd_off(0, KS, 0)>(vb), h0 = tr_read<v_rd_off(0, KS, 1)>(vb), l1 = tr_read<v_rd_off(1, KS, 0)>(vb), h1 = tr_read<v_rd_off(1, KS, 1)>(vb);
    const s16x4 l2 = tr_read<v_rd_off(2, KS, 0)>(vb), h2 = tr_read<v_rd_off(2, KS, 1)>(vb), l3 = tr_read<v_rd_off(3, KS, 0)>(vb), h3 = tr_read<v_rd_off(3, KS, 1)>(vb);
    asm volatile("s_waitcnt lgkmcnt(0)" ::: "memory"); SBAR();
#define PK(L, H) (bf16x8){L[0], L[1], L[2], L[3], H[0], H[1], H[2], H[3]}
    o[0] = __builtin_amdgcn_mfma_f32_32x32x16_bf16(pa, PK(l0, h0), o[0], 0, 0, 0);
    o[1] = __builtin_amdgcn_mfma_f32_32x32x16_bf16(pa, PK(l1, h1), o[1], 0, 0, 0);
    o[2] = __builtin_amdgcn_mfma_f32_32x32x16_bf16(pa, PK(l2, h2), o[2], 0, 0, 0);
    o[3] = __builtin_amdgcn_mfma_f32_32x32x16_bf16(pa, PK(l3, h3), o[3], 0, 0, 0);
#undef PK
}
__device__ __forceinline__ void pv_d0(f32x16* o, int vb, bf16x8 pa0, bf16x8 pa1, bf16x8 pa2, bf16x8 pa3) {
    pv_one<0>(o[0], vb, pa0, pa1, pa2, pa3); pv_one<1>(o[1], vb, pa0, pa1, pa2, pa3); pv_one<2>(o[2], vb, pa0, pa1, pa2, pa3); pv_one<3>(o[3], vb, pa0, pa1, pa2, pa3);
}
__device__ __forceinline__ void attn_unit(const bf16* __restrict__ Qb, const bf16* __restrict__ Kh, const bf16* __restrict__ Vh, bf16* __restrict__ Ob, int seq, char* lds) {
    int tid = threadIdx.x; asm volatile("" : "+v"(tid));
    const int wid = tid >> 6, lane = tid & 63, r32 = lane & 31, hi = lane >> 5;
    char* V_lds = lds; char* K_lds = lds + 2 * SHM_V;
    float* wsf = (float*)(lds + 2 * SHM_V + 2 * SHM_K) + wid * 64;
    float l_reg = 0; f32x16 o[4] = {}; bf16x8 qr[4];
    const bf16* Qw = Qb + (long)(wid * QBLK + r32) * 64 + hi * 8;
#pragma unroll
    for (int d0 = 0; d0 < 4; ++d0) qr[d0] = *reinterpret_cast<const bf16x8*>(Qw + d0 * 16);
    const int sr = tid >> 4, sc = (tid & 15) * 8, vst0 = v_st(sr, sc), vst1 = v_st(32 + sr, sc);
    const int kr = tid >> 3, kc = (tid & 7) * 8, kst = KSWZ64(kr, kc * 2);
    const int vb0 = (int)(uintptr_t)V_lds + v_rd_base(lane);
    struct { bf16x8 vs0, vs1, ks0; } sr_[1];
    const unsigned voff0 = (unsigned)((sr * 128 + sc) * 2), koff0 = (unsigned)((kr * 64 + kc) * 2);
#define SLOAD(i, k0) do { const char* vt_ = (const char*)Vh + (size_t)(k0) * 256; const char* kt_ = (const char*)Kh + (size_t)(k0) * 128; \
    sr_[i].vs0 = *reinterpret_cast<const bf16x8*>(vt_ + voff0); sr_[i].vs1 = *reinterpret_cast<const bf16x8*>(vt_ + 32 * 256 + voff0); \
    sr_[i].ks0 = *reinterpret_cast<const bf16x8*>(kt_ + koff0); } while (0)
#define SWRITE(b, i) do { *(bf16x8*)(V_lds + (b) * SHM_V + vst0) = sr_[i].vs0; *(bf16x8*)(V_lds + (b) * SHM_V + vst1) = sr_[i].vs1; \
    *(bf16x8*)(K_lds + (b) * SHM_K + kst) = sr_[i].ks0; } while (0)
#define SWAIT() asm volatile("s_waitcnt vmcnt(0)" ::: "memory")
    f32x16 pA0, pA1, pB0, pB1; bf16x8 pa0, pa1, pa2, pa3; const int NT = seq / KVBLK;
    constexpr int SE = 0, SO = 0;
    SLOAD(SE, 0); asm volatile("s_waitcnt vmcnt(0)" ::: "memory"); SWRITE(0, SE); __syncthreads();
    qkt(pA0, pA1, K_lds, qr, r32, hi); softHalf(pA0, l_reg, pa0, pa1);
    SLOAD(SO, KVBLK);
    SWAIT(); SWRITE(1, SO); __syncthreads();
    for (int j = 1; j + 1 < NT; j += 2) {
        SBAR(); qkt(pB0, pB1, K_lds + SHM_K, qr, r32, hi); pv_ks<0>(o, vb0, pa0); SBAR();
        softHalf(pA1, l_reg, pa2, pa3); SBAR();
        SLOAD(SO, (j + 1) * KVBLK); SBAR();
        pv_ks<1>(o, vb0, pa1); pv_ks<2>(o, vb0, pa2); pv_ks<3>(o, vb0, pa3); SBAR();
        softHalf(pB0, l_reg, pa0, pa1); SBAR();
        __syncthreads(); SWAIT(); SWRITE(0, SE);
        __syncthreads();
        SBAR(); qkt(pA0, pA1, K_lds, qr, r32, hi); pv_ks<0>(o, vb0 + SHM_V, pa0); SBAR();
        softHalf(pB1, l_reg, pa2, pa3); SBAR();
        SLOAD(SE, (j + 2) * KVBLK); SBAR();
        pv_ks<1>(o, vb0 + SHM_V, pa1); pv_ks<2>(o, vb0 + SHM_V, pa2); pv_ks<3>(o, vb0 + SHM_V, pa3); SBAR();
        softHalf(pA0, l_reg, pa0, pa1); SBAR();
        __syncthreads(); SWAIT(); SWRITE(1, SO);
        __syncthreads();
    }
    SBAR(); qkt(pB0, pB1, K_lds + SHM_K, qr, r32, hi); pv_ks<0>(o, vb0, pa0); SBAR();
    softHalf(pA1, l_reg, pa2, pa3); SBAR();
    pv_ks<1>(o, vb0, pa1); pv_ks<2>(o, vb0, pa2); pv_ks<3>(o, vb0, pa3); SBAR();
    softHalf(pB0, l_reg, pa0, pa1); SBAR();
    pv_ks<0>(o, vb0 + SHM_V, pa0); SBAR();
    softHalf(pB1, l_reg, pa2, pa3); SBAR();
    pv_ks<1>(o, vb0 + SHM_V, pa1); pv_ks<2>(o, vb0 + SHM_V, pa2); pv_ks<3>(o, vb0 + SHM_V, pa3);
    { auto rr = __builtin_amdgcn_permlane32_swap(__float_as_uint(l_reg), __float_as_uint(l_reg), false, false); l_reg = __uint_as_float(rr[0]) + __uint_as_float(rr[1]); }
    if (hi == 0) wsf[r32] = l_reg; asm volatile("s_waitcnt lgkmcnt(0)" ::: "memory");
    float rli[16];
#pragma unroll
    for (int r = 0; r < 16; ++r) rli[r] = __builtin_amdgcn_rcpf(wsf[crow(r, hi)]);
    bf16* Ow = Ob + (long)(wid * QBLK) * 128;
    {
        char* stg = lds + 53248 + wid * 8192;
#pragma unroll
        for (int r = 0; r < 16; ++r) { const int orow = crow(r, hi);
#pragma unroll
            for (int d0 = 0; d0 < 4; ++d0) *(unsigned short*)(stg + (orow * 128 + d0 * 32 + r32) * 2) = (unsigned short)f2bf(o[d0][r] * rli[r]); }
        asm volatile("s_waitcnt lgkmcnt(0)" ::: "memory");
#pragma unroll
        for (int i = 0; i < 8; ++i) { const int row = i * 4 + (lane >> 4), ch = lane & 15; const v4u v = *(const v4u*)(stg + row * 256 + ch * 16); *(v4u*)(Ow + (long)row * 128 + ch * 8) = v; }
    }
    __syncthreads();
#undef SLOAD
#undef SWRITE
#undef SWAIT
}
#undef SBAR
}
namespace ret {
using namespace att;
#define SBAR() __builtin_amdgcn_sched_barrier(0)
__device__ __forceinline__ int v_st64(int k, int c) { const int kk = (k & ~0xC) | ((k & 4) << 1) | ((k & 8) >> 1); return ((kk >> 3) * 2 + (c >> 5)) * 512 + ((kk & 7) * 32 + (c & 31)) * 2; }
constexpr int v_rd_off64(int d0, int ks, int half) { return d0 * 512 + ks * 2048 + half * 1024; }
__device__ __forceinline__ float log2_sigmoid(float x) { return -log1pf(expf(-x)) * 1.4426950408889634f; }
__device__ __forceinline__ bf16x8 scale8(bf16x8 v, float s) {
    v4u w = *reinterpret_cast<v4u*>(&v), o;
#pragma unroll
    for (int i = 0; i < 4; ++i) { const float lo = __builtin_bit_cast(float, w[i] << 16) * s, hi = __builtin_bit_cast(float, w[i] & 0xffff0000u) * s; o[i] = pk2(lo, hi); }
    return *reinterpret_cast<bf16x8*>(&o);
}
__device__ __forceinline__ void state_unit(const bf16* __restrict__ Kc, const bf16* __restrict__ Vc, float* __restrict__ Sf, float* __restrict__ Sb, float lgf2, float lgb2, char* lds) {
    int tid = threadIdx.x; asm volatile("" : "+v"(tid));
    const int wid = tid >> 6, lane = tid & 63, r32 = lane & 31, hi = lane >> 5;
    const int sr = tid >> 4, sc = (tid & 15) * 8, vst0 = v_st(sr, sc), vst1 = v_st(32 + sr, sc);
    const int kr = tid >> 3, kc = (tid & 7) * 8, kst = v_st64(kr, kc);
#pragma unroll
    for (int t = 0; t < 4; ++t) {
        const bf16x8 a0 = *reinterpret_cast<const bf16x8*>(Vc + (size_t)(64 * t + sr) * 128 + sc), a1 = *reinterpret_cast<const bf16x8*>(Vc + (size_t)(64 * t + 32 + sr) * 128 + sc);
        const bf16x8 k0 = *reinterpret_cast<const bf16x8*>(Kc + (size_t)(64 * t + kr) * 64 + kc);
        const int i = 64 * t + kr;
        const float wf = __builtin_amdgcn_exp2f((float)(255 - i) * lgf2), wb = __builtin_amdgcn_exp2f((float)i * lgb2);
        *(bf16x8*)(lds + t * 32768 + vst0) = a0; *(bf16x8*)(lds + t * 32768 + vst1) = a1;
        *(bf16x8*)(lds + t * 32768 + 16384 + kst) = scale8(k0, wf); *(bf16x8*)(lds + t * 32768 + 24576 + kst) = scale8(k0, wb);
    }
    __syncthreads();
    const int dblk = wid >> 2, eblk = wid & 3;
    const int vb = (int)(uintptr_t)lds + v_rd_base(lane);
    f32x16 accf = {}, accb = {};
#pragma unroll
    for (int t = 0; t < 4; ++t) {
#pragma unroll
        for (int ks = 0; ks < 4; ++ks) {
            s16x4 vl, vh, fl, fh, bl, bh;
            const int vo = vb + t * 32768 + eblk * 512 + ks * 4096, ko = vb + t * 32768 + 16384 + dblk * 512 + ks * 2048;
            asm volatile("ds_read_b64_tr_b16 %0, %1" : "=&v"(vl) : "v"(vo) : "memory");
            asm volatile("ds_read_b64_tr_b16 %0, %1 offset:2048" : "=&v"(vh) : "v"(vo) : "memory");
            asm volatile("ds_read_b64_tr_b16 %0, %1" : "=&v"(fl) : "v"(ko) : "memory");
            asm volatile("ds_read_b64_tr_b16 %0, %1 offset:1024" : "=&v"(fh) : "v"(ko) : "memory");
            asm volatile("ds_read_b64_tr_b16 %0, %1 offset:8192" : "=&v"(bl) : "v"(ko) : "memory");
            asm volatile("ds_read_b64_tr_b16 %0, %1 offset:9216" : "=&v"(bh) : "v"(ko) : "memory");
            asm volatile("s_waitcnt lgkmcnt(0)" ::: "memory"); SBAR();
            const bf16x8 vf = (bf16x8){vl[0], vl[1], vl[2], vl[3], vh[0], vh[1], vh[2], vh[3]};
            const bf16x8 kf = (bf16x8){fl[0], fl[1], fl[2], fl[3], fh[0], fh[1], fh[2], fh[3]};
            const bf16x8 kb = (bf16x8){bl[0], bl[1], bl[2], bl[3], bh[0], bh[1], bh[2], bh[3]};
            accf = __builtin_amdgcn_mfma_f32_32x32x16_bf16(kf, vf, accf, 0, 0, 0);
            accb = __builtin_amdgcn_mfma_f32_32x32x16_bf16(kb, vf, accb, 0, 0, 0);
        }
    }
#pragma unroll
    for (int r = 0; r < 16; ++r) { const int d = 32 * dblk + crow(r, hi), e = 32 * eblk + r32;
        Sf[d * 128 + e] = accf[r]; Sb[d * 128 + e] = accb[r]; }
    __syncthreads();
}
__device__ __forceinline__ void out_unit(const bf16* __restrict__ Qc, const bf16* __restrict__ Kc, const bf16* __restrict__ Vc, const float* __restrict__ ST, int c,
                                         const bf16* __restrict__ RGc, const float* __restrict__ gnorm, bf16* __restrict__ MIXc, float lgf2, float lgb2, char* lds) {
    int tid = threadIdx.x; asm volatile("" : "+v"(tid));
    const int wid = tid >> 6, lane = tid & 63, r32 = lane & 31, hi = lane >> 5;
    const int sr = tid >> 4, sc = (tid & 15) * 8, vst0 = v_st(sr, sc), vst1 = v_st(32 + sr, sc);
    const int kr = tid >> 3, kc = (tid & 7) * 8, kst = KSWZ64(kr, kc * 2);
#pragma unroll
    for (int t = 0; t < 4; ++t) {
        const bf16x8 a0 = *reinterpret_cast<const bf16x8*>(Vc + (size_t)(64 * t + sr) * 128 + sc), a1 = *reinterpret_cast<const bf16x8*>(Vc + (size_t)(64 * t + 32 + sr) * 128 + sc);
        const bf16x8 k0 = *reinterpret_cast<const bf16x8*>(Kc + (size_t)(64 * t + kr) * 64 + kc);
        *(bf16x8*)(lds + 32768 + t * 16384 + vst0) = a0; *(bf16x8*)(lds + 32768 + t * 16384 + vst1) = a1;
        *(bf16x8*)(lds + t * 8192 + kst) = k0;
    }
    {
        float rf[2][8], rb[2][8];
#pragma unroll
        for (int q = 0; q < 2; ++q)
#pragma unroll
            for (int j = 0; j < 8; ++j) { rf[q][j] = 0.f; rb[q][j] = 0.f; }
        for (int g3 = 0; g3 < 9; g3 += 3) {
            f32x4 sv[3][2][2]; float wf[3], wb[3];
#pragma unroll
            for (int u = 0; u < 3; ++u) { const int cp = g3 + u; const bool fwd = cp < c;
                const float wgt = cp == c ? 0.f : (fwd ? __builtin_amdgcn_exp2f((float)(256 * (c - 1 - cp)) * lgf2) : __builtin_amdgcn_exp2f((float)(256 * (cp - c - 1)) * lgb2));
                wf[u] = fwd ? wgt : 0.f; wb[u] = fwd ? 0.f : wgt;
                const float* S = ST + ((size_t)cp * 2 + (fwd ? 0 : 1)) * 8192;
#pragma unroll
                for (int q = 0; q < 2; ++q) { sv[u][q][0] = *(const f32x4*)(S + (sr + 32 * q) * 128 + sc); sv[u][q][1] = *(const f32x4*)(S + (sr + 32 * q) * 128 + sc + 4); } }
#pragma unroll
            for (int u = 0; u < 3; ++u)
#pragma unroll
                for (int q = 0; q < 2; ++q)
#pragma unroll
                    for (int j = 0; j < 8; ++j) { const float v = sv[u][q][j >> 2][j & 3]; rf[q][j] += wf[u] * v; rb[q][j] += wb[u] * v; }
        }
        {
            const float wgt = __builtin_amdgcn_exp2f((float)(256 * (8 - c)) * lgb2);
            const float* S = ST + 8192;
#pragma unroll
            for (int q = 0; q < 2; ++q) { const f32x4 s0 = *(const f32x4*)(S + (sr + 32 * q) * 128 + sc), s1 = *(const f32x4*)(S + (sr + 32 * q) * 128 + sc + 4);
                rb[q][0] += wgt * s0.x; rb[q][1] += wgt * s0.y; rb[q][2] += wgt * s0.z; rb[q][3] += wgt * s0.w; rb[q][4] += wgt * s1.x; rb[q][5] += wgt * s1.y; rb[q][6] += wgt * s1.z; rb[q][7] += wgt * s1.w; }
        }
#pragma unroll
        for (int q = 0; q < 2; ++q) {
            v4u of, ob;
            of.x = pk2(rf[q][0], rf[q][1]); of.y = pk2(rf[q][2], rf[q][3]); of.z = pk2(rf[q][4], rf[q][5]); of.w = pk2(rf[q][6], rf[q][7]);
            ob.x = pk2(rb[q][0], rb[q][1]); ob.y = pk2(rb[q][2], rb[q][3]); ob.z = pk2(rb[q][4], rb[q][5]); ob.w = pk2(rb[q][6], rb[q][7]);
            *(v4u*)(lds + 98304 + (q ? vst1 : vst0)) = of; *(v4u*)(lds + 114688 + (q ? vst1 : vst0)) = ob;
        }
    }
    bf16x8 qr[4];
    const bf16* Qw = Qc + (long)(wid * 32 + r32) * 64 + hi * 8;
#pragma unroll
    for (int d0 = 0; d0 < 4; ++d0) qr[d0] = *reinterpret_cast<const bf16x8*>(Qw + d0 * 16);
    __syncthreads();
    const int i = wid * 32 + r32;
    f32x16 o[4] = {};
    const int vb0 = (int)(uintptr_t)lds + v_rd_base(lane);
#pragma unroll 1
    for (int t = 0; t < 4; ++t) {
        f32x16 p0, p1;
        qkt(p0, p1, lds + t * 8192, qr, r32, hi);
        const float fi = (float)(i - 64 * t - 4 * hi);
#pragma unroll
        for (int r = 0; r < 16; ++r) {
            const float d0 = fi - (float)((r & 3) + 8 * (r >> 2)), d1 = d0 - 32.f;
            const float x0 = d0 >= 0.f ? d0 * lgf2 : -d0 * lgb2, x1 = d1 >= 0.f ? d1 * lgf2 : -d1 * lgb2;
            p0[r] *= __builtin_amdgcn_exp2f(x0); p1[r] *= __builtin_amdgcn_exp2f(x1);
        }
        bf16x8 pa0, pa1, pa2, pa3;
#define PK4(P, BASE, OUT) do { unsigned a0 = cvtpk(P[BASE + 0], P[BASE + 1]), a1 = cvtpk(P[BASE + 2], P[BASE + 3]);   \
    unsigned b0 = cvtpk(P[BASE + 4], P[BASE + 5]), b1 = cvtpk(P[BASE + 6], P[BASE + 7]);                              \
    auto r0 = __builtin_amdgcn_permlane32_swap(a0, b0, false, false); auto r1 = __builtin_amdgcn_permlane32_swap(a1, b1, false, false); \
    v4u w = {r0[0], r1[0], r0[1], r1[1]}; OUT = *reinterpret_cast<bf16x8*>(&w); } while (0)
        PK4(p0, 0, pa0); PK4(p0, 8, pa1); PK4(p1, 0, pa2); PK4(p1, 8, pa3);
#undef PK4
        SBAR();
        pv_d0(o, vb0 + 32768 + t * 16384, pa0, pa1, pa2, pa3);
    }
    {
        const float af = __builtin_amdgcn_exp2f((float)(i + 1) * lgf2), ab = __builtin_amdgcn_exp2f((float)(256 - i) * lgb2);
        SBAR();
        pv_d0(o, vb0 + 98304, scale8(qr[0], af), scale8(qr[1], af), scale8(qr[2], af), scale8(qr[3], af));
        pv_d0(o, vb0 + 114688, scale8(qr[0], ab), scale8(qr[1], ab), scale8(qr[2], ab), scale8(qr[3], ab));
    }
    __syncthreads();
    {
        float* stg = (float*)(lds + wid * 16384);
#pragma unroll
        for (int r = 0; r < 16; ++r) { const int orow = crow(r, hi);
#pragma unroll
            for (int d0 = 0; d0 < 4; ++d0) stg[orow * 128 + d0 * 32 + r32] = o[d0][r]; }
        const int c0 = (lane & 15) * 8, rq = lane >> 4;
        v4u gv[8];
#pragma unroll
        for (int i = 0; i < 8; ++i) gv[i] = *(const v4u*)(RGc + (size_t)(wid * 32 + i * 4 + rq) * 512 + c0);
        const f32x4 gn0 = *(const f32x4*)(gnorm + c0), gn1 = *(const f32x4*)(gnorm + c0 + 4);
        asm volatile("s_waitcnt lgkmcnt(0)" ::: "memory");
#pragma unroll
        for (int i = 0; i < 8; ++i) { const int row = i * 4 + rq;
            const f32x4 y0 = *(const f32x4*)(stg + row * 128 + c0), y1 = *(const f32x4*)(stg + row * 128 + c0 + 4);
            float ss = (y0.x * y0.x + y0.y * y0.y) + (y0.z * y0.z + y0.w * y0.w) + (y1.x * y1.x + y1.y * y1.y) + (y1.z * y1.z + y1.w * y1.w);
            ss += __int_as_float(__builtin_amdgcn_update_dpp(0, __float_as_int(ss), 0xB1, 0xf, 0xf, true));
            ss += __int_as_float(__builtin_amdgcn_update_dpp(0, __float_as_int(ss), 0x4E, 0xf, 0xf, true));
            ss += __int_as_float(__builtin_amdgcn_update_dpp(0, __float_as_int(ss), 0x141, 0xf, 0xf, true));
            ss += __int_as_float(__builtin_amdgcn_update_dpp(0, __float_as_int(ss), 0x140, 0xf, 0xf, true));
            const float rstd = rsqrtf(ss * (1.f / 128.f) + 1e-6f);
            float yv[8] = {y0.x, y0.y, y0.z, y0.w, y1.x, y1.y, y1.z, y1.w}; const float gnv[8] = {gn0.x, gn0.y, gn0.z, gn0.w, gn1.x, gn1.y, gn1.z, gn1.w};
            v4u ov;
#pragma unroll
            for (int j = 0; j < 4; ++j) { const float ga = __builtin_bit_cast(float, gv[i][j] << 16), gb = __builtin_bit_cast(float, gv[i][j] & 0xffff0000u);
                const float sa = ga * __builtin_amdgcn_rcpf(1.f + __expf(-ga)), sb = gb * __builtin_amdgcn_rcpf(1.f + __expf(-gb));
                ov[j] = pk2(yv[2 * j] * rstd * gnv[2 * j] * sa, yv[2 * j + 1] * rstd * gnv[2 * j + 1] * sb); }
            *(v4u*)(MIXc + (size_t)(wid * 32 + row) * 1024 + c0) = ov;
        }
    }
    __syncthreads();
}
#undef SBAR
}
namespace peer {
#ifndef PEER_DOT2
#define PEER_DOT2 0
#endif
using att::crow;
typedef __bf16 bf16x2_t __attribute__((ext_vector_type(2)));
__device__ __forceinline__ unsigned fkey(float f) { const unsigned u = __float_as_uint(f); return u ^ ((unsigned)((int)u >> 31) | 0x80000000u); }
__device__ __forceinline__ float kval(unsigned k) { const unsigned u = (k & 0x80000000u) ? (k ^ 0x80000000u) : ~k; return __uint_as_float(u); }
__device__ __forceinline__ unsigned kmax(unsigned a, unsigned b) { return __float_as_uint(__builtin_fmaxf(__uint_as_float(a), __uint_as_float(b))); }
__device__ __forceinline__ unsigned kmin(unsigned a, unsigned b) { return __float_as_uint(__builtin_fminf(__uint_as_float(a), __uint_as_float(b))); }
constexpr unsigned KEY_NEG_INF = 0xff800000u;
#define KSWZ256(row, colB) ((row) * 256 + ((colB) ^ (((row) & 7) << 4)))
template <int N> __device__ __forceinline__ void bitonic_sort_desc(unsigned (&a)[N]) {
#pragma unroll
    for (int k = 2; k <= N; k <<= 1)
#pragma unroll
        for (int j = k >> 1; j > 0; j >>= 1)
#pragma unroll
            for (int i = 0; i < N; ++i) { const int l = i ^ j;
                if (l > i) { const bool desc = (i & k) == 0; const unsigned mx = kmax(a[i], a[l]), mn = kmin(a[i], a[l]); a[i] = desc ? mx : mn; a[l] = desc ? mn : mx; } }
}
template <int N> __device__ __forceinline__ void bitonic_merge_desc(unsigned (&a)[N]) {
#pragma unroll
    for (int j = N >> 1; j > 0; j >>= 1)
#pragma unroll
        for (int i = 0; i < N; ++i) { const int l = i ^ j;
            if (l > i) { const unsigned mx = kmax(a[i], a[l]), mn = kmin(a[i], a[l]); a[i] = mx; a[l] = mn; } }
}
__device__ __forceinline__ void sort16_desc(unsigned (&a)[16]) {
#define PEER_CE(i, j) do { const unsigned mx_ = kmax(a[i], a[j]), mn_ = kmin(a[i], a[j]); a[i] = mx_; a[j] = mn_; } while (0)
    PEER_CE(0, 13); PEER_CE(1, 12); PEER_CE(2, 15); PEER_CE(3, 14); PEER_CE(4, 8); PEER_CE(5, 6); PEER_CE(7, 11); PEER_CE(9, 10);
    PEER_CE(0, 5); PEER_CE(1, 7); PEER_CE(2, 9); PEER_CE(3, 4); PEER_CE(6, 13); PEER_CE(8, 14); PEER_CE(10, 15); PEER_CE(11, 12);
    PEER_CE(0, 1); PEER_CE(2, 3); PEER_CE(4, 5); PEER_CE(6, 8); PEER_CE(7, 9); PEER_CE(10, 11); PEER_CE(12, 13); PEER_CE(14, 15);
    PEER_CE(0, 2); PEER_CE(1, 3); PEER_CE(4, 10); PEER_CE(5, 11); PEER_CE(6, 7); PEER_CE(8, 9); PEER_CE(12, 14); PEER_CE(13, 15);
    PEER_CE(1, 2); PEER_CE(3, 12); PEER_CE(4, 6); PEER_CE(5, 7); PEER_CE(8, 10); PEER_CE(9, 11); PEER_CE(13, 14);
    PEER_CE(1, 4); PEER_CE(2, 6); PEER_CE(5, 8); PEER_CE(7, 10); PEER_CE(9, 13); PEER_CE(11, 14);
    PEER_CE(2, 4); PEER_CE(3, 6); PEER_CE(9, 12); PEER_CE(11, 13);
    PEER_CE(3, 5); PEER_CE(6, 8); PEER_CE(7, 9); PEER_CE(10, 12);
    PEER_CE(3, 4); PEER_CE(5, 6); PEER_CE(7, 8); PEER_CE(9, 10); PEER_CE(11, 12);
    PEER_CE(6, 7); PEER_CE(8, 9);
#undef PEER_CE
}
__device__ __forceinline__ void merge_top16(unsigned (&Lst)[16], const unsigned (&S)[16]) {
#pragma unroll
    for (int i = 0; i < 16; ++i) Lst[i] = kmax(Lst[i], S[15 - i]);
    bitonic_merge_desc<16>(Lst);
}
__device__ __forceinline__ float max8_dpp(float a) {
    a = fmaxf(a, __int_as_float(__builtin_amdgcn_update_dpp(0, __float_as_int(a), 0xB1, 0xf, 0xf, true)));
    a = fmaxf(a, __int_as_float(__builtin_amdgcn_update_dpp(0, __float_as_int(a), 0x4E, 0xf, 0xf, true)));
    a = fmaxf(a, __int_as_float(__builtin_amdgcn_update_dpp(0, __float_as_int(a), 0x141, 0xf, 0xf, true)));
    return a;
}
__device__ __forceinline__ void quant_h2_wave(int t0w, int c, const bf16* __restrict__ x1a, const float* __restrict__ ssq, const float* __restrict__ mod,
                                              unsigned char* __restrict__ HQ, float* __restrict__ HS, int lane) {
    const int s = lane & 7, k0 = 256 * c + 32 * s;
#pragma unroll
    for (int pass = 0; pass < 2; ++pass) {
        const int t = t0w + pass * 8 + (lane >> 3), b = t >> 11;
        const f32x4 s0 = *(const f32x4*)(ssq + (size_t)t * 16), s1 = *(const f32x4*)(ssq + (size_t)t * 16 + 4), s2 = *(const f32x4*)(ssq + (size_t)t * 16 + 8), s3 = *(const f32x4*)(ssq + (size_t)t * 16 + 12);
        const float tot = ((s0.x + s0.y) + (s0.z + s0.w)) + ((s1.x + s1.y) + (s1.z + s1.w)) + ((s2.x + s2.y) + (s2.z + s2.w)) + ((s3.x + s3.y) + (s3.z + s3.w));
        const float rstd = rsqrtf(tot * (1.f / 1024.f) + 1e-6f);
        const float* be = mod + (size_t)b * 6144 + 3 * 1024 + k0;
        f32x4 hv[8]; float am = 0.f;
#pragma unroll
        for (int u = 0; u < 4; ++u) { const v4u xa = *(const v4u*)(x1a + (size_t)t * 1024 + k0 + 8 * u);
#pragma unroll
            for (int hh = 0; hh < 2; ++hh) { const unsigned w0 = xa[2 * hh], w1 = xa[2 * hh + 1];
                const f32x4 xv = {__builtin_bit_cast(float, w0 << 16), __builtin_bit_cast(float, w0 & 0xffff0000u), __builtin_bit_cast(float, w1 << 16), __builtin_bit_cast(float, w1 & 0xffff0000u)};
                const f32x4 h = xv * rstd + *(const f32x4*)(be + 8 * u + 4 * hh); hv[2 * u + hh] = h;
                am = fmaxf(am, fmaxf(fmaxf(fabsf(h.x), fabsf(h.y)), fmaxf(fabsf(h.z), fabsf(h.w)))); } }
        am = max8_dpp(am);
        const float sc = am > 0.f ? 119.f / am : 0.f;
        v4u oa, ob;
#pragma unroll
        for (int k = 0; k < 4; ++k) { unsigned wa = 0u, wb = 0u;
#pragma unroll
            for (int i = 0; i < 8; ++i) { const float f = (i < 4) ? hv[2 * k][i] : hv[2 * k + 1][i - 4]; const int q = (int)rintf(f * sc); const int ahi = (q + 8) >> 4, blo = q - 16 * ahi;
                wa |= ((unsigned)ahi & 15u) << (4 * i); wb |= ((unsigned)blo & 15u) << (4 * i); }
            oa[k] = wa; ob[k] = wb; }
        unsigned char* dst = HQ + ((size_t)c * 16384 + t) * 256 + 32 * s;
        *(v4u*)dst = oa; *(v4u*)(dst + 16) = ob;
        if (s == 0) HS[(size_t)c * 16384 + t] = am * (1.f / 119.f);
    }
}
__device__ __forceinline__ void topk_p_lds(const bf16* __restrict__ skf, const char* qlds, int r32, int hi, unsigned (&Lst)[16]) {
    bf16x8 bq[8];
#pragma unroll
    for (int ks = 0; ks < 8; ++ks) bq[ks] = *reinterpret_cast<const bf16x8*>(qlds + ((2 * ks + hi) * 32 + r32) * 16);
#pragma unroll
    for (int kb = 0; kb < 4; ++kb) {
        bf16x8 a[8];
#pragma unroll
        for (int ks = 0; ks < 8; ++ks) a[ks] = *reinterpret_cast<const bf16x8*>(skf + (size_t)((((kb * 8 + ks) * 2 + hi) * 32 + r32) * 8));
        f32x16 acc = {};
#pragma unroll
        for (int ks = 0; ks < 8; ++ks) acc = __builtin_amdgcn_mfma_f32_32x32x16_bf16(a[ks], bq[ks], acc, 0, 0, 0);
        unsigned S[16];
#pragma unroll
        for (int r = 0; r < 16; ++r) S[r] = (__float_as_uint(acc[r]) & ~127u) | (unsigned)(32 * kb + crow(r, hi));
        sort16_desc(S);
        if (kb == 0) {
#pragma unroll
            for (int r = 0; r < 16; ++r) Lst[r] = S[r];
        } else merge_top16(Lst, S);
    }
    unsigned Y[16];
#pragma unroll
    for (int s = 0; s < 16; ++s) { auto rr = __builtin_amdgcn_permlane32_swap(Lst[s], Lst[s], false, false); Y[s] = hi ? rr[0] : rr[1]; }
    merge_top16(Lst, Y);
}
__device__ __forceinline__ void select_wave_lds(const bf16* __restrict__ skf_h, char* qtile, int h, int* __restrict__ pidx, float* __restrict__ pgate, int wid, int lane) {
    const int r32 = lane & 31, hi = lane >> 5;
    unsigned T0[16], T1[16];
    topk_p_lds(skf_h, qtile + (wid * 2 + 0) * 8192, r32, hi, T0);
    topk_p_lds(skf_h + 4 * 8 * 2 * 32 * 8, qtile + (wid * 2 + 1) * 8192, r32, hi, T1);
    asm volatile("s_waitcnt lgkmcnt(0)" ::: "memory");
    unsigned short* tab = (unsigned short*)(qtile + wid * 16384) + lane;
    unsigned C[16], R1[16], X[32];
#define PEER_CAND(a, b, cid, dst) do { const float sum_ = __uint_as_float(T0[a] & ~127u) + __uint_as_float(T1[b] & ~127u); dst = (__float_as_uint(sum_) & ~63u) | (unsigned)(cid); \
        tab[(cid) * 64] = (unsigned short)((T0[a] & 127u) * 128u + (T1[b] & 127u)); } while (0)
#pragma unroll
    for (int b = 0; b < 16; ++b) PEER_CAND(0, b, 15 - b, C[b]);
#pragma unroll
    for (int b = 0; b < 16; ++b) { if (b < 8) PEER_CAND(1, b, 23 - b, R1[b]); else R1[b] = KEY_NEG_INF; }
    {   int xi = 0;
#pragma unroll
        for (int a = 2; a < 16; ++a)
#pragma unroll
            for (int b = 0; b < 16; ++b) if ((a + 1) * (b + 1) <= 16) { PEER_CAND(a, b, 24 + xi, X[xi]); ++xi; }
#pragma unroll
        for (int q = 26; q < 32; ++q) X[q] = KEY_NEG_INF;
    }
#undef PEER_CAND
    merge_top16(C, R1);
    {   unsigned X16[16], Xb[16];
#pragma unroll
        for (int q = 0; q < 16; ++q) { X16[q] = X[q]; Xb[q] = X[16 + q]; }
        sort16_desc(X16); sort16_desc(Xb);
        merge_top16(X16, Xb);
        merge_top16(C, X16); }
    asm volatile("s_waitcnt lgkmcnt(0)" ::: "memory");
    float v[16]; float sum = 0.f; const float mx = __uint_as_float(C[0] & ~63u);
#pragma unroll
    for (int s = 0; s < 16; ++s) { v[s] = __expf(__uint_as_float(C[s] & ~63u) - mx); sum += v[s]; }
    const float inv = 1.f / sum;
    int ex[16];
#pragma unroll
    for (int s = 0; s < 16; ++s) ex[s] = (int)tab[(C[s] & 63u) * 64];
    if (hi == 0) {
        int* pi = pidx + (size_t)(wid * 32 + r32) * 128 + h * 16; float* pg = pgate + (size_t)(wid * 32 + r32) * 128 + h * 16;
#pragma unroll
        for (int s = 0; s < 16; s += 4) { *(int4*)(pi + s) = make_int4(ex[s], ex[s + 1], ex[s + 2], ex[s + 3]); *(f32x4*)(pg + s) = (f32x4){v[s] * inv, v[s + 1] * inv, v[s + 2] * inv, v[s + 3] * inv}; }
    }
}
__device__ __forceinline__ void cvt_row_fp8(const float* __restrict__ src, unsigned char* __restrict__ T8, float* __restrict__ inv_scale, int e, int lane) {
    f32x4 v[4]; float am = 0.f;
#pragma unroll
    for (int j = 0; j < 4; ++j) { v[j] = *(const f32x4*)(src + (size_t)e * 1024 + 16 * lane + 4 * j);
        am = fmaxf(am, fmaxf(fmaxf(fabsf(v[j].x), fabsf(v[j].y)), fmaxf(fabsf(v[j].z), fabsf(v[j].w)))); }
#pragma unroll
    for (int o = 1; o < 64; o <<= 1) am = fmaxf(am, __shfl_xor(am, o));
    const int ex = (int)((__float_as_uint(am) >> 23) & 0xffu) - 127;
    const int k = (am > 0.f) ? (7 - ex) : 0;
    const int kc = k > 120 ? 120 : (k < -120 ? -120 : k);
    const float sc = __uint_as_float((unsigned)(127 + kc) << 23), isc = __uint_as_float((unsigned)(127 - kc) << 23);
    v4u o;
#pragma unroll
    for (int j = 0; j < 4; ++j) { int pk = 0;
        pk = __builtin_amdgcn_cvt_pk_fp8_f32(v[j].x * sc, v[j].y * sc, pk, false); pk = __builtin_amdgcn_cvt_pk_fp8_f32(v[j].z * sc, v[j].w * sc, pk, true); o[j] = (unsigned)pk; }
    *(v4u*)(T8 + ((size_t)(lane >> 3) * 16384 + e) * 128 + 16 * (lane & 7)) = o;
    if (lane == 0) inv_scale[e] = isc;
}
__device__ __forceinline__ unsigned fp4_code(float y) { const int q = (int)rintf(y); return (unsigned)q & 15u; }
__device__ __forceinline__ unsigned spread4(unsigned h16) { unsigned y = h16 & 0xffffu; y = (y | (y << 8)) & 0x00ff00ffu; y = (y | (y << 4)) & 0x0f0f0f0fu; return y; }
__device__ __forceinline__ void cvt_row_fp4(const float* __restrict__ src, unsigned char* __restrict__ T4, float* __restrict__ inv_scale, int e, int lane) {
    f32x4 v[4]; float am = 0.f;
#pragma unroll
    for (int j = 0; j < 4; ++j) { v[j] = *(const f32x4*)(src + (size_t)e * 1024 + 16 * lane + 4 * j);
        am = fmaxf(am, fmaxf(fmaxf(fabsf(v[j].x), fabsf(v[j].y)), fmaxf(fabsf(v[j].z), fabsf(v[j].w)))); }
#pragma unroll
    for (int o = 1; o < 64; o <<= 1) am = fmaxf(am, __shfl_xor(am, o));
    const float sc = am > 0.f ? 7.f / am : 0.f;
    unsigned n0 = 0u, n1 = 0u;
#pragma unroll
    for (int i = 0; i < 8; ++i) { n0 |= fp4_code(v[i >> 2][i & 3] * sc) << (4 * i); n1 |= fp4_code(v[2 + (i >> 2)][i & 3] * sc) << (4 * i); }
    const unsigned p0 = (unsigned)__builtin_amdgcn_update_dpp(0, (int)n0, 0xB1, 0xf, 0xf, true), p1 = (unsigned)__builtin_amdgcn_update_dpp(0, (int)n1, 0xB1, 0xf, 0xf, true);
    if ((lane & 1) == 0) {
        v4u o;
        o.x = spread4(n0) | (spread4(p0) << 4); o.y = spread4(n0 >> 16) | (spread4(p0 >> 16) << 4);
        o.z = spread4(n1) | (spread4(p1) << 4); o.w = spread4(n1 >> 16) | (spread4(p1 >> 16) << 4);
        *(v4u*)(T4 + ((size_t)(lane >> 4) * 16384 + e) * 128 + 16 * ((lane & 15) >> 1)) = o;
    }
    if (lane == 0) inv_scale[e] = am * (1.f / (7.f * 16.f));
}
__device__ __forceinline__ void cvt_row_i4(const float* __restrict__ src, unsigned char* __restrict__ T4, float* __restrict__ inv_scale, int e, int lane) {
    f32x4 v[4]; float am = 0.f;
#pragma unroll
    for (int j = 0; j < 4; ++j) { v[j] = *(const f32x4*)(src + (size_t)e * 1024 + 16 * lane + 4 * j);
        am = fmaxf(am, fmaxf(fmaxf(fabsf(v[j].x), fabsf(v[j].y)), fmaxf(fabsf(v[j].z), fabsf(v[j].w)))); }
#pragma unroll
    for (int o = 1; o < 64; o <<= 1) am = fmaxf(am, __shfl_xor(am, o));
    const float sc = am > 0.f ? 7.f / am : 0.f;
    v2u o;
#pragma unroll
    for (int k = 0; k < 2; ++k) { unsigned w = 0u;
#pragma unroll
        for (int i = 0; i < 8; ++i) { const int q = (int)rintf(v[2 * k + (i >> 2)][i & 3] * sc); w |= ((unsigned)q & 15u) << (4 * i); }
        o[k] = w; }
    *(v2u*)(T4 + ((size_t)(lane >> 4) * 16384 + e) * 128 + 8 * (lane & 15)) = o;
    if (lane == 0) inv_scale[e] = am * (1.f / 7.f);
}
__device__ __forceinline__ int sum8_dpp_i(int a) {
    a += __builtin_amdgcn_update_dpp(0, a, 0xB1, 0xf, 0xf, true);
    a += __builtin_amdgcn_update_dpp(0, a, 0x4E, 0xf, 0xf, true);
    a += __builtin_amdgcn_update_dpp(0, a, 0x141, 0xf, 0xf, true);
    return a;
}
__device__ __forceinline__ float gelu_exact(float x) { return 0.5f * x * (1.f + erff(x * 0.70710678118654752f)); }
struct Rows { v4u v[16]; };
__device__ __forceinline__ void issue_rows(Rows& R, const unsigned short* __restrict__ idxrow, const unsigned char* __restrict__ base  , unsigned loff  , int r) {
#pragma unroll
    for (int i = 0; i < 16; ++i) { const unsigned e = idxrow[8 * i + r]; R.v[i] = *(const v4u*)(base + (e * 128u + loff)); }
}
__device__ __forceinline__ float sum8_dpp(float a) {
    a += __int_as_float(__builtin_amdgcn_update_dpp(0, __float_as_int(a), 0xB1, 0xf, 0xf, true));
    a += __int_as_float(__builtin_amdgcn_update_dpp(0, __float_as_int(a), 0x4E, 0xf, 0xf, true));
    a += __int_as_float(__builtin_amdgcn_update_dpp(0, __float_as_int(a), 0x141, 0xf, 0xf, true));
    return a;
}
__device__ __forceinline__ float xor8_dpp(float a) { return __int_as_float(__builtin_amdgcn_update_dpp(0, __float_as_int(a), 0x128, 0xf, 0xf, true)); }
typedef float f32x2 __attribute__((ext_vector_type(2)));
typedef _Float16 f16x2 __attribute__((ext_vector_type(2)));
__device__ __forceinline__ void dec16p(const v4u raw, f32x2 (&f)[8]) {
#pragma unroll
    for (int j = 0; j < 4; ++j) { f[2 * j] = __builtin_amdgcn_cvt_pk_f32_fp8((int)raw[j], false); f[2 * j + 1] = __builtin_amdgcn_cvt_pk_f32_fp8((int)raw[j], true); }
}
template <int OFF = 65536>
__device__ __forceinline__ void stage_idx(const int* __restrict__ pidx, int t0, char* lds, int tid) {
#pragma unroll
    for (int k = 0; k < 8; ++k) { const int q = tid + 512 * k;
        const int4 v = *(const int4*)(pidx + (size_t)t0 * 128 + (size_t)q * 4);
        v2u o; o.x = (unsigned)v.x | ((unsigned)v.y << 16); o.y = (unsigned)v.z | ((unsigned)v.w << 16);
        *(v2u*)(lds + OFF + q * 8) = o; }
}
__device__ __forceinline__ int reduce8_i(const int (&v)[8], int s) {
    const bool b2 = (s & 4) != 0, b1 = (s & 2) != 0, b0 = (s & 1) != 0;
    int q4[4], q2[2];
#pragma unroll
    for (int k = 0; k < 4; ++k) { const int keep = b2 ? v[k + 4] : v[k], send = b2 ? v[k] : v[k + 4]; q4[k] = keep + __builtin_amdgcn_update_dpp(0, send, 0x141, 0xf, 0xf, true); }
#pragma unroll
    for (int k = 0; k < 2; ++k) { const int keep = b1 ? q4[k + 2] : q4[k], send = b1 ? q4[k] : q4[k + 2]; q2[k] = keep + __builtin_amdgcn_update_dpp(0, send, 0x4E, 0xf, 0xf, true); }
    const int keep = b0 ? q2[1] : q2[0], send = b0 ? q2[0] : q2[1];
    return keep + __builtin_amdgcn_update_dpp(0, send, 0xB1, 0xf, 0xf, true);
}
__device__ __forceinline__ void gatherA_stream(int c, int tile0, int tstep, int ntiles, const unsigned char* __restrict__ HQ,
                                               const int* __restrict__ pidx, const unsigned char* __restrict__ UT4, bf16* __restrict__ part, char* lds) {
    int tid = threadIdx.x; asm volatile("" : "+v"(tid));
    const int wid = tid >> 6, lane = tid & 63, r = lane >> 3, s = lane & 7;
    const int N = ntiles * 16;
    if (N <= 0) return;
    const unsigned char* base = UT4 + (size_t)c * 16384 * 128; const unsigned loff = 16u * (unsigned)s, l4 = 4u * (unsigned)lane;
    const unsigned char* hqc = HQ + (size_t)c * 16384 * 256; const unsigned char* pib = (const unsigned char*)pidx;
    bf16* partc = part + (size_t)c * 16384 * 128 + 8 * s + r;
    LAS unsigned char* ring = (LAS unsigned char*)lds + wid * 16384;
    LAS unsigned char* meta = (LAS unsigned char*)lds + 132096 + wid * 1536;
#define PEER_TOK(n) ((tile0 + ((n) >> 4) * tstep) * 128 + wid * 16 + ((n) & 15))
#define PEER_ISSUE_H(n) do { const unsigned t_ = (unsigned)PEER_TOK(n); \
        __builtin_amdgcn_global_load_lds((const unsigned*)(hqc + (t_ * 256u + l4)), (LAS unsigned*)(meta + ((n) & 1) * 256), 4, 0, 0); } while (0)
#define PEER_ISSUE_I(n) do { const unsigned t_ = (unsigned)PEER_TOK(n); \
        __builtin_amdgcn_global_load_lds((const unsigned*)(pib + (t_ * 512u + l4)), (LAS unsigned*)(meta + 512 + ((n) & 1) * 512), 4, 0, 0); \
        __builtin_amdgcn_global_load_lds((const unsigned*)(pib + (t_ * 512u + 256u + l4)), (LAS unsigned*)(meta + 512 + ((n) & 1) * 512 + 256), 4, 0, 0); } while (0)
#define PEER_LOAD_IDX(n) do { _Pragma("unroll") for (int i_ = 0; i_ < 16; ++i_) idxv[i_] = *(const LAS unsigned*)(meta + 512 + ((n) & 1) * 512 + (8 * i_ + r) * 4); } while (0)
#define PEER_ISSUE_ROW(i) __builtin_amdgcn_global_load_lds((const unsigned*)(base + (idxv[i] * 128u + loff)), (LAS unsigned*)(ring + (i) * 1024), 16, 0, 0)
#define PEER_READ_ROW(i) (*(const LAS v4u*)(ring + (i) * 1024 + lane * 16))
#define PEER_DOT_A(rw, i) do { int a_ = __builtin_amdgcn_sdot8((int)rw[0], (int)ha[0], 0, false); \
        a_ = __builtin_amdgcn_sdot8((int)rw[1], (int)ha[1], a_, false); a_ = __builtin_amdgcn_sdot8((int)rw[2], (int)ha[2], a_, false); a_ = __builtin_amdgcn_sdot8((int)rw[3], (int)ha[3], a_, false); \
        int b_ = __builtin_amdgcn_sdot8((int)rw[0], (int)hb[0], a_ << 4, false);                   \
        b_ = __builtin_amdgcn_sdot8((int)rw[1], (int)hb[1], b_, false); b_ = __builtin_amdgcn_sdot8((int)rw[2], (int)hb[2], b_, false); b_ = __builtin_amdgcn_sdot8((int)rw[3], (int)hb[3], b_, false); \
        pr[(i) & 7] = b_; \
        if ((i) == 7) res0 = reduce8_i(pr, s); else if ((i) == 15) res1 = reduce8_i(pr, s); } while (0)
#define PEER_VMWAIT(N) asm volatile("s_waitcnt vmcnt(" #N ")" ::: "memory")
#define PEER_LOAD_H(n) do { ha = *(const LAS v4u*)(meta + ((n) & 1) * 256 + 32 * s); hb = *(const LAS v4u*)(meta + ((n) & 1) * 256 + 32 * s + 16); } while (0)
    unsigned idxv[16]; v4u ha, hb, rcur, rnext; int pr[8];
    PEER_ISSUE_H(0); PEER_ISSUE_I(0); PEER_ISSUE_I(N > 1 ? 1 : 0);
    PEER_VMWAIT(0);
    PEER_LOAD_IDX(0);
#pragma unroll
    for (int i = 0; i < 16; ++i) PEER_ISSUE_ROW(i);
    PEER_VMWAIT(15);
    rcur = PEER_READ_ROW(0);
#pragma unroll 1
    for (int n = 0; n < N - 1; ++n) {
        int res0 = 0, res1 = 0;
        PEER_LOAD_IDX(n + 1);
        PEER_ISSUE_H(n + 1); { const int n2 = n + 2 < N ? n + 2 : N - 1; PEER_ISSUE_I(n2); }
        PEER_LOAD_H(n);
#pragma unroll
        for (int i = 0; i < 16; ++i) {
            if (i < 15) PEER_VMWAIT(17); else PEER_VMWAIT(14);
            rnext = PEER_READ_ROW((i + 1) & 15);
            PEER_DOT_A(rcur, i);
            asm volatile("s_waitcnt lgkmcnt(1)" ::: "memory");
            PEER_ISSUE_ROW(i);
            rcur = rnext;
        }
        bf16* prow = partc + (size_t)PEER_TOK(n) * 128; prow[0] = (bf16)f2bf((float)res0); prow[64] = (bf16)f2bf((float)res1);
    }
    {   int res0 = 0, res1 = 0;
        PEER_LOAD_H(N - 1);
        PEER_VMWAIT(14); rnext = PEER_READ_ROW(1);  PEER_DOT_A(rcur, 0);  rcur = rnext;
        PEER_VMWAIT(13); rnext = PEER_READ_ROW(2);  PEER_DOT_A(rcur, 1);  rcur = rnext;
        PEER_VMWAIT(12); rnext = PEER_READ_ROW(3);  PEER_DOT_A(rcur, 2);  rcur = rnext;
        PEER_VMWAIT(11); rnext = PEER_READ_ROW(4);  PEER_DOT_A(rcur, 3);  rcur = rnext;
        PEER_VMWAIT(10); rnext = PEER_READ_ROW(5);  PEER_DOT_A(rcur, 4);  rcur = rnext;
        PEER_VMWAIT(9);  rnext = PEER_READ_ROW(6);  PEER_DOT_A(rcur, 5);  rcur = rnext;
        PEER_VMWAIT(8);  rnext = PEER_READ_ROW(7);  PEER_DOT_A(rcur, 6);  rcur = rnext;
        PEER_VMWAIT(7);  rnext = PEER_READ_ROW(8);  PEER_DOT_A(rcur, 7);  rcur = rnext;
        PEER_VMWAIT(6);  rnext = PEER_READ_ROW(9);  PEER_DOT_A(rcur, 8);  rcur = rnext;
        PEER_VMWAIT(5);  rnext = PEER_READ_ROW(10); PEER_DOT_A(rcur, 9);  rcur = rnext;
        PEER_VMWAIT(4);  rnext = PEER_READ_ROW(11); PEER_DOT_A(rcur, 10); rcur = rnext;
        PEER_VMWAIT(3);  rnext = PEER_READ_ROW(12); PEER_DOT_A(rcur, 11); rcur = rnext;
        PEER_VMWAIT(2);  rnext = PEER_READ_ROW(13); PEER_DOT_A(rcur, 12); rcur = rnext;
        PEER_VMWAIT(1);  rnext = PEER_READ_ROW(14); PEER_DOT_A(rcur, 13); rcur = rnext;
        PEER_VMWAIT(0);  rnext = PEER_READ_ROW(15); PEER_DOT_A(rcur, 14); rcur = rnext;
        PEER_DOT_A(rcur, 15);
        bf16* prow = partc + (size_t)PEER_TOK(N - 1) * 128; prow[0] = (bf16)f2bf((float)res0); prow[64] = (bf16)f2bf((float)res1);
    }
#undef PEER_TOK
#undef PEER_ISSUE_H
#undef PEER_ISSUE_I
#undef PEER_LOAD_IDX
#undef PEER_ISSUE_ROW
#undef PEER_READ_ROW
#undef PEER_DOT_A
#undef PEER_VMWAIT
#undef PEER_LOAD_H
}
__device__ __forceinline__ void gatherA_fused(int tok0, int cstart, const unsigned char* __restrict__ HQ, const float* __restrict__ HS, const int* __restrict__ pidx, const float* __restrict__ pgate, unsigned char* __restrict__ recs  ,
                                              const unsigned char* __restrict__ UT4, const float* __restrict__ SUs, const float* __restrict__ SVs, char* lds) {
    int tid = threadIdx.x; asm volatile("" : "+v"(tid));
    const int wid = tid >> 6, lane = tid & 63, r = lane >> 3, s = lane & 7;
    const int tw0 = tok0 + wid * 8;
    const unsigned loff = 16u * (unsigned)s, l4 = 4u * (unsigned)lane;
    const unsigned char* pib = (const unsigned char*)pidx;
    LAS unsigned char* ring = (LAS unsigned char*)lds + wid * 16384;
    LAS unsigned char* meta = (LAS unsigned char*)lds + 132096 + wid * 1552;
#define PEER_TOK(n) (tw0 + ((n) & 7))
#define PEER_CQ(n) ((cstart + ((n) >> 3)) & 3)
#define PEER_ISSUE_H(n) do { const unsigned t_ = (unsigned)PEER_TOK(n); const unsigned char* hqc_ = HQ + (size_t)PEER_CQ(n) * 16384 * 256; \
        __builtin_amdgcn_global_load_lds((const unsigned*)(hqc_ + (t_ * 256u + l4)), (LAS unsigned*)(meta + ((n) & 1) * 256), 4, 0, 0); } while (0)
#define PEER_ISSUE_S(n) do { const float* hs_ = HS + (size_t)PEER_CQ(n) * 16384 + PEER_TOK(n); \
        if (lane == 0) __builtin_amdgcn_global_load_lds((const unsigned*)hs_, (LAS unsigned*)(meta + 1536 + ((n) & 1) * 4), 4, 0, 0); } while (0)
#define PEER_ISSUE_I(n) do { const unsigned t_ = (unsigned)PEER_TOK(n); \
        __builtin_amdgcn_global_load_lds((const unsigned*)(pib + (t_ * 512u + l4)), (LAS unsigned*)(meta + 512 + ((n) & 1) * 512), 4, 0, 0); \
        __builtin_amdgcn_global_load_lds((const unsigned*)(pib + (t_ * 512u + 256u + l4)), (LAS unsigned*)(meta + 512 + ((n) & 1) * 512 + 256), 4, 0, 0); } while (0)
#define PEER_LOAD_IDX(n) do { _Pragma("unroll") for (int i_ = 0; i_ < 16; ++i_) idxv[i_] = *(const LAS unsigned*)(meta + 512 + ((n) & 1) * 512 + (8 * i_ + r) * 4); } while (0)
#define PEER_ISSUE_ROW(i) __builtin_amdgcn_global_load_lds((const unsigned*)(basen + (idxv[i] * 128u + loff)), (LAS unsigned*)(ring + (i) * 1024), 16, 0, 0)
#define PEER_READ_ROW(i) (*(const LAS v4u*)(ring + (i) * 1024 + lane * 16))
#define PEER_DOT_A(rw, i) do { int a_ = __builtin_amdgcn_sdot8((int)rw[0], (int)ha[0], 0, false); \
        a_ = __builtin_amdgcn_sdot8((int)rw[1], (int)ha[1], a_, false); a_ = __builtin_amdgcn_sdot8((int)rw[2], (int)ha[2], a_, false); a_ = __builtin_amdgcn_sdot8((int)rw[3], (int)ha[3], a_, false); \
        int b_ = __builtin_amdgcn_sdot8((int)rw[0], (int)hb[0], a_ << 4, false); \
        b_ = __builtin_amdgcn_sdot8((int)rw[1], (int)hb[1], b_, false); b_ = __builtin_amdgcn_sdot8((int)rw[2], (int)hb[2], b_, false); b_ = __builtin_amdgcn_sdot8((int)rw[3], (int)hb[3], b_, false); \
        pr[(i) & 7] = b_; \
        if ((i) == 7) res0 = reduce8_i(pr, s); else if ((i) == 15) res1 = reduce8_i(pr, s); } while (0)
#define PEER_VMWAIT(N) asm volatile("s_waitcnt vmcnt(" #N ")" ::: "memory")
#define PEER_LOAD_H(n) do { ha = *(const LAS v4u*)(meta + ((n) & 1) * 256 + 32 * s); hb = *(const LAS v4u*)(meta + ((n) & 1) * 256 + 32 * s + 16); } while (0)
    unsigned idxv[16]; v4u ha, hb, rcur, rnext; int pr[8]; float tot0[8], tot1[8];
#pragma unroll
    for (int k = 0; k < 8; ++k) { tot0[k] = 0.f; tot1[k] = 0.f; }
    const unsigned char* basen = UT4 + (size_t)PEER_CQ(0) * 16384 * 128;
    PEER_ISSUE_H(0); PEER_ISSUE_S(0); PEER_ISSUE_I(0); PEER_ISSUE_I(1);
    PEER_VMWAIT(0);
    PEER_LOAD_IDX(0);
#pragma unroll
    for (int i = 0; i < 16; ++i) PEER_ISSUE_ROW(i);
    PEER_VMWAIT(15);
    rcur = PEER_READ_ROW(0);
#pragma unroll 1
    for (int cqi = 0; cqi < 4; ++cqi) {
#pragma unroll
        for (int tk = 0; tk < 8; ++tk) {
            const int n = cqi * 8 + tk, n1 = n + 1 < 32 ? n + 1 : 31, n2 = n + 2 < 32 ? n + 2 : 31;
            int res0 = 0, res1 = 0;
            PEER_LOAD_IDX(tk + 1);
            basen = UT4 + (size_t)PEER_CQ(n1) * 16384 * 128;
            PEER_ISSUE_H(n1); PEER_ISSUE_I(n2); PEER_ISSUE_S(n1);
            PEER_LOAD_H(tk);
            const float hsv = *(const LAS float*)(meta + 1536 + (tk & 1) * 4);
#pragma unroll
            for (int i = 0; i < 16; ++i) {
                if (i < 15) PEER_VMWAIT(18); else PEER_VMWAIT(14);
                rnext = PEER_READ_ROW((i + 1) & 15);
                PEER_DOT_A(rcur, i);
                asm volatile("s_waitcnt lgkmcnt(1)" ::: "memory");
                PEER_ISSUE_ROW(i);
                rcur = rnext;
            }
            tot0[tk] = fmaf((float)res0, hsv, tot0[tk]); tot1[tk] = fmaf((float)res1, hsv, tot1[tk]);
        }
    }
    PEER_VMWAIT(0);
#undef PEER_TOK
#undef PEER_CQ
#undef PEER_ISSUE_H
#undef PEER_ISSUE_S
#undef PEER_ISSUE_I
#undef PEER_LOAD_IDX
#undef PEER_ISSUE_ROW
#undef PEER_READ_ROW
#undef PEER_DOT_A
#undef PEER_VMWAIT
#undef PEER_LOAD_H
    const int sA = 8 * s + r, sB = 64 + sA;
    int eA[8], eB[8]; float gA[8], gB[8];
#pragma unroll
    for (int k = 0; k < 8; ++k) { const size_t o = (size_t)(tw0 + k) * 128; eA[k] = pidx[o + sA]; eB[k] = pidx[o + sB]; gA[k] = pgate[o + sA]; gB[k] = pgate[o + sB]; }
    float wA[8], wB[8];
#pragma unroll
    for (int k = 0; k < 8; ++k) { wA[k] = gelu_exact(tot0[k] * SUs[eA[k]]) * gA[k] * SVs[eA[k]]; wB[k] = gelu_exact(tot1[k] * SUs[eB[k]]) * gB[k] * SVs[eB[k]]; }
#pragma unroll
    for (int k = 0; k < 8; ++k) {
        float am = fmaxf(fabsf(wA[k]), fabsf(wB[k]));
#pragma unroll
        for (int sh = 1; sh < 64; sh <<= 1) am = fmaxf(am, __shfl_xor(am, sh));
        const int ex = (int)((__float_as_uint(am) >> 23) & 0xffu) - 127;
        int kk = am > 0.f ? 6 - ex : 0; kk = kk > 100 ? 100 : (kk < -100 ? -100 : kk);
        const float S = __uint_as_float((unsigned)(127 + kk) << 23);
        const float a0 = wA[k] * S, a1 = wB[k] * S;
        const float h0 = fmaxf(fminf(rintf(a0), 127.f), -127.f), h1 = fmaxf(fminf(rintf(a1), 127.f), -127.f);
        const int l0 = (int)fmaxf(fminf(rintf((a0 - h0) * 128.f), 127.f), -127.f), l1 = (int)fmaxf(fminf(rintf((a1 - h1) * 128.f), 127.f), -127.f);
        const unsigned kb = (unsigned)(kk + 128);
        unsigned iA = (unsigned)eA[k], iB = (unsigned)eB[k];
        if (s == 0 && r < 4) iA |= ((kb >> (2 * r)) & 3u) << 14;
        unsigned char* row = recs + (size_t)(tw0 + k) * 512;
        *(unsigned short*)(row + 2 * sA) = (unsigned short)iA; *(unsigned short*)(row + 2 * sB) = (unsigned short)iB;
        row[256 + sA] = (unsigned char)(int)h0; row[256 + sB] = (unsigned char)(int)h1;
        row[384 + sA] = (unsigned char)l0; row[384 + sB] = (unsigned char)l1;
    }
}
typedef int v2i32 __attribute__((ext_vector_type(2)));
typedef int v4i32 __attribute__((ext_vector_type(4)));
__device__ __forceinline__ void gatherB_stream(int c, int tile0, int tstep, int ntiles, float* out, const bf16* __restrict__ x1b, const float* __restrict__ mod, const unsigned* __restrict__ pw,
                                               const unsigned char* __restrict__ VT4, char* lds) {
    int tid = threadIdx.x; asm volatile("" : "+v"(tid));
    const int wid = tid >> 6, lane = tid & 63, r = lane >> 3, g = lane >> 4, li = lane & 15;
    const int N = ntiles * 16;
    if (N <= 0) return;
    const int colb = 256 * c + 64 * g + li;
    float gt[2][4];
#pragma unroll
    for (int k = 0; k < 2; ++k) { const int tl = tile0 + (k < ntiles ? k : 0) * tstep; const float* gp = mod + (size_t)((tl * 128) >> 11) * 6144 + 5 * 1024 + colb;
#pragma unroll
        for (int u = 0; u < 4; ++u) gt[k][u] = gp[16 * u]; }
    asm volatile("s_waitcnt vmcnt(0)" ::: "memory");
#pragma unroll
    for (int k = 0; k < 2; ++k)
#pragma unroll
        for (int u = 0; u < 4; ++u) asm volatile("" : "+v"(gt[k][u]));
    const unsigned char* base = VT4 + (size_t)c * 16384 * 128; const unsigned l4 = 4u * (unsigned)lane;
    const unsigned loff0 = 16u * (unsigned)((lane & 7) ^ (r >> 1)), loff1 = loff0 ^ 64u;
    const unsigned char* pwb = (const unsigned char*)pw;
    LAS unsigned char* ring = (LAS unsigned char*)lds + wid * 16384;
    LAS unsigned char* meta = (LAS unsigned char*)lds + 132096 + wid * 512;
    LAS unsigned char* xslot = (LAS unsigned char*)lds + 136192 + wid * 1024;
    const unsigned char* xb = (const unsigned char*)(x1b + 256 * c);
    unsigned tra[8];
#pragma unroll
    for (int t = 0; t < 8; ++t) tra[t] = (unsigned)(g * 1024 + (li >> 1) * 128 + ((t ^ (li >> 2) ^ (4 * (g & 1))) * 16) + 8 * (li & 1));
    const int m4 = li & 3;
    const unsigned aoffs = (unsigned)((m4 == 1 ? 384 : 256) + 8 * g);
#define PEER_TOK(n) ((tile0 + ((n) >> 4) * tstep) * 128 + wid * 16 + ((n) & 15))
#define PEER_ISSUE_W(n) do { const unsigned t_ = (unsigned)PEER_TOK(n); \
        __builtin_amdgcn_global_load_lds((const unsigned*)(pwb + (t_ * 512u + l4)), (LAS unsigned*)(meta), 4, 0, 0); \
        __builtin_amdgcn_global_load_lds((const unsigned*)(pwb + (t_ * 512u + 256u + l4)), (LAS unsigned*)(meta + 256), 4, 0, 0); } while (0)
#define PEER_ISSUE_X(n) do { const unsigned t_ = (unsigned)PEER_TOK(n); \
        if (lane < 32) __builtin_amdgcn_global_load_lds((const unsigned*)(xb + ((size_t)t_ * 2048u + 4u * l4)), (LAS unsigned*)(xslot), 16, 0, 0); } while (0)
#define PEER_LOAD_IDX() do { _Pragma("unroll") for (int i_ = 0; i_ < 16; ++i_) idxv[i_] = *(const LAS unsigned short*)(meta + (8 * i_ + r) * 2); } while (0)
#define PEER_ISSUE_ROW(i) __builtin_amdgcn_global_load_lds((const unsigned*)(base + ((idxv[i] & 0x3fffu) * 128u + (((i) & 1) ? loff1 : loff0))), (LAS unsigned*)(ring + (i) * 1024), 16, 0, 0)
#define PEER_LOAD_A(AOP, WS) do { _Pragma("unroll") for (int q_ = 0; q_ < 2; ++q_) { const v2u a_ = *(const LAS v2u*)(meta + aoffs + 64 * q_), b_ = *(const LAS v2u*)(meta + aoffs + 64 * q_ + 32); \
            v4i32 z_; z_[0] = m4 < 2 ? (int)a_.x : 0; z_[1] = m4 < 2 ? (int)a_.y : 0; z_[2] = m4 < 2 ? (int)b_.x : 0; z_[3] = m4 < 2 ? (int)b_.y : 0; AOP[q_] = z_; } \
        const v2u d_ = *(const LAS v2u*)(meta); \
        const int kb_ = (int)(((d_.x >> 14) & 3u) | (((d_.x >> 30) & 3u) << 2) | (((d_.y >> 14) & 3u) << 4) | (((d_.y >> 30) & 3u) << 6)); \
        WS = __uint_as_float((unsigned)(255 - kb_) << 23); } while (0)
#define PEER_WIDEN(x, L, H) do { L = (int)((((unsigned)(x)) << 4) & 0xf0f0f0f0u); H = (int)(((unsigned)(x)) & 0xf0f0f0f0u); } while (0)
#define PEER_KSTEP_B(Q) do { _Pragma("unroll") for (int t_ = 0; t_ < 8; ++t_) { \
            const v2i32 b0_ = __builtin_amdgcn_ds_read_tr8_b64_v2i32((LAS v2i32*)(ring + (Q) * 8192 + tra[t_])); \
            const v2i32 b1_ = __builtin_amdgcn_ds_read_tr8_b64_v2i32((LAS v2i32*)(ring + (Q) * 8192 + 4096 + tra[t_])); \
            v4i32 lo_, hi_; PEER_WIDEN(b0_[0], lo_[0], hi_[0]); PEER_WIDEN(b0_[1], lo_[1], hi_[1]); PEER_WIDEN(b1_[0], lo_[2], hi_[2]); PEER_WIDEN(b1_[1], lo_[3], hi_[3]); \
            acc[2 * t_] = __builtin_amdgcn_mfma_i32_16x16x64_i8(aop[Q], lo_, acc[2 * t_], 0, 0, 0); \
            acc[2 * t_ + 1] = __builtin_amdgcn_mfma_i32_16x16x64_i8(aop[Q], hi_, acc[2 * t_ + 1], 0, 0, 0); } \
        asm volatile("s_waitcnt lgkmcnt(0)" ::: "memory"); } while (0)
#define PEER_VMWAIT(N) asm volatile("s_waitcnt vmcnt(" #N ")" ::: "memory")
#define PEER_FINISH_B(n) do { const int t_ = PEER_TOK(n); const bool k1_ = ((n) >> 4) != 0; \
        float* o_ = out + (size_t)t_ * 1024 + colb; \
        _Pragma("unroll") for (int u_ = 0; u_ < 4; ++u_) { \
            const v4i32 s_ = g == 0 ? acc[u_] : (g == 1 ? acc[4 + u_] : (g == 2 ? acc[8 + u_] : acc[12 + u_])); \
            const float x_ = bf2f(*(const LAS unsigned short*)(xslot + (64 * g + 16 * u_ + li) * 2)); \
            o_[16 * u_] = x_ + (k1_ ? gt[1][u_] : gt[0][u_]) * (((float)s_[0] + (float)s_[1] * (1.f / 128.f)) * wscale); } \
        asm volatile("s_waitcnt lgkmcnt(0)" ::: "memory"); \
        _Pragma("unroll") for (int q_ = 0; q_ < 16; ++q_) acc[q_] = (v4i32){0, 0, 0, 0}; } while (0)
    unsigned idxv[16]; v4i32 aop[2], aopn[2]; v4i32 acc[16]; float wscale, wscalen;
#pragma unroll
    for (int q = 0; q < 16; ++q) acc[q] = (v4i32){0, 0, 0, 0};
    PEER_ISSUE_W(0);
    PEER_VMWAIT(0);
    PEER_LOAD_IDX(); PEER_LOAD_A(aop, wscale);
    asm volatile("s_waitcnt lgkmcnt(0)" ::: "memory");
    PEER_ISSUE_W(N > 1 ? 1 : 0);
#pragma unroll
    for (int i = 0; i < 16; ++i) PEER_ISSUE_ROW(i);
    PEER_VMWAIT(16);
#pragma unroll 1
    for (int n = 0; n < N - 1; ++n) {
        PEER_LOAD_IDX(); PEER_LOAD_A(aopn, wscalen);
        asm volatile("s_waitcnt lgkmcnt(0)" ::: "memory");
        { const int n2 = n + 2 < N ? n + 2 : N - 1; PEER_ISSUE_W(n2); }
        PEER_ISSUE_X(n);
        PEER_VMWAIT(11); PEER_KSTEP_B(0);
        PEER_ISSUE_ROW(0);  PEER_ISSUE_ROW(1);  PEER_ISSUE_ROW(2);  PEER_ISSUE_ROW(3);  PEER_ISSUE_ROW(4);  PEER_ISSUE_ROW(5);  PEER_ISSUE_ROW(6);  PEER_ISSUE_ROW(7);
        PEER_VMWAIT(11); PEER_KSTEP_B(1);
        PEER_ISSUE_ROW(8);  PEER_ISSUE_ROW(9);  PEER_ISSUE_ROW(10); PEER_ISSUE_ROW(11); PEER_ISSUE_ROW(12); PEER_ISSUE_ROW(13); PEER_ISSUE_ROW(14); PEER_ISSUE_ROW(15);
        PEER_VMWAIT(16);
        PEER_FINISH_B(n);
        aop[0] = aopn[0]; aop[1] = aopn[1];
        wscale = wscalen;
    }
    {
        PEER_ISSUE_X(N - 1);
        PEER_VMWAIT(9); PEER_KSTEP_B(0);
        PEER_VMWAIT(1); PEER_KSTEP_B(1);
        PEER_VMWAIT(0);
        PEER_FINISH_B(N - 1);
    }
#undef PEER_TOK
#undef PEER_ISSUE_W
#undef PEER_ISSUE_X
#undef PEER_LOAD_IDX
#undef PEER_ISSUE_ROW
#undef PEER_LOAD_A
#undef PEER_WIDEN
#undef PEER_KSTEP_B
#undef PEER_VMWAIT
#undef PEER_FINISH_B
}
__device__ __forceinline__ void gatherB_fused(int tok0, int cstart, float* out, const bf16* __restrict__ x1b, const float* __restrict__ mod, const unsigned* __restrict__ pw,
                                               const unsigned char* __restrict__ VT4, char* lds) {
    int tid = threadIdx.x; asm volatile("" : "+v"(tid));
    const int wid = tid >> 6, lane = tid & 63, r = lane >> 3, g = lane >> 4, li = lane & 15;
    constexpr int N = 32;
    const int tw0 = tok0 + wid * 8;
    {
        const float* gp = mod + (size_t)(tok0 >> 11) * 6144 + 5 * 1024;
        for (int i = tid; i < 1024; i += 512) *(LAS float*)((LAS unsigned char*)lds + 132096 + 8192 + i * 4) = gp[i];
    }
    __syncthreads();
    const LAS float* gtab = (const LAS float*)((LAS unsigned char*)lds + 132096 + 8192);
    const int colg = 64 * g + li;
    const unsigned char* basen = VT4 + (size_t)(cstart & 3) * 16384 * 128; const unsigned l4 = 4u * (unsigned)lane;
    const unsigned loff0 = 16u * (unsigned)((lane & 7) ^ (r >> 1)), loff1 = loff0 ^ 64u;
    const unsigned char* pwb = (const unsigned char*)pw;
    LAS unsigned char* ring = (LAS unsigned char*)lds + wid * 16384;
    LAS unsigned char* meta = (LAS unsigned char*)lds + 132096 + wid * 512;
    LAS unsigned char* xslot = (LAS unsigned char*)lds + 132096 + 4096 + wid * 512;
    const unsigned char* xb = (const unsigned char*)x1b;
    unsigned tra[8];
#pragma unroll
    for (int t = 0; t < 8; ++t) tra[t] = (unsigned)(g * 1024 + (li >> 1) * 128 + ((t ^ (li >> 2) ^ (4 * (g & 1))) * 16) + 8 * (li & 1));
    const int m4 = li & 3;
    const unsigned aoffs = (unsigned)((m4 == 1 ? 384 : 256) + 8 * g);
#define PEER_TOK(n) (tw0 + ((n) & 7))
#define PEER_CQ(n) ((cstart + ((n) >> 3)) & 3)
#define PEER_ISSUE_W(n) do { const unsigned t_ = (unsigned)PEER_TOK(n); \
        __builtin_amdgcn_global_load_lds((const unsigned*)(pwb + (t_ * 512u + l4)), (LAS unsigned*)(meta), 4, 0, 0); \
        __builtin_amdgcn_global_load_lds((const unsigned*)(pwb + (t_ * 512u + 256u + l4)), (LAS unsigned*)(meta + 256), 4, 0, 0); } while (0)
#define PEER_ISSUE_X(n) do { const unsigned t_ = (unsigned)PEER_TOK(n); \
        if (lane < 32) __builtin_amdgcn_global_load_lds((const unsigned*)(xb + ((size_t)t_ * 2048u + (unsigned)PEER_CQ(n) * 512u + 4u * l4)), (LAS unsigned*)(xslot), 16, 0, 0); } while (0)
#define PEER_LOAD_IDX() do { _Pragma("unroll") for (int i_ = 0; i_ < 16; ++i_) idxv[i_] = *(const LAS unsigned short*)(meta + (8 * i_ + r) * 2); } while (0)
#define PEER_ISSUE_ROW(i) __builtin_amdgcn_global_load_lds((const unsigned*)(basen + ((idxv[i] & 0x3fffu) * 128u + (((i) & 1) ? loff1 : loff0))), (LAS unsigned*)(ring + (i) * 1024), 16, 0, 0)
#define PEER_LOAD_A(AOP, WS) do { _Pragma("unroll") for (int q_ = 0; q_ < 2; ++q_) { const v2u a_ = *(const LAS v2u*)(meta + aoffs + 64 * q_), b_ = *(const LAS v2u*)(meta + aoffs + 64 * q_ + 32); \
            v4i32 z_; z_[0] = m4 < 2 ? (int)a_.x : 0; z_[1] = m4 < 2 ? (int)a_.y : 0; z_[2] = m4 < 2 ? (int)b_.x : 0; z_[3] = m4 < 2 ? (int)b_.y : 0; AOP[q_] = z_; } \
        const v2u d_ = *(const LAS v2u*)(meta); \
        const int kb_ = (int)(((d_.x >> 14) & 3u) | (((d_.x >> 30) & 3u) << 2) | (((d_.y >> 14) & 3u) << 4) | (((d_.y >> 30) & 3u) << 6)); \
        WS = __uint_as_float((unsigned)(255 - kb_) << 23); } while (0)
#define PEER_WIDEN(x, L, H) do { L = (int)((((unsigned)(x)) << 4) & 0xf0f0f0f0u); H = (int)(((unsigned)(x)) & 0xf0f0f0f0u); } while (0)
#define PEER_KSTEP_B(Q) do { _Pragma("unroll") for (int t_ = 0; t_ < 8; ++t_) { \
            const v2i32 b0_ = __builtin_amdgcn_ds_read_tr8_b64_v2i32((LAS v2i32*)(ring + (Q) * 8192 + tra[t_])); \
            const v2i32 b1_ = __builtin_amdgcn_ds_read_tr8_b64_v2i32((LAS v2i32*)(ring + (Q) * 8192 + 4096 + tra[t_])); \
            v4i32 lo_, hi_; PEER_WIDEN(b0_[0], lo_[0], hi_[0]); PEER_WIDEN(b0_[1], lo_[1], hi_[1]); PEER_WIDEN(b1_[0], lo_[2], hi_[2]); PEER_WIDEN(b1_[1], lo_[3], hi_[3]); \
            acc[2 * t_] = __builtin_amdgcn_mfma_i32_16x16x64_i8(aop[Q], lo_, acc[2 * t_], 0, 0, 0); \
            acc[2 * t_ + 1] = __builtin_amdgcn_mfma_i32_16x16x64_i8(aop[Q], hi_, acc[2 * t_ + 1], 0, 0, 0); } \
        asm volatile("s_waitcnt lgkmcnt(0)" ::: "memory"); } while (0)
#define PEER_VMWAIT(N) asm volatile("s_waitcnt vmcnt(" #N ")" ::: "memory")
#define PEER_FINISH_B(n) do { const int t_ = PEER_TOK(n); const int colq_ = 256 * PEER_CQ(n) + colg; \
        float* o_ = out + (size_t)t_ * 1024 + colq_; \
        _Pragma("unroll") for (int u_ = 0; u_ < 4; ++u_) { \
            const v4i32 s_ = g == 0 ? acc[u_] : (g == 1 ? acc[4 + u_] : (g == 2 ? acc[8 + u_] : acc[12 + u_])); \
            const float x_ = bf2f(*(const LAS unsigned short*)(xslot + (colg + 16 * u_) * 2)); \
            o_[16 * u_] = x_ + gtab[colq_ + 16 * u_] * (((float)s_[0] + (float)s_[1] * (1.f / 128.f)) * wscale); } \
        asm volatile("s_waitcnt lgkmcnt(0)" ::: "memory"); \
        _Pragma("unroll") for (int q_ = 0; q_ < 16; ++q_) acc[q_] = (v4i32){0, 0, 0, 0}; } while (0)
    unsigned idxv[16]; v4i32 aop[2], aopn[2]; v4i32 acc[16]; float wscale, wscalen;
#pragma unroll
    for (int q = 0; q < 16; ++q) acc[q] = (v4i32){0, 0, 0, 0};
    PEER_ISSUE_W(0);
    PEER_VMWAIT(0);
    PEER_LOAD_IDX(); PEER_LOAD_A(aop, wscale);
    asm volatile("s_waitcnt lgkmcnt(0)" ::: "memory");
    PEER_ISSUE_W(1);
#pragma unroll
    for (int i = 0; i < 16; ++i) PEER_ISSUE_ROW(i);
    PEER_VMWAIT(16);
#pragma unroll 1
    for (int n = 0; n < N - 1; ++n) {
        PEER_LOAD_IDX(); PEER_LOAD_A(aopn, wscalen);
        asm volatile("s_waitcnt lgkmcnt(0)" ::: "memory");
        basen = VT4 + (size_t)PEER_CQ(n + 1) * 16384 * 128;
        { const int n2 = n + 2 < N ? n + 2 : N - 1; PEER_ISSUE_W(n2); }
        PEER_ISSUE_X(n);
        PEER_VMWAIT(11); PEER_KSTEP_B(0);
        PEER_ISSUE_ROW(0);  PEER_ISSUE_ROW(1);  PEER_ISSUE_ROW(2);  PEER_ISSUE_ROW(3);  PEER_ISSUE_ROW(4);  PEER_ISSUE_ROW(5);  PEER_ISSUE_ROW(6);  PEER_ISSUE_ROW(7);
        PEER_VMWAIT(11); PEER_KSTEP_B(1);
        PEER_ISSUE_ROW(8);  PEER_ISSUE_ROW(9);  PEER_ISSUE_ROW(10); PEER_ISSUE_ROW(11); PEER_ISSUE_ROW(12); PEER_ISSUE_ROW(13); PEER_ISSUE_ROW(14); PEER_ISSUE_ROW(15);
        PEER_VMWAIT(16);
        PEER_FINISH_B(n);
        aop[0] = aopn[0]; aop[1] = aopn[1];
        wscale = wscalen;
    }
    {
        PEER_ISSUE_X(N - 1);
        PEER_VMWAIT(9); PEER_KSTEP_B(0);
        PEER_VMWAIT(1); PEER_KSTEP_B(1);
        PEER_VMWAIT(0);
        PEER_FINISH_B(N - 1);
    }
#undef PEER_TOK
#undef PEER_CQ
#undef PEER_ISSUE_W
#undef PEER_ISSUE_X
#undef PEER_LOAD_IDX
#undef PEER_ISSUE_ROW
#undef PEER_LOAD_A
#undef PEER_WIDEN
#undef PEER_KSTEP_B
#undef PEER_VMWAIT
#undef PEER_FINISH_B
}
}
namespace mk {
#ifndef MK_CTX_IN_P1
#define MK_CTX_IN_P1 0
#endif
#ifndef MK_DUP
#define MK_DUP -1
#endif
constexpr int NWAVES = 8, NTHR = 512;
constexpr int D = 1024, NB = 8, L = 2048, CT = 256, LT = L + CT, INC = 3072, NMODC = 6 * D;
constexpr int M1 = NB * LT;
constexpr int M2 = NB * L;
constexpr float EPS = 1e-6f;
constexpr float C2 = 0.125f * 1.4426950408889634f;
constexpr size_t MiB = 1u << 20;
constexpr size_t WS_CTL = 0, CTL_ZERO_BYTES = 18 * 1024;
constexpr size_t WS_MOD = 1 * MiB;
constexpr size_t WS_TAB = WS_MOD + 256 * 1024;
constexpr size_t WS_ALPHA2 = WS_TAB + 512 * 1024;
constexpr size_t WS_BIASQ = WS_ALPHA2 + 32 * 1024;
constexpr size_t WS_SSQ = 2 * MiB;
constexpr size_t WS_WIN = 3 * MiB;
constexpr size_t WS_WOUT = 9 * MiB;
constexpr size_t WS_WQ = 11 * MiB;
constexpr size_t WS_SUBK = 15 * MiB;
constexpr size_t WS_PU = 16 * MiB;
constexpr size_t WS_PV = 32 * MiB;
constexpr size_t WS_SU = 48 * MiB, WS_SV = 49 * MiB;
constexpr size_t WS_X1B = 133 * MiB;
constexpr size_t WS_PW2 = 52 * MiB;
constexpr size_t WS_PART = 116 * MiB;
constexpr size_t WS_A = 80 * MiB;
constexpr size_t WS_HB = WS_A, WS_OD = WS_A, WS_X1A = WS_A;
constexpr size_t WS_B = 116 * MiB;
constexpr size_t WS_RQ = WS_B;
constexpr size_t WS_RK = WS_RQ + 8 * MiB;
constexpr size_t WS_RV = WS_RK + 9 * MiB;
constexpr size_t WS_RG = WS_RV + 18 * MiB;
constexpr size_t WS_DQ = WS_RG + 16 * MiB;
constexpr size_t WS_DK = WS_DQ + 16 * MiB;
constexpr size_t WS_DV = WS_DK + 18 * MiB;
constexpr size_t WS_ST = 219 * MiB;
constexpr size_t WS_MIX = WS_DQ;
constexpr size_t WS_QP = WS_B;
constexpr size_t WS_HQ = 180 * MiB;
constexpr size_t WS_HS = 196 * MiB;
constexpr size_t WS_PIDX = 200 * MiB;
constexpr size_t WS_PGATE = 208 * MiB;
constexpr size_t WS_END = 237 * MiB;
constexpr int CVT_LATE = 5376;
constexpr int CW_BAR = 1024;
static_assert((CW_BAR + XCD_BAR_WORDS) * 4 <= (int)CTL_ZERO_BYTES, "barrier words inside the memset region");
constexpr int RING_BYTES = 131072, MISC_OFF = RING_BYTES + 320, LDS_BYTES = 147456;

struct Args { const float* in[19]; float* out; unsigned char* ws; int ph_lo, ph_hi; };

template <int R, bool SILU>
__device__ __forceinline__ void gemv_rows(const float* const (&src)[R], const float* __restrict__ W, int N, const float* __restrict__ bias, float* __restrict__ out, int out_stride, LAS float* lds) {
    LAS float* s = lds; LAS float* part = lds + R * 1024;
    const int tid = threadIdx.x;
    bool did = false;
    for (int cb = blockIdx.x; cb < N / 32; cb += gridDim.x) {
        if (!did) {
            for (int i = tid; i < R * 1024; i += NTHR) { const int r = i >> 10, k = i & 1023; float v = 0.f;
#pragma unroll
                for (int q = 0; q < R; ++q) if (q == r) v = src[q][k];
                s[i] = SILU ? v / (1.f + expf(-v)) : v; }
            __syncthreads(); did = true;
        }
        const int cc = tid & 31, ks = tid >> 5;
        float acc[R];
#pragma unroll
        for (int r = 0; r < R; ++r) acc[r] = 0.f;
        const float* wp = W + (size_t)(ks * 64) * N + cb * 32 + cc;
#pragma unroll
        for (int k0 = 0; k0 < 64; k0 += 16) {
            float w[16];
#pragma unroll
            for (int k = 0; k < 16; ++k) w[k] = wp[(size_t)(k0 + k) * N];
#pragma unroll
            for (int k = 0; k < 16; ++k)
#pragma unroll
                for (int r = 0; r < R; ++r) acc[r] += s[r * 1024 + ks * 64 + k0 + k] * w[k]; }
#pragma unroll
        for (int r = 0; r < R; ++r) part[(ks * R + r) * 32 + cc] = acc[r];
        __syncthreads();
        if (tid < R * 32) { const int r = tid >> 5, c2 = tid & 31; float t = 0.f;
#pragma unroll
            for (int q = 0; q < 16; ++q) t += part[(q * R + r) * 32 + c2];
            out[(size_t)r * out_stride + cb * 32 + c2] = t + (bias ? bias[cb * 32 + c2] : 0.f); }
        __syncthreads();
    }
}
__device__ __forceinline__ void transpose_item(const float* __restrict__ W, int K, int N, bf16* __restrict__ WT, int k0, int n0, int n_dst0, LAS float* scr, int lane) {
#pragma unroll 8
    for (int i = 0; i < 32; ++i) { const int kk = 2 * i + (lane >> 5); scr[kk * 33 + (lane & 31)] = W[(size_t)(k0 + kk) * N + n0 + (lane & 31)]; }
    LDS_WAIT(); asm volatile("" ::: "memory");
    const int c = lane & 7;
#pragma unroll
    for (int j = 0; j < 4; ++j) { const int n = (lane >> 3) + 8 * j; const LAS float* sp = scr + (8 * c) * 33 + n;
        v4u o; o.x = pk2(sp[0 * 33], sp[1 * 33]); o.y = pk2(sp[2 * 33], sp[3 * 33]); o.z = pk2(sp[4 * 33], sp[5 * 33]); o.w = pk2(sp[6 * 33], sp[7 * 33]);
        *(v4u*)(WT + (size_t)(n_dst0 + n) * K + k0 + 8 * c) = o; }
    LDS_WAIT(); asm volatile("" ::: "memory");
}
__host__ __device__ __forceinline__ int win_perm(int q_abs) { const int T = q_abs >> 8, q = q_abs & 255; return T * 256 + 128 * ((q >> 5) & 1) + 32 * (q >> 6) + (q & 31); }


struct EpiInProj {
    static constexpr bool PERM = false, AFTER_DRAIN = false;
    bf16 *RQ, *RK, *RV, *RG, *DQ, *DK, *DV; const float* tab; const float* qkg;
    __device__ __forceinline__ void operator()(const pg8::f32x4 (&acc)[2][2][4][2], const pg8::Unit& u, int wr, int wc, int fr, int fq) const {
        const int b = u.pm / 9, w = u.pm % 9, pn = u.pn; const bool isctx = (w == 0);
        const int grp = (pn == 0) ? 0 : (pn == 1) ? 1 : (pn < 4) ? 2 : (pn < 6) ? 3 : (pn < 8) ? 4 : (pn < 10) ? 5 : 6;
        f32x4 gq[2][2];
        if (grp == 4 || grp == 5) {
#pragma unroll
            for (int bj = 0; bj < 2; ++bj)
#pragma unroll
                for (int n = 0; n < 2; ++n) gq[bj][n] = *(const f32x4*)(qkg + (grp == 5 ? 64 : 0) + 32 * bj + 16 * n + 4 * fq);
        }
#pragma unroll
        for (int ai = 0; ai < 2; ++ai)
#pragma unroll
            for (int m = 0; m < 4; ++m) {
                const int rl = 128 * ai + 64 * wr + 16 * m + fr;
                const int tok = 256 * w + rl;
                const int l = tok - 256;
                f32x4 v[2][2];
#pragma unroll
                for (int bj = 0; bj < 2; ++bj)
#pragma unroll
                    for (int n = 0; n < 2; ++n) v[bj][n] = acc[ai][bj][m][n];
                if (grp == 4 || grp == 5) {
                    float ss = 0.f;
#pragma unroll
                    for (int bj = 0; bj < 2; ++bj)
#pragma unroll
                        for (int n = 0; n < 2; ++n) ss += (v[bj][n].x * v[bj][n].x + v[bj][n].y * v[bj][n].y) + (v[bj][n].z * v[bj][n].z + v[bj][n].w * v[bj][n].w);
                    ss += __shfl_xor(ss, 16); ss += __shfl_xor(ss, 32);
                    const float rstd = rsqrtf(ss * (1.f / 64.f) + EPS);
#pragma unroll
                    for (int bj = 0; bj < 2; ++bj)
#pragma unroll
                        for (int n = 0; n < 2; ++n) v[bj][n] = v[bj][n] * rstd * gq[bj][n];
                }
                const bool rope = (grp == 0 || grp == 1 || grp == 4 || grp == 5) && !isctx;
                if (rope) {
#pragma unroll
                    for (int bj = 0; bj < 2; ++bj) {
                        const f32x4 cs = *(const f32x4*)(tab + (size_t)l * 64 + 16 * bj + 4 * fq), sn = *(const f32x4*)(tab + (size_t)l * 64 + 32 + 16 * bj + 4 * fq);
                        const f32x4 x0 = v[bj][0], x1 = v[bj][1];
                        v[bj][0] = x0 * cs - x1 * sn; v[bj][1] = x1 * cs + x0 * sn;
                    }
                }
                float scl = 1.f; bf16* dst;
                if (grp == 0) { dst = RQ + ((size_t)(b * 4 + wc) * L + l) * 64; }
                else if (grp == 1) { dst = RK + ((size_t)(b * 4 + wc) * LT + tok) * 64; scl = 0.125f; }
                else if (grp == 2) { dst = RV + ((size_t)(b * 4 + 2 * (pn - 2) + (wc >> 1)) * LT + tok) * 128 + 64 * (wc & 1); }
                else if (grp == 3) { dst = RG + ((size_t)b * L + l) * 512 + 256 * (pn - 4) + 64 * wc; }
                else if (grp == 4) { dst = DQ + ((size_t)(b * 8 + 4 * (pn - 6) + wc) * L + l) * 64; scl = C2; }
                else if (grp == 5) { dst = DK + ((size_t)(b * 8 + 4 * (pn - 8) + wc) * LT + tok) * 64; }
                else { dst = DV + ((size_t)(b * 4 + 2 * (pn - 10) + (wc >> 1)) * LT + tok) * 128 + 64 * (wc & 1); }
#pragma unroll
                for (int bj = 0; bj < 2; ++bj)
#pragma unroll
                    for (int n = 0; n < 2; ++n) { const f32x4 o = v[bj][n] * scl; v2u pk; pk.x = pk2(o.x, o.y); pk.y = pk2(o.z, o.w);
                        *(v2u*)(dst + 32 * bj + 16 * n + 4 * fq) = pk; }
            }
    }
};
struct InSched {
    int xcd, slot, nslots;
    __device__ __forceinline__ void init(int G, int c) { xcd = c % 8; slot = c / 8; nslots = G / 8; }
#if MK_CTX_IN_P1
    __device__ __forceinline__ bool next(int i, pg8::Unit& u) const {
        const int idx = i * nslots + slot;
        if (idx >= 96) return false;
        u.pn = idx >> 3; u.pm = 9 * xcd + 1 + (idx & 7); return true;
    }
#else
    __device__ __forceinline__ bool next(int i, pg8::Unit& u) const {
        int idx = i * nslots + slot;
        if (idx >= 103) return false;
        int pn = 0, w = 0;
#pragma unroll
        for (int p = 0; p < 12; ++p) {
            const bool cn = (p == 1 || p == 2 || p == 3 || p >= 8); const int cnt = cn ? 9 : 8;
            if (idx >= 0 && idx < cnt) { pn = p; w = cn ? idx : idx + 1; idx = -1000; }
            else idx -= cnt;
        }
        u.pm = 9 * xcd + w; u.pn = pn; return true;
    }
#endif
    __device__ __forceinline__ void a_ready(const pg8::Unit&) const {}
    __device__ __forceinline__ void done(const pg8::Unit&) const {}
};
struct OneUnit {
    int pm, pn;
    __device__ __forceinline__ bool next(int i, pg8::Unit& u) const { if (i > 0) return false; u.pm = pm; u.pn = pn; return true; }
    __device__ __forceinline__ void a_ready(const pg8::Unit&) const {}
    __device__ __forceinline__ void done(const pg8::Unit&) const {}
};

struct EpiOutProj {
    static constexpr bool PERM = false, AFTER_DRAIN = false;
    static constexpr int MB = 2;
    const float* x; bf16* x1b; bf16* x1a; const float* mod; const float* alpha2; float* ssq;
    __device__ __forceinline__ void operator()(const pg8::f32x4 (&acc)[2][2][4][2], const pg8::Unit& u, int wr, int wc, int fr, int fq) const {
        const int b = u.pm >> 3;
        const int col0 = u.pn * 256 + wc * 32 + 4 * fq;
        f32x4 gt[2][2], al[2][2];
#pragma unroll
        for (int bj = 0; bj < 2; ++bj)
#pragma unroll
            for (int n = 0; n < 2; ++n) { gt[bj][n] = *(const f32x4*)(mod + (size_t)b * NMODC + 2 * D + col0 + bj * 128 + n * 16); al[bj][n] = *(const f32x4*)(alpha2 + (size_t)b * D + col0 + bj * 128 + n * 16); }
#pragma unroll
        for (int ai = 0; ai < 2; ++ai)
#pragma unroll
            for (int mh = 0; mh < 4; mh += MB) {
                f32x4 xv[MB][2][2];
#pragma unroll
                for (int mm = 0; mm < MB; ++mm) { const size_t row = (size_t)u.pm * 256 + ai * 128 + wr * 64 + (mh + mm) * 16 + fr;
#pragma unroll
                    for (int bj = 0; bj < 2; ++bj)
#pragma unroll
                        for (int n = 0; n < 2; ++n) xv[mm][bj][n] = *(const f32x4*)(x + row * D + col0 + bj * 128 + n * 16); }
#pragma unroll
                for (int mm = 0; mm < MB; ++mm) { const int m = mh + mm;
                    const size_t row = (size_t)u.pm * 256 + ai * 128 + wr * 64 + m * 16 + fr;
                    float ss = 0.f;
#pragma unroll
                    for (int bj = 0; bj < 2; ++bj)
#pragma unroll
                        for (int n = 0; n < 2; ++n) { const size_t off = row * D + col0 + bj * 128 + n * 16;
                            const f32x4 x1 = xv[mm][bj][n] + gt[bj][n] * acc[ai][bj][m][n];
                            { v2u pb; pb.x = pk2(x1.x, x1.y); pb.y = pk2(x1.z, x1.w); *(v2u*)(x1b + off) = pb; } ss += (x1.x * x1.x + x1.y * x1.y) + (x1.z * x1.z + x1.w * x1.w);
                            const f32x4 xa = x1 * al[bj][n]; v2u pk; pk.x = pk2(xa.x, xa.y); pk.y = pk2(xa.z, xa.w); *(v2u*)(x1a + off) = pk; }
                    ss += __shfl_xor(ss, 16); ss += __shfl_xor(ss, 32);
                    if (fq == 0) ssq[row * 16 + u.pn * 4 + wc] = ss;
                }
            }
    }
};
struct EpiQuery {
    static constexpr bool PERM = true, AFTER_DRAIN = false;
    bf16* qp; const float* biasq; const float* ssq;
    __device__ __forceinline__ void operator()(const pg8::f32x4 (&acc)[2][2][4][2], const pg8::Unit& u, int wr, int wc, int fr, int fq) const {
        const int b = u.pm >> 3;
        const int col0 = u.pn * 256 + wc * 32 + 8 * fq;
        f32x4 bv[2][2];
#pragma unroll
        for (int bj = 0; bj < 2; ++bj)
#pragma unroll
            for (int n = 0; n < 2; ++n) bv[bj][n] = *(const f32x4*)(biasq + (size_t)b * 2048 + col0 + bj * 128 + 4 * n);
#pragma unroll
        for (int ai = 0; ai < 2; ++ai)
#pragma unroll
            for (int m = 0; m < 4; ++m) {
                const size_t row = (size_t)u.pm * 256 + ai * 128 + wr * 64 + m * 16 + fr;
                const f32x4 s0 = *(const f32x4*)(ssq + row * 16), s1 = *(const f32x4*)(ssq + row * 16 + 4), s2 = *(const f32x4*)(ssq + row * 16 + 8), s3 = *(const f32x4*)(ssq + row * 16 + 12);
                const float tot = ((s0.x + s0.y) + (s0.z + s0.w)) + ((s1.x + s1.y) + (s1.z + s1.w)) + ((s2.x + s2.y) + (s2.z + s2.w)) + ((s3.x + s3.y) + (s3.z + s3.w));
                const float rstd = rsqrtf(tot * (1.f / D) + EPS);
#pragma unroll
                for (int bj = 0; bj < 2; ++bj) { const f32x4 v0 = acc[ai][bj][m][0] * rstd + bv[bj][0], v1 = acc[ai][bj][m][1] * rstd + bv[bj][1];
                    v4u w; w.x = pk2(v0.x, v0.y); w.y = pk2(v0.z, v0.w); w.z = pk2(v1.x, v1.y); w.w = pk2(v1.z, v1.w);
                    const int kg = 4 * wc + fq;
                    *(v4u*)(qp + ((((row >> 5) * 8 + u.pn) * 2 + bj) * 16 + kg) * 256 + (row & 31) * 8) = w; }
            }
    }
};

struct EpiQuerySelect {
    static constexpr bool PERM = true, AFTER_DRAIN = true;
    const float* biasq; const float* ssq; const bf16* skf; int* pidx; float* pgate;
    __device__ __forceinline__ void fused(pg8::f32x4 (&acc)[2][2][4][2], const pg8::Unit& u, int wr, int wc, int fr, int fq, PG8_LAS unsigned char* lds, int wid, int lane) const {
        const int b = u.pm >> 3;
        const int col0 = u.pn * 256 + wc * 32 + 8 * fq, kg = 4 * wc + fq;
        f32x4 bv[2][2];
#pragma unroll
        for (int bj = 0; bj < 2; ++bj)
#pragma unroll
            for (int n = 0; n < 2; ++n) bv[bj][n] = *(const f32x4*)(biasq + (size_t)b * 2048 + col0 + bj * 128 + 4 * n);
#pragma unroll
        for (int ai = 0; ai < 2; ++ai)
#pragma unroll
            for (int m = 0; m < 4; ++m) {
                const int rl = ai * 128 + wr * 64 + m * 16 + fr; const size_t row = (size_t)u.pm * 256 + rl;
                const f32x4 s0 = *(const f32x4*)(ssq + row * 16), s1 = *(const f32x4*)(ssq + row * 16 + 4), s2 = *(const f32x4*)(ssq + row * 16 + 8), s3 = *(const f32x4*)(ssq + row * 16 + 12);
                const float tot = ((s0.x + s0.y) + (s0.z + s0.w)) + ((s1.x + s1.y) + (s1.z + s1.w)) + ((s2.x + s2.y) + (s2.z + s2.w)) + ((s3.x + s3.y) + (s3.z + s3.w));
                const float rstd = rsqrtf(tot * (1.f / D) + EPS);
#pragma unroll
                for (int bj = 0; bj < 2; ++bj) { const f32x4 v0 = acc[ai][bj][m][0] * rstd + bv[bj][0], v1 = acc[ai][bj][m][1] * rstd + bv[bj][1];
                    v4u w; w.x = pk2(v0.x, v0.y); w.y = pk2(v0.z, v0.w); w.z = pk2(v1.x, v1.y); w.w = pk2(v1.z, v1.w);
                    *(LAS v4u*)(lds + ((((rl >> 5) * 2 + bj) * 16 + kg) * 512 + (rl & 31) * 16)) = w; }
            }
        asm volatile("s_waitcnt lgkmcnt(0)" ::: "memory"); __builtin_amdgcn_s_barrier(); asm volatile("" ::: "memory");
        peer::select_wave_lds(skf + (size_t)u.pn * (2 * 4 * 8 * 2 * 32 * 8), (char*)lds, u.pn, pidx + (size_t)u.pm * 256 * 128, pgate + (size_t)u.pm * 256 * 128, wid, lane);
    }
};

__global__ void __launch_bounds__(NTHR, 2) mega(Args args) {
    extern __shared__ __attribute__((aligned(16))) unsigned char lds_raw[];
    LAS unsigned char* lds = (LAS unsigned char*)lds_raw;
    volatile LAS unsigned* MISC = (volatile LAS unsigned*)(lds + MISC_OFF);
    const int tid = threadIdx.x, lane = tid & 63, wave = __builtin_amdgcn_readfirstlane(tid >> 6);
    const int G = gridDim.x;
    const int gw = blockIdx.x * NWAVES + wave, NGW = G * NWAVES;
    unsigned char* ws = args.ws;
    const float* x = args.in[0]; const float* cnd = args.in[1]; const float* ctx = args.in[2]; const float* cctx = args.in[3];
    const float* w_mod = args.in[4]; const float* b_mod = args.in[5]; const float* g1 = args.in[6]; const float* g2 = args.in[7];
    const float* w_in = args.in[8]; const float* qkg = args.in[11];
    const float* w_out = args.in[14]; const float* wq = args.in[15];
    const float* subk = args.in[16]; const float* pu = args.in[17]; const float* pv = args.in[18];
    float* mod = (float*)(ws + WS_MOD); float* tab = (float*)(ws + WS_TAB); float* alpha2 = (float*)(ws + WS_ALPHA2); float* biasq = (float*)(ws + WS_BIASQ);
    bf16* WinT = (bf16*)(ws + WS_WIN); bf16* WoutT = (bf16*)(ws + WS_WOUT); bf16* WqT = (bf16*)(ws + WS_WQ); bf16* SubK = (bf16*)(ws + WS_SUBK);
    unsigned char* UT8 = ws + WS_PU; unsigned char* VT8 = ws + WS_PV; float* SUs = (float*)(ws + WS_SU); float* SVs = (float*)(ws + WS_SV); bf16* HB = (bf16*)(ws + WS_HB);

    for (int u = tid; u < (LDS_BYTES - RING_BYTES) / 4; u += NTHR) ((LAS unsigned*)(lds + RING_BYTES))[u] = 0u;
    __syncthreads();
    XcdBarrier bar = xcd_barrier_post((unsigned*)(ws + WS_CTL) + CW_BAR, MISC + 8);
    const int lo = args.ph_lo, hi = args.ph_hi;
#define IN(k) (lo <= (k) && (k) < hi)
#define SEAM(k) do { if (IN(k) && IN((k) + 1)) xcd_barrier(bar); } while (0)

    if (IN(0)) { for (int rep = 0; rep < (MK_DUP == 0 ? 2 : 1); ++rep) {
        {   const float* const rows[9] = {cnd, cnd + D, cnd + 2 * D, cnd + 3 * D, cnd + 4 * D, cnd + 5 * D, cnd + 6 * D, cnd + 7 * D, cctx};
            gemv_rows<9, true>(rows, w_mod, NMODC, b_mod, mod, NMODC, (LAS float*)lds); }
        LAS float* scr = (LAS float*)(lds + 57344 + wave * 8448);
        constexpr int I_IN = 16 * 96, I_OUT = 16 * 32, I_Q = 16 * 64;
        for (int it = gw; it < I_IN + I_OUT + I_Q; it += NGW) {
            int r = it;
            if (r < I_IN) { const int kb = r / 96, nb = r % 96; transpose_item(w_in, D, INC, WinT, 64 * kb, 32 * nb, win_perm(32 * nb), scr, lane); continue; } r -= I_IN;
            if (r < I_OUT) { const int kb = r / 32, nb = r % 32; transpose_item(w_out, D, D, WoutT, 64 * kb, 32 * nb, 32 * nb, scr, lane); continue; } r -= I_OUT;
            { const int kb = r / 64, nb = r % 64; transpose_item(wq, D, 2048, WqT, 64 * kb, 32 * nb, 32 * nb, scr, lane); }
        }
        const size_t gt = (size_t)blockIdx.x * NTHR + tid, GT = (size_t)G * NTHR;
        for (size_t i = gt; i < (size_t)8 * 2 * 128 * 128 / 8; i += GT) {
            const int ii = (int)i, hp = ii >> 11, n = (ii >> 4) & 127, c8 = ii & 15;
            const f32x4 a = *(const f32x4*)(subk + (size_t)ii * 8), bq4 = *(const f32x4*)(subk + (size_t)ii * 8 + 4);
            v4u o; o.x = pk2(a.x, a.y); o.y = pk2(a.z, a.w); o.z = pk2(bq4.x, bq4.y); o.w = pk2(bq4.z, bq4.w);
            *(v4u*)(SubK + (size_t)((((hp * 4 + (n >> 5)) * 8 + (c8 >> 1)) * 2 + (c8 & 1)) * 32 + (n & 31)) * 8) = o; }
        for (size_t i = gt; i < (size_t)L * 32; i += GT) {
            const int l = (int)(i >> 5), a = (int)((i >> 4) & 1), q = (int)(i & 15);
            const float f = powf(10000.f, -(float)q / 16.f); const float pos = a == 0 ? (float)(l >> 6) : (float)(l & 63); const float ang = pos * f;
            tab[l * 64 + a * 16 + q] = cosf(ang); tab[l * 64 + 32 + a * 16 + q] = sinf(ang);
        }
    if (MK_DUP == 0 && rep == 0) xcd_barrier(bar); } }
    SEAM(0);
    if (IN(1)) { for (int rep = 0; rep < (MK_DUP == 1 ? 2 : 1); ++rep) {
        const int NCTXWG = MK_CTX_IN_P1 ? 56 : G, nlat = G - NCTXWG;
        const bool ctxwg = nlat > 0 && (int)blockIdx.x >= nlat;
        const int cu_ = (int)blockIdx.x - nlat, cb_ = cu_ / 7, cj_ = cu_ % 7;
        const int mi0 = ctxwg ? wave : (int)blockIdx.x * NWAVES + wave, mstep = ctxwg ? NWAVES : (nlat > 0 ? nlat : G) * NWAVES, mcnt = ctxwg ? CT : (nlat > 0 ? M2 : M1);
        for (int mi = mi0; mi < mcnt; mi += 4 * mstep) {
            f32x4 v[4][4]; float ss[4]; int mrow_[4]; bool ok[4];
#pragma unroll
            for (int q = 0; q < 4; ++q) {
                const int mq = mi + q * mstep; ok[q] = mq < mcnt; const int mqq = ok[q] ? mq : mi;
                const int m = ctxwg ? cb_ * LT + mqq : (nlat > 0 ? (mqq >> 11) * LT + CT + (mqq & 2047) : mqq);
                mrow_[q] = m;
                const int b = m / LT, w = m % LT;
                const float* src = w < CT ? ctx + ((size_t)b * CT + w) * D : x + ((size_t)b * L + (w - CT)) * D;
                ss[q] = 0.f;
#pragma unroll
                for (int j2 = 0; j2 < 4; ++j2) { v[q][j2] = ((const f32x4*)src)[lane + 64 * j2]; }
            }
#pragma unroll
            for (int q = 0; q < 4; ++q) {
#pragma unroll
                for (int j2 = 0; j2 < 4; ++j2) ss[q] += (v[q][j2].x * v[q][j2].x + v[q][j2].y * v[q][j2].y) + (v[q][j2].z * v[q][j2].z + v[q][j2].w * v[q][j2].w);
                ss[q] = wave_sum(ss[q]);
            }
#pragma unroll
            for (int q = 0; q < 4; ++q) {
                if (!ok[q]) continue;
                const int m = mrow_[q]; const int b = m / LT, w = m % LT;
                const float* mrow = mod + (size_t)(w < CT ? 8 : b) * NMODC;
                const float rstd = rsqrtf(ss[q] * (1.f / D) + EPS);
#pragma unroll
                for (int j2 = 0; j2 < 4; ++j2) { const int k0 = 4 * lane + 256 * j2;
                    const f32x4 g = *(const f32x4*)(g1 + k0), sc = *(const f32x4*)(mrow + D + k0), sh = *(const f32x4*)(mrow + k0);
                    const f32x4 y = v[q][j2] * rstd * g; const f32x4 h = y * (sc + 1.f) + sh;
                    v2u pk; pk.x = pk2(h.x, h.y); pk.y = pk2(h.z, h.w);
                    *(v2u*)(HB + (size_t)m * D + k0) = pk; }
            }
        }
        if (ctxwg) {
            asm volatile("s_waitcnt vmcnt(0)" ::: "memory"); __syncthreads();
            const int pnl[7] = {1, 2, 3, 8, 9, 10, 11};
            int pn = 1;
#pragma unroll
            for (int q = 0; q < 7; ++q) if (q == cj_) pn = pnl[q];
            pg8::Gemm g{HB, WinT, M1, INC, D}; OneUnit S{9 * cb_, pn};
            EpiInProj E{(bf16*)(ws + WS_RQ), (bf16*)(ws + WS_RK), (bf16*)(ws + WS_RV), (bf16*)(ws + WS_RG), (bf16*)(ws + WS_DQ), (bf16*)(ws + WS_DK), (bf16*)(ws + WS_DV), tab, qkg};
            pg8::gemm_phase<EpiInProj, OneUnit, PG8_ALIGN, PG8_SP2>(lds, g, S, E);
            __syncthreads();
        }
        for (int i = blockIdx.x * NTHR + tid; i < NB * D; i += G * NTHR) { const int b = i >> 10, k = i & 1023; alpha2[i] = g2[k] * (1.f + mod[(size_t)b * NMODC + 4 * D + k]); }
        {   const float* const rows[8] = {mod + 3 * D, mod + NMODC + 3 * D, mod + 2 * NMODC + 3 * D, mod + 3 * NMODC + 3 * D, mod + 4 * NMODC + 3 * D, mod + 5 * NMODC + 3 * D, mod + 6 * NMODC + 3 * D, mod + 7 * NMODC + 3 * D};
            __syncthreads();
            gemv_rows<8, false>(rows, wq, 2048, nullptr, biasq, 2048, (LAS float*)lds); }
    if (MK_DUP == 1 && rep == 0) xcd_barrier(bar); } }
    SEAM(1);
    if (IN(2)) { for (int rep = 0; rep < (MK_DUP == 2 ? 2 : 1); ++rep) {
        __syncthreads();
        pg8::Gemm g{HB, WinT, M1, INC, D}; InSched S; S.init(G, (int)blockIdx.x);
        EpiInProj E{(bf16*)(ws + WS_RQ), (bf16*)(ws + WS_RK), (bf16*)(ws + WS_RV), (bf16*)(ws + WS_RG), (bf16*)(ws + WS_DQ), (bf16*)(ws + WS_DK), (bf16*)(ws + WS_DV), tab, qkg};
        pg8::gemm_phase<EpiInProj, InSched, PG8_ALIGN, PG8_SP2>(lds, g, S, E);
#if !MK_CTX_IN_P1
        {
            const int nslots = G >> 3, rr = 103 % nslots, xcd = (int)blockIdx.x & 7, slot = (int)blockIdx.x >> 3;
            const bool freewg = rr == 0 || slot >= rr;
            const int fidx = rr == 0 ? (int)blockIdx.x : (slot - rr) * 8 + xcd, nfree = rr == 0 ? G : (nslots - rr) * 8;
            if (freewg && rep == 0)
                for (int e = fidx * NWAVES + wave; e < 2 * 16384 - CVT_LATE; e += nfree * NWAVES) { if (e < 16384) peer::cvt_row_i4(pu, UT8, SUs, e, lane); else peer::cvt_row_fp4(pv, VT8, SVs, e - 16384, lane); }
        }
#endif
    if (MK_DUP == 2 && rep == 0) xcd_barrier(bar); } }
    SEAM(2);
    if (IN(3)) { for (int rep = 0; rep < (MK_DUP == 3 ? 2 : 1); ++rep) {
        __syncthreads();
        const bf16* DQb = (const bf16*)(ws + WS_DQ); const bf16* DKb = (const bf16*)(ws + WS_DK); const bf16* DVb = (const bf16*)(ws + WS_DV); bf16* ODb = (bf16*)(ws + WS_OD);
        for (int idx = blockIdx.x; idx < 512; idx += G) {
            const int b = idx & 7, rest = idx >> 3, hp = rest >> 3, qb = rest & 7;
            att::attn_unit(DQb + ((size_t)(b * 8 + hp) * L + qb * 256) * 64, DKb + (size_t)(b * 8 + hp) * LT * 64, DVb + (size_t)(b * 4 + (hp >> 1)) * LT * 128,
                           ODb + ((size_t)(b * 8 + hp) * L + qb * 256) * 128, LT, (char*)lds_raw);
        }
        const float* decay = args.in[9];
        for (int idx = blockIdx.x; idx < 288; idx += G) {
            const int b = idx & 7, rest = idx >> 3, h = rest / 9, c = rest % 9;
            float* st = (float*)(ws + WS_ST) + ((size_t)((b * 4 + h) * 9 + c) * 2) * 8192;
            ret::state_unit((const bf16*)(ws + WS_RK) + ((size_t)(b * 4 + h) * LT + 256 * c) * 64, (const bf16*)(ws + WS_RV) + ((size_t)(b * 4 + h) * LT + 256 * c) * 128,
                            st, st + 8192, ret::log2_sigmoid(decay[h]), ret::log2_sigmoid(decay[4 + h]), (char*)lds_raw);
        }
        {
            const int nextra = 288 > G ? 288 - G : 0, nslack = G - nextra;
            if ((int)blockIdx.x >= nextra && rep == 0)
                for (int e = 2 * 16384 - CVT_LATE + ((int)blockIdx.x - nextra) * NWAVES + wave; e < 2 * 16384; e += nslack * NWAVES) peer::cvt_row_fp4(pv, VT8, SVs, e - 16384, lane);
        }
    if (MK_DUP == 3 && rep == 0) xcd_barrier(bar); } }
    SEAM(3);
    if (IN(4)) { for (int rep = 0; rep < (MK_DUP == 4 ? 2 : 1); ++rep) {
        __syncthreads();
        const float* decay = args.in[9]; const float* ret_g = args.in[10]; const float* lamp = args.in[12]; const float* diff_g = args.in[13];
        bf16* MIX = (bf16*)(ws + WS_MIX);
        for (int idx = blockIdx.x; idx < 256; idx += G) {
            const int b = idx & 7, rest = idx >> 3, h = rest >> 3, blk = rest & 7, c = blk + 1;
            ret::out_unit((const bf16*)(ws + WS_RQ) + ((size_t)(b * 4 + h) * L + 256 * blk) * 64, (const bf16*)(ws + WS_RK) + ((size_t)(b * 4 + h) * LT + 256 * c) * 64,
                          (const bf16*)(ws + WS_RV) + ((size_t)(b * 4 + h) * LT + 256 * c) * 128, (const float*)(ws + WS_ST) + (size_t)(b * 4 + h) * 9 * 2 * 8192, c,
                          (const bf16*)(ws + WS_RG) + ((size_t)b * L + 256 * blk) * 512 + h * 128, ret_g + h * 128, MIX + ((size_t)b * L + 256 * blk) * D + h * 128,
                          ret::log2_sigmoid(decay[h]), ret::log2_sigmoid(decay[4 + h]), (char*)lds_raw);
        }
        {
            float a = lamp[lane] * lamp[64 + lane], b2 = lamp[128 + lane] * lamp[192 + lane];
            a = wave_sum(a); b2 = wave_sum(b2);
            const float lam_init = 0.2f, lam = expf(a) - expf(b2) + lam_init;
            const bf16* ODb = (const bf16*)(ws + WS_OD);
            const int h = lane >> 4, e0 = (lane & 15) * 8;
            const f32x4 g0 = *(const f32x4*)(diff_g + h * 128 + e0), g1v = *(const f32x4*)(diff_g + h * 128 + e0 + 4);
            for (int t0 = gw; t0 < M2; t0 += 4 * NGW) {
                v4u p0[4], p1[4];
#pragma unroll
                for (int u = 0; u < 4; ++u) { const int t = t0 + u * NGW < M2 ? t0 + u * NGW : t0; const int b = t >> 11, l = t & 2047;
                    p0[u] = *(const v4u*)(ODb + ((size_t)(b * 8 + 2 * h) * L + l) * 128 + e0); p1[u] = *(const v4u*)(ODb + ((size_t)(b * 8 + 2 * h + 1) * L + l) * 128 + e0); }
#pragma unroll
                for (int u = 0; u < 4; ++u) {
                    const int t = t0 + u * NGW;
                    float y[8]; float ss = 0.f;
#pragma unroll
                    for (int j = 0; j < 4; ++j) {
                        y[2 * j] = __builtin_bit_cast(float, p0[u][j] << 16) - lam * __builtin_bit_cast(float, p1[u][j] << 16);
                        y[2 * j + 1] = __builtin_bit_cast(float, p0[u][j] & 0xffff0000u) - lam * __builtin_bit_cast(float, p1[u][j] & 0xffff0000u);
                        ss += y[2 * j] * y[2 * j] + y[2 * j + 1] * y[2 * j + 1]; }
                    ss += __shfl_xor(ss, 1); ss += __shfl_xor(ss, 2); ss += __shfl_xor(ss, 4); ss += __shfl_xor(ss, 8);
                    const float rstd = rsqrtf(ss * (1.f / 128.f) + EPS) * (1.f - lam_init);
                    v4u o; o.x = pk2(y[0] * rstd * g0.x, y[1] * rstd * g0.y); o.y = pk2(y[2] * rstd * g0.z, y[3] * rstd * g0.w);
                    o.z = pk2(y[4] * rstd * g1v.x, y[5] * rstd * g1v.y); o.w = pk2(y[6] * rstd * g1v.z, y[7] * rstd * g1v.w);
                    if (t < M2) *(v4u*)(MIX + (size_t)t * D + 512 + h * 128 + e0) = o;
                }
            }
        }
    if (MK_DUP == 4 && rep == 0) xcd_barrier(bar); } }
    SEAM(4);
    if (IN(5)) { for (int rep = 0; rep < (MK_DUP == 5 ? 2 : 1); ++rep) {
        __syncthreads();
        pg8::Gemm g{(const bf16*)(ws + WS_MIX), WoutT, M2, D, D}; pg8::StaticOrder S; S.init(M2, D, G, (int)blockIdx.x);
        EpiOutProj E{x, (bf16*)(ws + WS_X1B), (bf16*)(ws + WS_X1A), mod, alpha2, (float*)(ws + WS_SSQ)};
        pg8::gemm_phase<EpiOutProj, pg8::StaticOrder, PG8_ALIGN, PG8_SP2>(lds, g, S, E);
    if (MK_DUP == 5 && rep == 0) xcd_barrier(bar); } }
    SEAM(5);
    if (IN(6)) { for (int rep = 0; rep < (MK_DUP == 6 ? 2 : 1); ++rep) {
        pg8::Gemm g{(const bf16*)(ws + WS_X1A), WqT, M2, 2048, D}; pg8::StaticOrder S0; S0.init(M2, 2048, G, (int)blockIdx.x);
        EpiQuerySelect E{biasq, (const float*)(ws + WS_SSQ), SubK, (int*)(ws + WS_PIDX), (float*)(ws + WS_PGATE)};
        for (int i = 0; ; ++i) {
            pg8::Unit u; if (!S0.next(i, u)) break;
            __syncthreads();
            OneUnit S{u.pm, u.pn};
            pg8::gemm_phase<EpiQuerySelect, OneUnit, false, PG8_SP2>(lds, g, S, E);
            peer::quant_h2_wave(u.pm * 256 + (u.pn & 1) * 128 + wave * 16, u.pn >> 1, (const bf16*)(ws + WS_X1A), (const float*)(ws + WS_SSQ), mod, ws + WS_HQ, (float*)(ws + WS_HS), lane);
        }
    if (MK_DUP == 6 && rep == 0) xcd_barrier(bar); } }
    SEAM(6);
    if (IN(8)) { for (int rep = 0; rep < (MK_DUP == 8 ? 2 : 1); ++rep) {
        __syncthreads();
        for (int grp = blockIdx.x; grp < M2 / 64; grp += G) {
            peer::gatherA_fused(grp * 64, (int)blockIdx.x & 3, ws + WS_HQ, (const float*)(ws + WS_HS), (const int*)(ws + WS_PIDX), (const float*)(ws + WS_PGATE), ws + WS_PW2, UT8, SUs, SVs, (char*)lds_raw);
            __syncthreads();
            peer::gatherB_fused(grp * 64, (int)blockIdx.x & 3, args.out, (const bf16*)(ws + WS_X1B), mod, (const unsigned*)(ws + WS_PW2), VT8, (char*)lds_raw);
            __syncthreads(); }
    if (MK_DUP == 8 && rep == 0) xcd_barrier(bar); } }
#undef IN
#undef SEAM
}
}

#ifndef MK_N_LAUNCHES
#define MK_N_LAUNCHES 1
#endif
extern "C" void kernel_launch(void* const* d_in, const int* in_sizes, int n_in, void* d_out, int out_size, void* d_ws, size_t ws_size, hipStream_t stream) {
    static int grid = 0;
    if (grid == 0) {
        int dev = 0, cus = 0, per_cu = 0;
        if (n_in != 19 || out_size != mk::M2 * mk::D || ws_size < mk::WS_END) { fprintf(stderr, "kernel_launch: unexpected shapes (n_in %d out %d ws %zu)\n", n_in, out_size, ws_size); grid = -1; return; }
        if (hipGetDevice(&dev) != hipSuccess || hipDeviceGetAttribute(&cus, hipDeviceAttributeMultiprocessorCount, dev) != hipSuccess) { grid = -1; return; }
        if (hipFuncSetAttribute((const void*)mk::mega, hipFuncAttributeMaxDynamicSharedMemorySize, mk::LDS_BYTES) != hipSuccess) { fprintf(stderr, "kernel_launch: hipFuncSetAttribute failed\n"); grid = -1; return; }
        if (hipOccupancyMaxActiveBlocksPerMultiprocessor(&per_cu, (const void*)mk::mega, mk::NTHR, mk::LDS_BYTES) != hipSuccess || per_cu < 1) { fprintf(stderr, "kernel_launch: occupancy query says %d blocks per CU\n", per_cu); grid = -1; return; }
        (void)hipGetLastError();
        grid = (cus / 8) * 8;
    }
    if (grid < 0) return;
    (void)in_sizes;
    unsigned char* wsb = (unsigned char*)d_ws;
    (void)hipMemsetAsync(wsb + mk::WS_CTL, 0, mk::CTL_ZERO_BYTES, stream);
#ifdef PROBE_MEMSET2
    (void)hipMemsetAsync(wsb + mk::WS_CTL, 0, mk::CTL_ZERO_BYTES, stream);
#endif
    mk::Args a{};
    for (int i = 0; i < 19; ++i) a.in[i] = (const float*)d_in[i];
    a.out = (float*)d_out; a.ws = wsb;
    if (MK_N_LAUNCHES == 1) { a.ph_lo = 0; a.ph_hi = 11; hipLaunchKernelGGL(mk::mega, dim3(grid), dim3(mk::NTHR), mk::LDS_BYTES, stream, a); }
    else for (int ph = 0; ph < 11; ++ph) { a.ph_lo = ph; a.ph_hi = ph + 1; hipLaunchKernelGGL(mk::mega, dim3(grid), dim3(mk::NTHR), mk::LDS_BYTES, stream, a); }
}
```
